# Optimizing an MI355X kernel written in HIP

```python
import math
import jax
import jax.numpy as jnp
from jax import lax
import numpy as np

D_MODEL = 2048
BATCH = 4
SEQ = 4096
DEPTH = 2

N_EVEN = (DEPTH + 1) // 2
N_ODD = DEPTH // 2
D_FF = 5632
EPS = 1e-6
CONV_CH = D_MODEL // 2
CONV_WIDTH = 31
DN_HEADS = 8
DN_DK = 128
DN_DV = 128
DN_QK = DN_HEADS * DN_DK
DN_WIDTH = DN_HEADS * DN_DV
SHORT_CONV = 3
CHUNK = 64
EVEN_IN = 2 * CONV_CH + 2 * DN_QK + 2 * DN_WIDTH + 4 * DN_HEADS
DA_HEADS = 8
DA_DH = D_MODEL // (2 * DA_HEADS)
ROPE_THETA = 500000.0
ROPE_DIMS = DA_DH // 4
Q_BLOCK = 128

kernel_name = "hybrid_conformer_deltanet_diffattn_encoder"


def rmsnorm(x, g):
    xf = x.astype(jnp.float32)
    y = xf * lax.rsqrt(jnp.mean(xf * xf, axis=-1, keepdims=True) + EPS)
    return (y * g.astype(jnp.float32)).astype(x.dtype)


def layernorm(x, g, b):
    xf = x.astype(jnp.float32)
    mu = jnp.mean(xf, axis=-1, keepdims=True)
    xc = xf - mu
    y = xc * lax.rsqrt(jnp.mean(xc * xc, axis=-1, keepdims=True) + EPS)
    return (y * g.astype(jnp.float32) + b.astype(jnp.float32)).astype(x.dtype)


def l2norm(x):
    xf = x.astype(jnp.float32)
    return xf * lax.rsqrt(jnp.sum(xf * xf, axis=-1, keepdims=True) + EPS)


def swiglu(x, wg, wu, wd):
    return (jax.nn.silu(x @ wg) * (x @ wu)) @ wd


def depthwise_conv(x, w):
    k = w.shape[0]
    return lax.conv_general_dilated(
        x, w[:, None, :].astype(x.dtype), window_strides=(1,),
        padding=[(k // 2, k // 2)], dimension_numbers=("NWC", "WIO", "NWC"),
        feature_group_count=x.shape[-1])


def gated_delta_rule(q, k, v, g, beta):
    b, h, s, dk = q.shape
    dv = v.shape[-1]
    n = s // CHUNK
    q = q.reshape(b, h, n, CHUNK, dk)
    k = k.reshape(b, h, n, CHUNK, dk)
    v = v.reshape(b, h, n, CHUNK, dv)
    beta = beta.reshape(b, h, n, CHUNK)
    gc = jnp.cumsum(g.reshape(b, h, n, CHUNK), axis=-1)
    idx = jnp.arange(CHUNK)
    incl = idx[:, None] >= idx[None, :]
    strict = idx[:, None] > idx[None, :]
    decay = jnp.exp(jnp.where(incl, gc[..., :, None] - gc[..., None, :], -jnp.inf))
    kb = k * beta[..., None]
    vb = v * beta[..., None]
    lmat = jnp.where(strict, jnp.einsum("bhnid,bhnjd->bhnij", kb, k) * decay, 0.0)
    eye = jnp.eye(CHUNK, dtype=jnp.float32)
    tmat = lax.linalg.triangular_solve(lmat + eye, jnp.broadcast_to(eye, lmat.shape),
                                       left_side=True, lower=True, unit_diagonal=True)
    gexp = jnp.exp(gc)
    u = tmat @ vb
    w = tmat @ (kb * gexp[..., None])
    a_intra = jnp.einsum("bhnid,bhnjd->bhnij", q, k) * decay
    q_dec = q * gexp[..., None]
    g_last = gc[..., -1]
    k_dec = k * jnp.exp(g_last[..., None] - gc)[..., None]
    xs = tuple(jnp.moveaxis(t, 2, 0) for t in (u, w, q_dec, k_dec, a_intra, jnp.exp(g_last)))

    def step(state, inp):
        u_i, w_i, qd_i, kd_i, a_i, gl_i = inp
        v_new = u_i - jnp.einsum("bhcd,bhde->bhce", w_i, state)
        o_i = jnp.einsum("bhcd,bhde->bhce", qd_i, state) + jnp.einsum("bhij,bhje->bhie", a_i, v_new)
        state = state * gl_i[..., None, None] + jnp.einsum("bhcd,bhce->bhde", kd_i, v_new)
        return state, o_i

    state0 = jnp.zeros((b, h, dk, dv), jnp.float32)
    _, o = lax.scan(step, state0, xs)
    return jnp.moveaxis(o, 0, 2).reshape(b, h, s, dv)


def even_mixer(hx, w_in, conv_w, conv_b, ln_g, ln_b, short_w, a_log, dt_bias, onorm_g, w_out):
    b, s, _ = hx.shape
    p = hx @ w_in
    i1 = CONV_CH
    i2 = 2 * CONV_CH
    i3 = i2 + 2 * DN_QK + DN_WIDTH
    i4 = i3 + DN_WIDTH
    i5 = i4 + 2 * DN_HEADS
    glu_v, glu_g, qkv, z, beta_raw, alpha_raw = jnp.split(p, [i1, i2, i3, i4, i5], axis=-1)
    a = glu_v * jax.nn.sigmoid(glu_g)
    a = depthwise_conv(a, conv_w) + conv_b.astype(a.dtype)
    a = jax.nn.silu(layernorm(a, ln_g, ln_b))
    qkv = jax.nn.silu(depthwise_conv(qkv, short_w))
    q, k, v = jnp.split(qkv, [DN_QK, 2 * DN_QK], axis=-1)
    q = l2norm(q.reshape(b, s, DN_HEADS, DN_DK)) * (DN_DK ** -0.5)
    k = l2norm(k.reshape(b, s, DN_HEADS, DN_DK))
    v = v.reshape(b, s, DN_HEADS, DN_DV).astype(jnp.float32)
    beta = jax.nn.sigmoid(beta_raw.astype(jnp.float32)).reshape(b, s, 2, DN_HEADS)
    g = -jnp.exp(a_log.astype(jnp.float32)) * jax.nn.softplus(
        alpha_raw.astype(jnp.float32).reshape(b, s, 2, DN_HEADS) + dt_bias.astype(jnp.float32))
    qh = jnp.transpose(q, (0, 2, 1, 3))
    kh = jnp.transpose(k, (0, 2, 1, 3))
    vh = jnp.transpose(v, (0, 2, 1, 3))
    g_f = jnp.transpose(g[:, :, 0], (0, 2, 1))
    g_b = jnp.transpose(g[:, :, 1], (0, 2, 1))
    b_f = jnp.transpose(beta[:, :, 0], (0, 2, 1))
    b_b = jnp.transpose(beta[:, :, 1], (0, 2, 1))
    o_fwd = gated_delta_rule(qh, kh, vh, g_f, b_f)
    o_bwd = jnp.flip(gated_delta_rule(jnp.flip(qh, 2), jnp.flip(kh, 2), jnp.flip(vh, 2),
                                      jnp.flip(g_b, 2), jnp.flip(b_b, 2)), 2)
    o = jnp.transpose(o_fwd + o_bwd, (0, 2, 1, 3))
    o = rmsnorm(o, onorm_g) * jax.nn.silu(z.reshape(b, s, DN_HEADS, DN_DV).astype(jnp.float32))
    o = o.reshape(b, s, DN_WIDTH).astype(hx.dtype)
    return jnp.concatenate([a, o], axis=-1) @ w_out


def partial_rotary(x, cos, sin):
    half = ROPE_DIMS // 2
    x1 = x[..., :half]
    x2 = x[..., half:ROPE_DIMS]
    return jnp.concatenate([x1 * cos - x2 * sin, x2 * cos + x1 * sin, x[..., ROPE_DIMS:]], axis=-1)


def odd_mixer(hx, positions, w_qkv, lq1, lk1, lq2, lk2, subln_g, w_o, lambda_init):
    b, s, _ = hx.shape
    q, k, v = jnp.split(hx @ w_qkv, [D_MODEL, 2 * D_MODEL], axis=-1)
    q = q.reshape(b, s, DA_HEADS, 2, DA_DH)
    k = k.reshape(b, s, DA_HEADS, 2, DA_DH)
    v = v.reshape(b, s, DA_HEADS, 2 * DA_DH)
    inv_freq = ROPE_THETA ** (-jnp.arange(0, ROPE_DIMS, 2, dtype=jnp.float32) / ROPE_DIMS)
    ang = positions.astype(jnp.float32)[..., None] * inv_freq
    cos = jnp.cos(ang)[:, :, None, None, :].astype(hx.dtype)
    sin = jnp.sin(ang)[:, :, None, None, :].astype(hx.dtype)
    q = partial_rotary(q, cos, sin) * (DA_DH ** -0.5)
    k = partial_rotary(k, cos, sin)
    nb = s // Q_BLOCK
    qb = jnp.transpose(q.reshape(b, nb, Q_BLOCK, DA_HEADS, 2, DA_DH), (1, 0, 3, 4, 2, 5))
    kt = jnp.transpose(k, (0, 2, 3, 1, 4))
    vt = jnp.transpose(v, (0, 2, 1, 3))
    lam = (jnp.exp(jnp.sum(lq1.astype(jnp.float32) * lk1.astype(jnp.float32)))
           - jnp.exp(jnp.sum(lq2.astype(jnp.float32) * lk2.astype(jnp.float32))) + lambda_init)

    def attend(q_blk):
        sc = jnp.einsum("bhmqd,bhmkd->bhmqk", q_blk, kt).astype(jnp.float32)
        pr = jax.nn.softmax(sc, axis=-1)
        wgt = pr[:, :, 0] - lam * pr[:, :, 1]
        return jnp.einsum("bhqk,bhke->bhqe", wgt.astype(vt.dtype), vt)

    o = lax.map(attend, qb)
    o = jnp.transpose(o, (1, 0, 3, 2, 4)).reshape(b, s, DA_HEADS, 2 * DA_DH)
    o = rmsnorm(o, subln_g) * (1.0 - lambda_init)
    return o.reshape(b, s, D_MODEL) @ w_o


def setup_inputs(seed: int = 0) -> dict:
    key = jax.random.key(seed)
    ks = iter(jax.random.split(key, 48))

    def nrm(shape, scale):
        return jax.random.normal(next(ks), shape, jnp.float32) * scale

    def gain(shape):
        return 1.0 + nrm(shape, 0.02)

    x = nrm((BATCH, SEQ, D_MODEL), 1.0)
    positions = jnp.broadcast_to(jnp.arange(SEQ, dtype=jnp.int32), (BATCH, SEQ))
    norm_ffn1 = gain((DEPTH, D_MODEL))
    ffn1_wg = nrm((DEPTH, D_MODEL, D_FF), D_MODEL ** -0.5)
    ffn1_wu = nrm((DEPTH, D_MODEL, D_FF), D_MODEL ** -0.5)
    ffn1_wd = nrm((DEPTH, D_FF, D_MODEL), D_FF ** -0.5)
    norm_mix = gain((DEPTH, D_MODEL))
    norm_ffn2 = gain((DEPTH, D_MODEL))
    ffn2_wg = nrm((DEPTH, D_MODEL, D_FF), D_MODEL ** -0.5)
    ffn2_wu = nrm((DEPTH, D_MODEL, D_FF), D_MODEL ** -0.5)
    ffn2_wd = nrm((DEPTH, D_FF, D_MODEL), D_FF ** -0.5)
    ev_w_in = nrm((N_EVEN, D_MODEL, EVEN_IN), D_MODEL ** -0.5)
    ev_conv_w = nrm((N_EVEN, CONV_WIDTH, CONV_CH), CONV_WIDTH ** -0.5)
    ev_conv_b = nrm((N_EVEN, CONV_CH), 0.02)
    ev_ln_g = gain((N_EVEN, CONV_CH))
    ev_ln_b = nrm((N_EVEN, CONV_CH), 0.02)
    ev_short_w = nrm((N_EVEN, SHORT_CONV, 2 * DN_QK + DN_WIDTH), SHORT_CONV ** -0.5)
    ev_a_log = jnp.log(jax.random.uniform(next(ks), (N_EVEN, 2, DN_HEADS), jnp.float32, 1.0, 16.0))
    dt = jnp.exp(jax.random.uniform(next(ks), (N_EVEN, 2, DN_HEADS), jnp.float32,
                                    math.log(1e-3), math.log(1e-1)))
    ev_dt_bias = dt + jnp.log(-jnp.expm1(-dt))
    ev_onorm_g = gain((N_EVEN, DN_DV))
    ev_w_out = nrm((N_EVEN, CONV_CH + DN_WIDTH, D_MODEL), (CONV_CH + DN_WIDTH) ** -0.5)
    od_w_qkv = nrm((N_ODD, D_MODEL, 3 * D_MODEL), D_MODEL ** -0.5)
    od_lq1 = nrm((N_ODD, DA_DH), 0.1)
    od_lk1 = nrm((N_ODD, DA_DH), 0.1)
    od_lq2 = nrm((N_ODD, DA_DH), 0.1)
    od_lk2 = nrm((N_ODD, DA_DH), 0.1)
    od_subln_g = gain((N_ODD, 2 * DA_DH))
    od_w_o = nrm((N_ODD, D_MODEL, D_MODEL), D_MODEL ** -0.5)
    final_norm = gain((D_MODEL,))
    return {"x": x, "positions": positions,
            "norm_ffn1": norm_ffn1, "ffn1_wg": ffn1_wg, "ffn1_wu": ffn1_wu, "ffn1_wd": ffn1_wd,
            "norm_mix": norm_mix,
            "norm_ffn2": norm_ffn2, "ffn2_wg": ffn2_wg, "ffn2_wu": ffn2_wu, "ffn2_wd": ffn2_wd,
            "ev_w_in": ev_w_in, "ev_conv_w": ev_conv_w, "ev_conv_b": ev_conv_b,
            "ev_ln_g": ev_ln_g, "ev_ln_b": ev_ln_b, "ev_short_w": ev_short_w,
            "ev_a_log": ev_a_log, "ev_dt_bias": ev_dt_bias, "ev_onorm_g": ev_onorm_g, "ev_w_out": ev_w_out,
            "od_w_qkv": od_w_qkv, "od_lq1": od_lq1, "od_lk1": od_lk1, "od_lq2": od_lq2, "od_lk2": od_lk2,
            "od_subln_g": od_subln_g, "od_w_o": od_w_o,
            "final_norm": final_norm}


def reference(x, positions, norm_ffn1, ffn1_wg, ffn1_wu, ffn1_wd, norm_mix,
              norm_ffn2, ffn2_wg, ffn2_wu, ffn2_wd,
              ev_w_in, ev_conv_w, ev_conv_b, ev_ln_g, ev_ln_b, ev_short_w,
              ev_a_log, ev_dt_bias, ev_onorm_g, ev_w_out,
              od_w_qkv, od_lq1, od_lk1, od_lq2, od_lk2, od_subln_g, od_w_o,
              final_norm):
    for i in range(DEPTH):
        x = x + 0.5 * swiglu(rmsnorm(x, norm_ffn1[i]), ffn1_wg[i], ffn1_wu[i], ffn1_wd[i])
        hx = rmsnorm(x, norm_mix[i])
        j = i // 2
        if i % 2 == 0:
            x = x + even_mixer(hx, ev_w_in[j], ev_conv_w[j], ev_conv_b[j], ev_ln_g[j], ev_ln_b[j],
                               ev_short_w[j], ev_a_log[j], ev_dt_bias[j], ev_onorm_g[j], ev_w_out[j])
        else:
            lambda_init = 0.8 - 0.6 * math.exp(-0.3 * i)
            x = x + odd_mixer(hx, positions, od_w_qkv[j], od_lq1[j], od_lk1[j], od_lq2[j], od_lk2[j],
                              od_subln_g[j], od_w_o[j], lambda_init)
        x = x + 0.5 * swiglu(rmsnorm(x, norm_ffn2[i]), ffn2_wg[i], ffn2_wu[i], ffn2_wd[i])
    return rmsnorm(x, final_norm)
```

```cpp
#include <hip/hip_runtime.h>
#include <hip/hip_cooperative_groups.h>
#include <cstdio>
#include <cstdint>
namespace cg = cooperative_groups;
__device__ __forceinline__ int tidx() { int t = threadIdx.x; asm volatile("" : "+v"(t)); return t; }
namespace pg8 {
#define PG8_LAS __attribute__((address_space(3)))
typedef unsigned short bf16_t;
typedef short bf16x8 __attribute__((ext_vector_type(8)));
typedef float f32x4 __attribute__((ext_vector_type(4)));
typedef unsigned u32x4 __attribute__((ext_vector_type(4)));
constexpr int BM = 256, BK = 64, HALF = 128, HTB = HALF * BK * 2  , STAGE_BYTES = 8 * HTB, NXCD = 8, WGM = 8;

__host__ __device__ __forceinline__ int lds_byte(int r, int c) { const int st = (r >> 4) * 2 + (c >> 5), rr = r & 15, cc = c & 31, ob = rr * 64 + cc * 2; return st * 1024 + (ob ^ (((ob >> 9) & 1) << 5)); }
__host__ __device__ __forceinline__ void stage_rc(int b, int& R, int& C) { const int st = b / 1024, sb = b % 1024, swz = sb ^ (((sb >> 9) & 1) << 5); R = (st >> 1) * 16 + swz / 64; C = (st & 1) * 32 + (swz % 64) / 2; }
__host__ __device__ __forceinline__ int perm32(int rho) { const int n = rho >> 4, i = rho & 15; return 8 * (i >> 2) + 4 * n + (i & 3); }
struct Unit { int pm, pn; };
struct Gemm { const bf16_t* A; const bf16_t* Bt; int M, N, K; };

struct StaticOrder {
    int nM, nN, nwg, G, c;
    __host__ __device__ void init(int M, int N, int G_, int c_) { nM = M / BM; nN = N / BM; nwg = nM * nN; G = G_; c = c_; }
    __host__ __device__ bool next(int i, Unit& u) const {
        const long L = (long)i * G + c; if (L >= nwg) return false;
        int wgid = (int)L; { const int q = nwg / NXCD, r = nwg % NXCD, xcd = wgid % NXCD, off = wgid / NXCD; wgid = (xcd < r ? xcd * (q + 1) : r * (q + 1) + (xcd - r) * q) + off; }
        const int nig = WGM * nN, gid = wgid / nig, fm = gid * WGM, gsz = (nM - fm) < WGM ? (nM - fm) : WGM;
        u.pm = fm + ((wgid % nig) % gsz); u.pn = (wgid % nig) / gsz; return true;
    }
    __device__ __forceinline__ void a_ready(const Unit&) const {}
    __device__ __forceinline__ void done(const Unit&) const {}
};
__device__ __forceinline__ unsigned cvt_pk_bf16(float lo, float hi) { unsigned r; asm volatile("v_cvt_pk_bf16_f32 %0, %1, %2" : "=v"(r) : "v"(lo), "v"(hi)); return r; }
template <class Epi, class Sched, bool STAMP = false>
__device__ __forceinline__ void gemm_phase(PG8_LAS unsigned char* lds, const Gemm g, const Sched& S, const Epi& E, unsigned long long* stamps) {
    const int tid = tidx(), wid = __builtin_amdgcn_readfirstlane(tid >> 6), lane = tid & 63, wr = wid >> 2, wc = wid & 3, fr = lane & 15, fq = lane >> 4;
    const int K = g.K, nt = K / BK;
    int ts_lo = 0, ts_hi = 0, nts = 0; const unsigned long long rt_entry = STAMP ? (unsigned long long)wall_clock64() : 0ull;
#define PG8_STAMP() do { if (STAMP && wid == 0 && nts < 64) { const unsigned long long _c = (unsigned long long)clock64(); \
        ts_lo = (lane == nts) ? (int)(unsigned)_c : ts_lo; ts_hi = (lane == nts) ? (int)(unsigned)(_c >> 32) : ts_hi; ++nts; } } while (0)
    PG8_STAMP();
    unsigned voffA[2], voffB[2];
#pragma unroll
    for (int i = 0; i < 2; ++i) { int R, C; stage_rc(tid * 16 + i * 8192, R, C); const int Rb = Epi::PERM ? ((R & ~31) + perm32(R & 31)) : R;
        voffA[i] = (unsigned)(R * K + C) * 2u; voffB[i] = (unsigned)(Rb * K + C) * 2u; }
    const size_t kstep = (size_t)(BK * 2);
    const size_t hstep = (size_t)HALF * K * 2;
    const size_t tstep = 2 * hstep;
    const unsigned ldsw = (unsigned)wid * 1024u;
    const int aoff = lds_byte(wr * 64 + fr, fq * 8), boff = lds_byte(wc * 32 + fr, fq * 8);
#define PG8_SA(b, h) (((b) * 2 + (h)) * HTB)
#define PG8_SB(b, h) ((4 + (b) * 2 + (h)) * HTB)
#define PG8_STAGE(bufoff, gbase, voff) do { _Pragma("unroll") for (int _i = 0; _i < 2; ++_i) \
        __builtin_amdgcn_global_load_lds((const unsigned*)((const char*)(gbase) + (voff)[_i]), (PG8_LAS unsigned*)(lds + (bufoff) + ldsw + _i * 8192), 16, 0, 0); } while (0)
#define PG8_LDA(dst, b, h) do { _Pragma("unroll") for (int m = 0; m < 4; ++m) _Pragma("unroll") for (int k = 0; k < 2; ++k) dst[m][k] = *(const PG8_LAS bf16x8*)(lds + PG8_SA(b, h) + aoff + m * 2048 + k * 1024); } while (0)
#define PG8_LDB(dst, b, h) do { _Pragma("unroll") for (int n = 0; n < 2; ++n) _Pragma("unroll") for (int k = 0; k < 2; ++k) dst[n][k] = *(const PG8_LAS bf16x8*)(lds + PG8_SB(b, h) + boff + n * 2048 + k * 1024); } while (0)
#define PG8_MMA(ai, bj, At, Bt) do { __builtin_amdgcn_s_setprio(1); _Pragma("unroll") for (int m = 0; m < 4; ++m) _Pragma("unroll") for (int n = 0; n < 2; ++n) _Pragma("unroll") for (int k = 0; k < 2; ++k) \
        acc[ai][bj][m][n] = __builtin_amdgcn_mfma_f32_16x16x32_bf16(Bt[n][k], At[m][k], acc[ai][bj][m][n], 0, 0, 0); __builtin_amdgcn_s_setprio(0); } while (0)
#define PG8_WAIT_V(n) asm volatile("s_waitcnt vmcnt(" #n ")" ::: "memory")
#define PG8_WAIT_L(n) asm volatile("s_waitcnt lgkmcnt(" #n ")" ::: "memory")
#define PG8_BAR __builtin_amdgcn_s_barrier()
#define PG8_SCHED __builtin_amdgcn_sched_barrier(0)
    Unit cur, nxt; int ui = 0;
    if (!S.next(0, cur)) return;
    f32x4 acc[2][2][4][2];
#pragma unroll
    for (int a = 0; a < 2; ++a)
#pragma unroll
        for (int b = 0; b < 2; ++b)
#pragma unroll
            for (int m = 0; m < 4; ++m)
#pragma unroll
                for (int n = 0; n < 2; ++n) acc[a][b][m][n] = (f32x4){0.f, 0.f, 0.f, 0.f};
    bf16x8 At[4][2], B0[2][2], B1[2][2];
    const char* cA = (const char*)g.A + (size_t)cur.pm * tstep; const char* cB = (const char*)g.Bt + (size_t)cur.pn * tstep;
    S.a_ready(cur);
    PG8_STAGE(PG8_SB(0, 0), cB, voffB); PG8_STAGE(PG8_SA(0, 0), cA, voffA); PG8_STAGE(PG8_SB(0, 1), cB + hstep, voffB); PG8_STAGE(PG8_SA(0, 1), cA + hstep, voffA);
    if (wr == 1) PG8_BAR;
    PG8_WAIT_V(4); PG8_BAR;
    PG8_STAGE(PG8_SB(1, 0), cB + kstep, voffB); PG8_STAGE(PG8_SA(1, 0), cA + kstep, voffA); PG8_STAGE(PG8_SB(1, 1), cB + hstep + kstep, voffB);
    PG8_WAIT_V(6); PG8_BAR;
    PG8_STAMP();
    for (;;) {
        const bool has_next = S.next(ui + 1, nxt);
        const char* nA = has_next ? (const char*)g.A + (size_t)nxt.pm * tstep : cA; const char* nB = has_next ? (const char*)g.Bt + (size_t)nxt.pn * tstep : cB;
        for (int t = 0; t < nt; t += 2) {
            const bool last = (t == nt - 2);
            const char* a1 = cA + (size_t)(t + 1) * kstep;
            const char* a2 = last ? nA : cA + (size_t)(t + 2) * kstep; const char* b2 = last ? nB : cB + (size_t)(t + 2) * kstep;
            const char* a3 = a2 + kstep; const char* b3 = b2 + kstep;
            if (last && has_next) S.a_ready(nxt);
            PG8_LDB(B0, 0, 0); PG8_SCHED; PG8_LDA(At, 0, 0); PG8_STAGE(PG8_SA(1, 1), a1 + hstep, voffA);
            PG8_WAIT_L(8); PG8_BAR; PG8_WAIT_L(0); PG8_MMA(0, 0, At, B0); PG8_BAR; PG8_SCHED;
            PG8_LDB(B1, 0, 1); PG8_STAGE(PG8_SB(0, 0), b2, voffB);
            PG8_BAR; PG8_WAIT_L(0); PG8_MMA(0, 1, At, B1); PG8_BAR;
            PG8_LDA(At, 0, 1); PG8_STAGE(PG8_SA(0, 0), a2, voffA);
            PG8_BAR; PG8_WAIT_L(0); PG8_MMA(1, 0, At, B0); PG8_BAR; PG8_SCHED;
            PG8_STAGE(PG8_SB(0, 1), b2 + hstep, voffB);
            PG8_WAIT_V(6); PG8_BAR; PG8_MMA(1, 1, At, B1); PG8_BAR;
            PG8_LDB(B0, 1, 0); PG8_SCHED; PG8_LDA(At, 1, 0); PG8_STAGE(PG8_SA(0, 1), a2 + hstep, voffA);
            PG8_WAIT_L(8); PG8_BAR; PG8_WAIT_L(0); PG8_MMA(0, 0, At, B0); PG8_BAR; PG8_SCHED;
            PG8_LDB(B1, 1, 1); PG8_STAGE(PG8_SB(1, 0), b3, voffB);
            PG8_BAR; PG8_WAIT_L(0); PG8_MMA(0, 1, At, B1); PG8_BAR;
            PG8_LDA(At, 1, 1); PG8_STAGE(PG8_SA(1, 0), a3, voffA);
            PG8_BAR; PG8_WAIT_L(0); PG8_MMA(1, 0, At, B0); PG8_BAR; PG8_SCHED;
            PG8_STAGE(PG8_SB(1, 1), b3 + hstep, voffB);
            PG8_WAIT_V(6); PG8_BAR; PG8_MMA(1, 1, At, B1); PG8_BAR;
        }
        PG8_STAMP();
        if constexpr (!Epi::AFTER_DRAIN) { E(acc, cur, wr, wc, fr, fq); S.done(cur); }
        PG8_STAMP();
        if (!has_next) break;
#pragma unroll
        for (int a = 0; a < 2; ++a)
#pragma unroll
            for (int b = 0; b < 2; ++b)
#pragma unroll
                for (int m = 0; m < 4; ++m)
#pragma unroll
                    for (int n = 0; n < 2; ++n) acc[a][b][m][n] = (f32x4){0.f, 0.f, 0.f, 0.f};
        cur = nxt; cA = nA; cB = nB; ++ui;
    }
    PG8_WAIT_V(0);
    if (wr == 0) PG8_BAR;
    PG8_BAR;
    if constexpr (Epi::AFTER_DRAIN) { E.fused(acc, cur, wr, wc, fr, fq, lds, wid, lane); S.done(cur); }
    PG8_STAMP();
    if (STAMP && wid == 0) { stamps[lane] = lane < nts ? (((unsigned long long)(unsigned)ts_hi << 32) | (unsigned)ts_lo) : 0ull;
        if (lane == 62) stamps[62] = rt_entry; if (lane == 63) stamps[63] = (unsigned long long)wall_clock64(); }
#undef PG8_STAMP
#undef PG8_SA
#undef PG8_SB
#undef PG8_STAGE
#undef PG8_LDA
#undef PG8_LDB
#undef PG8_MMA
#undef PG8_WAIT_V
#undef PG8_WAIT_L
#undef PG8_BAR
#undef PG8_SCHED
}
}

namespace att {
using bf16 = unsigned short;
constexpr int   D = 128, NW = 8, QBLK = 32, KVBLK = 64;
constexpr float SCALE = 0.088388347648318440f;
constexpr float THR = 8.f;
constexpr int SDEPTH = 2;
constexpr int LDQ = 6144, LDK = 6144, LDO = 2048;
constexpr size_t SHM_V = KVBLK * D * 2, SHM_K = KVBLK * D * 2, SHM_ATTN = 2 * SHM_V + 2 * SHM_K + NW * 64 * 4;
using bf16x8 = __attribute__((ext_vector_type(8))) short;
using s16x4  = __attribute__((ext_vector_type(4))) short;
using f32x16 = __attribute__((ext_vector_type(16))) float;
using f32x8  = __attribute__((ext_vector_type(8))) float;
using u32x4  = __attribute__((ext_vector_type(4))) unsigned;
#define KSWZ(row, colB) ((row) * 256 + ((colB) ^ (((row) & 7) << 4)))
#define SBAR() __builtin_amdgcn_sched_barrier(0)
__device__ __forceinline__ int crow(int r, int hi) { return (r & 3) + 8 * (r >> 2) + 4 * hi; }
__device__ __forceinline__ unsigned cvtpk(float lo, float hi) {
  unsigned r; asm volatile("v_cvt_pk_bf16_f32 %0, %1, %2" : "=v"(r) : "v"(lo), "v"(hi)); return r;
}
template <typename TIn> struct Stage;
template <> struct Stage<bf16>  { using T = bf16x8;
  __device__ static __forceinline__ T ld8(const bf16* p) { return *reinterpret_cast<const bf16x8*>(p); }
  __device__ static __forceinline__ bf16x8 tobf(T x) { return x; } };
template <> struct Stage<float> { using T = f32x8;
  __device__ static __forceinline__ T ld8(const float* p) { return *reinterpret_cast<const f32x8*>(p); }
  __device__ static __forceinline__ bf16x8 tobf(T x) {
    u32x4 w = {cvtpk(x[0], x[1]), cvtpk(x[2], x[3]), cvtpk(x[4], x[5]), cvtpk(x[6], x[7])}; return *reinterpret_cast<bf16x8*>(&w); } };

__device__ __forceinline__ void partialSM(f32x16& p0, f32x16& p1, float& m_reg, float& mn, float& alpha) {
  constexpr float C = SCALE * 1.4426950408889634f;
  float pmax = p0[0]; for (int r = 1; r < 16; ++r) pmax = fmaxf(pmax, p0[r]); for (int r = 0; r < 16; ++r) pmax = fmaxf(pmax, p1[r]);
  { auto rr = __builtin_amdgcn_permlane32_swap(__float_as_uint(pmax), __float_as_uint(pmax), false, false);
    pmax = fmaxf(__uint_as_float(rr[0]), __uint_as_float(rr[1])); }
  if (__builtin_expect(__all(pmax - m_reg <= THR / SCALE), 1)) { mn = m_reg; alpha = 1.f; }
  else { mn = fmaxf(m_reg, pmax); alpha = __builtin_amdgcn_exp2f((m_reg - mn) * C); m_reg = mn; }
  float mnC = -mn * C;
  for (int r = 0; r < 16; ++r) p0[r] = fmaf(p0[r], C, mnC); for (int r = 0; r < 16; ++r) p1[r] = fmaf(p1[r], C, mnC);
  for (int r = 0; r < 16; ++r) p0[r] = __builtin_amdgcn_exp2f(p0[r]);
}
__device__ __forceinline__ void finishSM(f32x16& p0, f32x16& p1, float alpha, float& l_reg, bf16x8& pa0, bf16x8& pa1, bf16x8& pa2, bf16x8& pa3) {
  for (int r = 0; r < 16; ++r) p1[r] = __builtin_amdgcn_exp2f(p1[r]);
  float ps = 0; for (int r = 0; r < 16; ++r) ps += p0[r]; for (int r = 0; r < 16; ++r) ps += p1[r];
  { auto rr = __builtin_amdgcn_permlane32_swap(__float_as_uint(ps), __float_as_uint(ps), false, false);
    ps = __uint_as_float(rr[0]) + __uint_as_float(rr[1]); }
  l_reg = l_reg * alpha + ps;
#define PK4(P, BASE, OUT) do { unsigned a0 = cvtpk(P[BASE + 0], P[BASE + 1]), a1 = cvtpk(P[BASE + 2], P[BASE + 3]);   \
    unsigned b0 = cvtpk(P[BASE + 4], P[BASE + 5]), b1 = cvtpk(P[BASE + 6], P[BASE + 7]);                              \
    auto r0 = __builtin_amdgcn_permlane32_swap(a0, b0, false, false); auto r1 = __builtin_amdgcn_permlane32_swap(a1, b1, false, false); \
    u32x4 w = {r0[0], r1[0], r0[1], r1[1]}; OUT = *reinterpret_cast<bf16x8*>(&w); } while (0)
  PK4(p0, 0, pa0); PK4(p0, 8, pa1); PK4(p1, 0, pa2); PK4(p1, 8, pa3);
#undef PK4
}
__device__ __forceinline__ void qkt(f32x16& p0, f32x16& p1, const bf16* Ks, const bf16x8* qr, int r32, int hi) {
  p0 = f32x16{}; p1 = f32x16{};
  for (int d0 = 0; d0 < 8; ++d0) { int cb = (d0 * 16 + hi * 8) * 2;
    bf16x8 b0 = *reinterpret_cast<const bf16x8*>((const char*)Ks + KSWZ(r32, cb));
    bf16x8 b1 = *reinterpret_cast<const bf16x8*>((const char*)Ks + KSWZ(32 + r32, cb));
    p0 = __builtin_amdgcn_mfma_f32_32x32x16_bf16(b0, qr[d0], p0, 0, 0, 0);
    p1 = __builtin_amdgcn_mfma_f32_32x32x16_bf16(b1, qr[d0], p1, 0, 0, 0); }
}
__device__ __forceinline__ int v_st(int k, int c) { const int kk = (k & ~0xC) | ((k & 4) << 1) | ((k & 8) >> 1); return ((kk >> 3) * 4 + (c >> 5)) * 512 + ((kk & 7) * 32 + (c & 31)) * 2; }
__device__ __forceinline__ int v_rd_base(int lane) { return ((lane & 3) << 3) | (((lane >> 2) & 3) << 6) | (((lane >> 4) & 1) << 5) | (((lane >> 5) & 1) << 8); }
constexpr int v_rd_off(int d0, int ks, int half) { return d0 * 512 + ks * 4096 + half * 2048; }
template <int OFF> __device__ __forceinline__ s16x4 tr_read(int vb) {
  s16x4 r; asm volatile("ds_read_b64_tr_b16 %0, %1 offset:%2" : "=&v"(r) : "v"(vb), "i"(OFF) : "memory"); return r;
}
template <int D0> __device__ __forceinline__ void pv_one(f32x16& od, int vb, bf16x8 pa0, bf16x8 pa1, bf16x8 pa2, bf16x8 pa3) {
  const s16x4 l0 = tr_read<v_rd_off(D0, 0, 0)>(vb), h0 = tr_read<v_rd_off(D0, 0, 1)>(vb), l1 = tr_read<v_rd_off(D0, 1, 0)>(vb), h1 = tr_read<v_rd_off(D0, 1, 1)>(vb);
  const s16x4 l2 = tr_read<v_rd_off(D0, 2, 0)>(vb), h2 = tr_read<v_rd_off(D0, 2, 1)>(vb), l3 = tr_read<v_rd_off(D0, 3, 0)>(vb), h3 = tr_read<v_rd_off(D0, 3, 1)>(vb);
  asm volatile("s_waitcnt lgkmcnt(0)" ::: "memory"); SBAR();
#define PK(L, H) (bf16x8){L[0], L[1], L[2], L[3], H[0], H[1], H[2], H[3]}
  od = __builtin_amdgcn_mfma_f32_32x32x16_bf16(pa0, PK(l0, h0), od, 0, 0, 0);
  od = __builtin_amdgcn_mfma_f32_32x32x16_bf16(pa1, PK(l1, h1), od, 0, 0, 0);
  od = __builtin_amdgcn_mfma_f32_32x32x16_bf16(pa2, PK(l2, h2), od, 0, 0, 0);
  od = __builtin_amdgcn_mfma_f32_32x32x16_bf16(pa3, PK(l3, h3), od, 0, 0, 0);
#undef PK
}
__device__ __forceinline__ void pv_d0(f32x16* o, int vb, bf16x8 pa0, bf16x8 pa1, bf16x8 pa2, bf16x8 pa3) {
  pv_one<0>(o[0], vb, pa0, pa1, pa2, pa3); pv_one<1>(o[1], vb, pa0, pa1, pa2, pa3); pv_one<2>(o[2], vb, pa0, pa1, pa2, pa3); pv_one<3>(o[3], vb, pa0, pa1, pa2, pa3);
}

template <typename TQ>
__device__ __forceinline__ void attn_dense_body(const TQ* __restrict__ Qb, const bf16* __restrict__ Kh, const bf16* __restrict__ Vh,
                                                float* __restrict__ Ob, int seq, char* lds, int mode, float lam) {
  using St = Stage<bf16>; using SQ = Stage<TQ>;
  const int tid = tidx(), wid = tid >> 6, lane = tid & 63, r32 = lane & 31, hi = lane >> 5;
  bf16* V_lds = (bf16*)lds; bf16* K_lds = (bf16*)(lds + 2 * SHM_V);
  float* ws = (float*)(lds + 2 * SHM_V + 2 * SHM_K) + wid * 64; float* li_l = ws; float* al_l = ws + 32;
  float m_reg = -1e30f, l_reg = 0; f32x16 o[4] = {}; bf16x8 qr[8];
  const TQ* Qw = Qb + (long)(wid * QBLK + r32) * LDQ + hi * 8;
#pragma unroll
  for (int d0 = 0; d0 < 8; ++d0) qr[d0] = SQ::tobf(SQ::ld8(Qw + d0 * 16));
  const int sr = tid >> 4, sc = (tid & 15) * 8, vst0 = v_st(sr, sc), vst1 = v_st(32 + sr, sc);
  const int vb0 = (int)(uintptr_t)V_lds + v_rd_base(lane);
  struct { typename St::T vs0, vs1, ks0, ks1; } sr_[SDEPTH];
#define SLOAD(i, k0) do { sr_[i].vs0 = St::ld8(&Vh[(long)((k0) + sr) * LDK + sc]); sr_[i].vs1 = St::ld8(&Vh[(long)((k0) + 32 + sr) * LDK + sc]); \
    sr_[i].ks0 = St::ld8(&Kh[(long)((k0) + sr) * LDK + sc]); sr_[i].ks1 = St::ld8(&Kh[(long)((k0) + 32 + sr) * LDK + sc]); } while (0)
#define SWRITE(b, i) do { *(bf16x8*)((char*)V_lds + (b) * SHM_V + vst0) = St::tobf(sr_[i].vs0);          \
    *(bf16x8*)((char*)V_lds + (b) * SHM_V + vst1) = St::tobf(sr_[i].vs1); int kc = sc * 2;               \
    *(bf16x8*)((char*)K_lds + (b) * SHM_K + KSWZ(sr, kc)) = St::tobf(sr_[i].ks0);                       \
    *(bf16x8*)((char*)K_lds + (b) * SHM_K + KSWZ(32 + sr, kc)) = St::tobf(sr_[i].ks1); } while (0)
#define SWAIT() do { if constexpr (SDEPTH == 2) asm volatile("s_waitcnt vmcnt(4)" ::: "memory"); else asm volatile("s_waitcnt vmcnt(0)" ::: "memory"); } while (0)
#define RESC(a) do { if (__any((a) < 1.f)) { if (hi == 0) al_l[r32] = (a); asm volatile("s_waitcnt lgkmcnt(0)" ::: "memory"); \
    for (int d = 0; d < 4; ++d) for (int r = 0; r < 16; ++r) o[d][r] *= al_l[crow(r, hi)]; } } while (0)
  f32x16 pA0, pA1, pB0, pB1; float mnA, mnB, alA, alB; bf16x8 pa0, pa1, pa2, pa3; const int NT = seq / KVBLK;
  constexpr int SE = 0, SO = SDEPTH - 1;
  SLOAD(SE, 0); asm volatile("s_waitcnt vmcnt(0)" ::: "memory"); SWRITE(0, SE); __syncthreads();
  qkt(pA0, pA1, K_lds, qr, r32, hi); partialSM(pA0, pA1, m_reg, mnA, alA);
  SLOAD(SO, KVBLK); if constexpr (SDEPTH == 2) { if (2 < NT) SLOAD(SE, 2 * KVBLK); }
  SWAIT(); SWRITE(1, SO); __syncthreads();
  for (int j = 1; j + 1 < NT; j += 2) {
    SBAR(); qkt(pB0, pB1, (bf16*)((char*)K_lds + SHM_K), qr, r32, hi);
    finishSM(pA0, pA1, alA, l_reg, pa0, pa1, pa2, pa3); SBAR();
    SLOAD(SO, (j + SDEPTH) * KVBLK); SBAR();
    pv_d0(o, vb0, pa0, pa1, pa2, pa3); partialSM(pB0, pB1, m_reg, mnB, alB);
    __syncthreads(); SWAIT(); SWRITE(0, SE);
    RESC(alB); __syncthreads();
    SBAR(); qkt(pA0, pA1, K_lds, qr, r32, hi);
    finishSM(pB0, pB1, alB, l_reg, pa0, pa1, pa2, pa3); SBAR();
    if (SDEPTH == 1 || j + 3 < NT) SLOAD(SE, (j + 1 + SDEPTH) * KVBLK); SBAR();
    pv_d0(o, vb0 + (int)SHM_V, pa0, pa1, pa2, pa3); partialSM(pA0, pA1, m_reg, mnA, alA);
    __syncthreads(); SWAIT(); SWRITE(1, SO);
    RESC(alA); __syncthreads();
  }
  SBAR(); qkt(pB0, pB1, (bf16*)((char*)K_lds + SHM_K), qr, r32, hi);
  finishSM(pA0, pA1, alA, l_reg, pa0, pa1, pa2, pa3); SBAR();
  pv_d0(o, vb0, pa0, pa1, pa2, pa3); partialSM(pB0, pB1, m_reg, mnB, alB);
  __syncthreads(); RESC(alB);
  finishSM(pB0, pB1, alB, l_reg, pa0, pa1, pa2, pa3); SBAR();
  pv_d0(o, vb0 + (int)SHM_V, pa0, pa1, pa2, pa3);
  if (hi == 0) li_l[r32] = l_reg; asm volatile("s_waitcnt lgkmcnt(0)" ::: "memory");
  float rli[16];
#pragma unroll
  for (int r = 0; r < 16; ++r) rli[r] = __builtin_amdgcn_rcpf(li_l[crow(r, hi)]);
  float* Ow = Ob + (long)(wid * QBLK) * LDO;
#pragma unroll
  for (int r = 0; r < 16; ++r) { int orow = crow(r, hi);
    for (int d0 = 0; d0 < 4; ++d0) { float* op = &Ow[(long)orow * LDO + d0 * 32 + r32]; const float val = o[d0][r] * rli[r]; *op = mode ? (*op - lam * val) : val; } }
#undef SLOAD
#undef SWRITE
#undef SWAIT
#undef RESC
}

#undef KSWZ
#undef SBAR
}
namespace mk {
using pg8::bf16_t; using pg8::f32x4; using pg8::u32x4; using pg8::cvt_pk_bf16; using pg8::Unit;
typedef unsigned u32x2 __attribute__((ext_vector_type(2)));
typedef float f32x2 __attribute__((ext_vector_type(2)));
constexpr int T = 16384, DM = 2048, FF = 5632, SEQ = 4096;
constexpr int NIN_REAL = 6176, NIN = 6400, NQKV = 6144;
constexpr int LDS_BYTES = 139264;
constexpr float EPS = 1e-6f;
constexpr float LAMBDA_INIT = 0.35550906759096924f;
constexpr int NPHASE = 24;

constexpr size_t SZ_SMALL = (size_t)T * 32 * 4;
constexpr size_t SZ_GU = (size_t)2 * FF * DM * 2, SZ_D = (size_t)DM * FF * 2;
constexpr size_t WS_ROPE = 0, WS_BA = WS_ROPE + SZ_SMALL, WS_BG = WS_BA + SZ_SMALL;
constexpr size_t WS_WGU = WS_BG + SZ_SMALL, WS_WD = WS_WGU + 4 * SZ_GU;
constexpr size_t WS_WIN = WS_WD + 4 * SZ_D, WS_WOUT = WS_WIN + (size_t)NIN * DM * 2;
constexpr size_t WS_WQKV = WS_WOUT + (size_t)DM * DM * 2, WS_WO = WS_WQKV + (size_t)NQKV * DM * 2;
constexpr size_t WS_XN = WS_WO + (size_t)DM * DM * 2;
constexpr size_t WS_H = WS_XN + (size_t)T * DM * 2;
constexpr size_t WS_S = WS_H + (size_t)T * NIN * 2;
constexpr size_t SZ_T1K = (size_t)T * 1024 * 2;
constexpr size_t WS_END = WS_S + 5 * SZ_T1K;

struct Args { const float* in[29]; float* out; unsigned char* ws; int ph_lo, ph_hi; };
typedef const __attribute__((address_space(4))) Args* AP;

__device__ __forceinline__ float bflo(unsigned w) { return __uint_as_float(w << 16); }
__device__ __forceinline__ float bfhi(unsigned w) { return __uint_as_float(w & 0xffff0000u); }
__device__ __forceinline__ float sigm(float x) { return __builtin_amdgcn_rcpf(1.f + __expf(-x)); }
__device__ __forceinline__ float silu(float x) { return x * sigm(x); }
__device__ __forceinline__ float wave_sum(float v) {
#pragma unroll
  for (int m = 32; m >= 1; m >>= 1) v += __shfl_xor(v, m, 64);
  return v;
}

struct EpiSwiglu { static constexpr bool PERM = true, AFTER_DRAIN = false; bf16_t* H;
  __device__ __forceinline__ void operator()(const f32x4 (&acc)[2][2][4][2], const Unit& u, int wr, int wc, int fr, int fq) const {
    const int row0 = u.pm * 256 + wr * 64 + fr, col0 = u.pn * 128 + wc * 32 + 8 * fq;
#pragma unroll
    for (int ai = 0; ai < 2; ++ai)
#pragma unroll
      for (int m = 0; m < 4; ++m) {
        const f32x4 g0 = acc[ai][0][m][0], g1 = acc[ai][0][m][1], u0 = acc[ai][1][m][0], u1 = acc[ai][1][m][1];
        float h[8];
#pragma unroll
        for (int j = 0; j < 4; ++j) { h[j] = silu(g0[j]) * u0[j]; h[4 + j] = silu(g1[j]) * u1[j]; }
        u32x4 w; w[0] = cvt_pk_bf16(h[0], h[1]); w[1] = cvt_pk_bf16(h[2], h[3]); w[2] = cvt_pk_bf16(h[4], h[5]); w[3] = cvt_pk_bf16(h[6], h[7]);
        *(u32x4*)(H + (size_t)(row0 + ai * 128 + m * 16) * FF + col0) = w;
      }
  }
};
struct EpiResid { static constexpr bool PERM = false, AFTER_DRAIN = false; const float* in; float* out; float scale;
  __device__ __forceinline__ void operator()(const f32x4 (&acc)[2][2][4][2], const Unit& u, int wr, int wc, int fr, int fq) const {
    const int row0 = u.pm * 256 + wr * 64 + fr, col0 = u.pn * 256 + wc * 32 + 4 * fq;
#pragma unroll
    for (int ai = 0; ai < 2; ++ai)
#pragma unroll
      for (int m = 0; m < 4; ++m) {
        const size_t off = (size_t)(row0 + ai * 128 + m * 16) * DM + col0;
#pragma unroll
        for (int bj = 0; bj < 2; ++bj)
#pragma unroll
          for (int n = 0; n < 2; ++n) { const size_t o2 = off + bj * 128 + n * 16; const f32x4 r = *(const f32x4*)(in + o2); *(f32x4*)(out + o2) = r + acc[ai][bj][m][n] * scale; }
      }
  }
};
struct EpiP { static constexpr bool PERM = true, AFTER_DRAIN = false; bf16_t* P; float* BA;
  __device__ __forceinline__ void operator()(const f32x4 (&acc)[2][2][4][2], const Unit& u, int wr, int wc, int fr, int fq) const {
    const int row0 = u.pm * 256 + wr * 64 + fr, col0 = u.pn * 256 + wc * 32 + 8 * fq;
#pragma unroll
    for (int ai = 0; ai < 2; ++ai)
#pragma unroll
      for (int m = 0; m < 4; ++m) {
        const int row = row0 + ai * 128 + m * 16;
#pragma unroll
        for (int bj = 0; bj < 2; ++bj) {
          const f32x4 a0 = acc[ai][bj][m][0], a1 = acc[ai][bj][m][1];
          u32x4 w; w[0] = cvt_pk_bf16(a0[0], a0[1]); w[1] = cvt_pk_bf16(a0[2], a0[3]); w[2] = cvt_pk_bf16(a1[0], a1[1]); w[3] = cvt_pk_bf16(a1[2], a1[3]);
          *(u32x4*)(P + (size_t)row * NIN + col0 + bj * 128) = w;
        }
        if (u.pn == 24 && wc == 0) { *(f32x4*)(BA + (size_t)row * 32 + 8 * fq) = acc[ai][0][m][0]; *(f32x4*)(BA + (size_t)row * 32 + 8 * fq + 4) = acc[ai][0][m][1]; }
      }
  }
};
struct EpiQKV { static constexpr bool PERM = false, AFTER_DRAIN = false; bf16_t* O; const float* rope;
  __device__ __forceinline__ void operator()(const f32x4 (&acc)[2][2][4][2], const Unit& u, int wr, int wc, int fr, int fq) const {
    const int row0 = u.pm * 256 + wr * 64 + fr, col0 = u.pn * 256 + wc * 32 + 4 * fq;
#pragma unroll
    for (int ai = 0; ai < 2; ++ai)
#pragma unroll
      for (int m = 0; m < 4; ++m) {
        const int row = row0 + ai * 128 + m * 16;
#pragma unroll
        for (int bj = 0; bj < 2; ++bj) {
          f32x4 v0 = acc[ai][bj][m][0], v1 = acc[ai][bj][m][1];
          if (wc == 0 && (2 * u.pn + bj) < 32) {
            const f32x4 c = *(const f32x4*)(rope + (size_t)row * 32 + 4 * fq), s = *(const f32x4*)(rope + (size_t)row * 32 + 16 + 4 * fq);
            const f32x4 n0 = v0 * c - v1 * s, n1 = v1 * c + v0 * s; v0 = n0; v1 = n1;
          }
          u32x2 w0, w1; w0[0] = cvt_pk_bf16(v0[0], v0[1]); w0[1] = cvt_pk_bf16(v0[2], v0[3]); w1[0] = cvt_pk_bf16(v1[0], v1[1]); w1[1] = cvt_pk_bf16(v1[2], v1[3]);
          bf16_t* p = O + (size_t)row * NQKV + col0 + bj * 128;
          *(u32x2*)p = w0; *(u32x2*)(p + 16) = w1;
        }
      }
  }
};

__device__ __forceinline__ void xpose_mat(const float* __restrict__ W, int K, int N, bf16_t* __restrict__ Wt, int mode, float* tile) {
  const int tid = tidx();
  const int nkt = K / 512, ntiles = nkt * (N / 32);
  for (int t = blockIdx.x; t < ntiles; t += gridDim.x) {
    const int kt = t % nkt, nt = t / nkt, k0 = kt * 512, n0 = nt * 32;
    const int rn = tid & 31, rk = tid >> 5;
    const float* src = W + (size_t)(k0 + rk) * N + n0 + rn;
    float v[32];
#pragma unroll
    for (int i = 0; i < 32; ++i) v[i] = src[(size_t)(16 * i) * N];
#pragma unroll
    for (int i = 0; i < 32; ++i) tile[(rk + 16 * i) * 33 + rn] = v[i];
    __syncthreads();
    const int wn = tid >> 4, wk = (tid & 15) * 8, n = n0 + wn;
    int nd = n; if (mode == 1) nd = (n >> 7) * 256 + (n & 127); else if (mode == 2) nd = (n >> 7) * 256 + 128 + (n & 127);
#pragma unroll
    for (int q = 0; q < 4; ++q) {
      const int kk = wk + 128 * q; const float* tp = tile + kk * 33 + wn;
      u32x4 w; w[0] = cvt_pk_bf16(tp[0], tp[33]); w[1] = cvt_pk_bf16(tp[66], tp[99]); w[2] = cvt_pk_bf16(tp[132], tp[165]); w[3] = cvt_pk_bf16(tp[198], tp[231]);
      *(u32x4*)(Wt + (size_t)nd * K + k0 + kk) = w;
    }
    __syncthreads();
  }
}

template <bool F32OUT>
__device__ __forceinline__ void rmsnorm_phase(const float* X, const float* __restrict__ g, void* dst) {
  const int lane = tidx() & 63, wid = tidx() >> 6;
  for (int row = blockIdx.x * 8 + wid; row < T; row += gridDim.x * 8) {
    const float* xr = X + (size_t)row * DM;
    f32x4 v[8]; float ss = 0.f;
#pragma unroll
    for (int i = 0; i < 8; ++i) { v[i] = *(const f32x4*)(xr + (i * 64 + lane) * 4); ss += v[i][0] * v[i][0] + v[i][1] * v[i][1] + v[i][2] * v[i][2] + v[i][3] * v[i][3]; }
    ss = wave_sum(ss);
    const float rstd = rsqrtf(ss * (1.f / DM) + EPS);
#pragma unroll
    for (int i = 0; i < 8; ++i) {
      const f32x4 gg = *(const f32x4*)(g + (i * 64 + lane) * 4); const f32x4 y = v[i] * rstd * gg;
      if (F32OUT) *(f32x4*)((float*)dst + (size_t)row * DM + (i * 64 + lane) * 4) = y;
      else { u32x2 w; w[0] = cvt_pk_bf16(y[0], y[1]); w[1] = cvt_pk_bf16(y[2], y[3]); *(u32x2*)((bf16_t*)dst + (size_t)row * DM + (i * 64 + lane) * 4) = w; }
    }
  }
}

__device__ __forceinline__ void prologue(AP a, unsigned char* lds) {
  unsigned char* ws = a->ws;
  float* tile = (float*)lds;
  for (int f = 0; f < 4; ++f) {
    const int layer = f >> 1, which = f & 1;
    const float* wg = a->in[which ? 8 : 3] + (size_t)layer * DM * FF; const float* wu = a->in[which ? 9 : 4] + (size_t)layer * DM * FF; const float* wd = a->in[which ? 10 : 5] + (size_t)layer * DM * FF;
    xpose_mat(wg, DM, FF, (bf16_t*)(ws + WS_WGU + f * SZ_GU), 1, tile);
    xpose_mat(wu, DM, FF, (bf16_t*)(ws + WS_WGU + f * SZ_GU), 2, tile);
    xpose_mat(wd, FF, DM, (bf16_t*)(ws + WS_WD + f * SZ_D), 0, tile);
  }
  xpose_mat(a->in[11], DM, NIN_REAL, (bf16_t*)(ws + WS_WIN), 0, tile);
  xpose_mat(a->in[20], DM, DM, (bf16_t*)(ws + WS_WOUT), 0, tile);
  xpose_mat(a->in[21], DM, NQKV, (bf16_t*)(ws + WS_WQKV), 0, tile);
  xpose_mat(a->in[27], DM, DM, (bf16_t*)(ws + WS_WO), 0, tile);
  const size_t gtid = (size_t)blockIdx.x * 512 + tidx(), gn = (size_t)gridDim.x * 512;
  { u32x4* p = (u32x4*)(ws + WS_WIN + (size_t)NIN_REAL * DM * 2); const size_t n16 = (size_t)(NIN - NIN_REAL) * DM * 2 / 16; const u32x4 z = {0u, 0u, 0u, 0u};
    for (size_t i = gtid; i < n16; i += gn) p[i] = z; }
  { float* rope = (float*)(ws + WS_ROPE); const int* pos = (const int*)a->in[1];
    for (size_t i = gtid; i < (size_t)T * 16; i += gn) {
      const int tok = (int)(i >> 4), j = (int)(i & 15);
      const float inv = exp2f(-(float)j * (18.931568569324174f / 16.f));
      double rev = (double)pos[tok] * (double)inv * 0.15915494309189535; rev -= floor(rev);
      const float fr = (float)rev;
      rope[(size_t)tok * 32 + j] = __builtin_amdgcn_cosf(fr); rope[(size_t)tok * 32 + 16 + j] = __builtin_amdgcn_sinf(fr);
    } }
  rmsnorm_phase<false>(a->in[0], a->in[2], ws + WS_XN);
}

__device__ __forceinline__ void conv_module(AP a, unsigned char* lds) {
  const bf16_t* P = (const bf16_t*)(a->ws + WS_H); bf16_t* CAT = (bf16_t*)(a->ws + WS_XN);
  unsigned* glu = (unsigned*)lds; float* part = (float*)(lds + 62 * 512 * 4); float* stats = part + 512;
  const int tid = tidx(), lane = tid & 63, wid = tid >> 6, c0 = 2 * tid;
  const float* cw = a->in[12];
  float w0[31], w1[31];
#pragma unroll
  for (int j = 0; j < 31; ++j) { const f32x2 t = *(const f32x2*)(cw + j * 1024 + c0); w0[j] = t[0]; w1[j] = t[1]; }
  const f32x2 cb = *(const f32x2*)(a->in[13] + c0), lg = *(const f32x2*)(a->in[14] + c0), lb = *(const f32x2*)(a->in[15] + c0);
  for (int tile = blockIdx.x; tile < T / 32; tile += gridDim.x) {
    const int tok0 = tile * 32, s0 = tok0 & (SEQ - 1);
    for (int r = 0; r < 62; ++r) {
      const int s = s0 - 15 + r; unsigned val = 0u;
      if (s >= 0 && s < SEQ) { const bf16_t* pr = P + (size_t)(tok0 - 15 + r) * NIN + c0; const unsigned pv = *(const unsigned*)pr, pg = *(const unsigned*)(pr + 1024);
        val = cvt_pk_bf16(bflo(pv) * sigm(bflo(pg)), bfhi(pv) * sigm(bfhi(pg))); }
      glu[r * 512 + tid] = val;
    }
#pragma unroll 1
    for (int tt = 0; tt < 32; ++tt) {
      float o0 = cb[0], o1 = cb[1];
#pragma unroll
      for (int j = 0; j < 31; ++j) { const unsigned u = glu[(tt + j) * 512 + tid]; o0 += w0[j] * bflo(u); o1 += w1[j] * bfhi(u); }
      const float s = wave_sum(o0 + o1), q = wave_sum(o0 * o0 + o1 * o1);
      if (lane == 0) { part[(wid * 32 + tt) * 2] = s; part[(wid * 32 + tt) * 2 + 1] = q; }
    }
    __syncthreads();
    if (tid < 32) { float s = 0.f, q = 0.f;
      for (int w = 0; w < 8; ++w) { s += part[(w * 32 + tid) * 2]; q += part[(w * 32 + tid) * 2 + 1]; }
      const float mean = s * (1.f / 1024.f), var = fmaxf(q * (1.f / 1024.f) - mean * mean, 0.f);
      stats[tid * 2] = mean; stats[tid * 2 + 1] = rsqrtf(var + EPS); }
    __syncthreads();
#pragma unroll 1
    for (int tt = 0; tt < 32; ++tt) {
      float o0 = cb[0], o1 = cb[1];
#pragma unroll
      for (int j = 0; j < 31; ++j) { const unsigned u = glu[(tt + j) * 512 + tid]; o0 += w0[j] * bflo(u); o1 += w1[j] * bfhi(u); }
      const float mean = stats[tt * 2], rstd = stats[tt * 2 + 1];
      const float y0 = (o0 - mean) * rstd * lg[0] + lb[0], y1 = (o1 - mean) * rstd * lg[1] + lb[1];
      *(unsigned*)(CAT + (size_t)(tok0 + tt) * DM + c0) = cvt_pk_bf16(silu(y0), silu(y1));
    }
    __syncthreads();
  }
}

__device__ __forceinline__ void dn_prep(AP a) {
  const bf16_t* P = (const bf16_t*)(a->ws + WS_H);
  bf16_t* QN = (bf16_t*)(a->ws + WS_S); bf16_t* KN = (bf16_t*)(a->ws + WS_S + SZ_T1K); bf16_t* VS = (bf16_t*)(a->ws + WS_S + 2 * SZ_T1K);
  const float* sw = a->in[16];
  const int lane = tidx() & 63, wid = tidx() >> 6;
  for (int task = blockIdx.x * 8 + wid; task < T * 24; task += gridDim.x * 8) {
    const int tok = task / 24, slot = task - tok * 24, s = tok & (SEQ - 1);
    const int c = slot * 128 + 2 * lane;
    const f32x2 wa = *(const f32x2*)(sw + c), wb = *(const f32x2*)(sw + 3072 + c), wc = *(const f32x2*)(sw + 6144 + c);
    const bf16_t* pr = P + (size_t)tok * NIN + 2048 + c;
    const unsigned x0 = *(const unsigned*)pr;
    const unsigned xm = (s > 0) ? *(const unsigned*)(pr - NIN) : 0u, xp = (s < SEQ - 1) ? *(const unsigned*)(pr + NIN) : 0u;
    float y0 = wa[0] * bflo(xm) + wb[0] * bflo(x0) + wc[0] * bflo(xp), y1 = wa[1] * bfhi(xm) + wb[1] * bfhi(x0) + wc[1] * bfhi(xp);
    y0 = silu(y0); y1 = silu(y1);
    if (slot < 16) { const float ss = wave_sum(y0 * y0 + y1 * y1); float r = rsqrtf(ss + EPS); if (slot < 8) r *= 0.08838834764831845f; y0 *= r; y1 *= r; }
    bf16_t* dst = (slot < 8 ? QN : (slot < 16 ? KN : VS)) + (size_t)tok * 1024 + (slot & 7) * 128 + 2 * lane;
    *(unsigned*)dst = cvt_pk_bf16(y0, y1);
  }
  const float* BA = (const float*)(a->ws + WS_BA); float* BG = (float*)(a->ws + WS_BG);
  for (size_t i = (size_t)blockIdx.x * 512 + tidx(); i < (size_t)T * 16; i += (size_t)gridDim.x * 512) {
    const int tok = (int)(i >> 4), j = (int)(i & 15);
    const float braw = BA[(size_t)tok * 32 + j], araw = BA[(size_t)tok * 32 + 16 + j];
    const float xx = araw + a->in[18][j]; const float sp = xx > 20.f ? xx : log1pf(expf(xx));
    const float g = -expf(a->in[17][j]) * sp;
    BG[(size_t)tok * 32 + j] = sigm(braw); BG[(size_t)tok * 32 + 16 + j] = expf(g);
  }
}

__device__ __forceinline__ void scan_phase(AP a, unsigned char* lds) {
  const bf16_t* QN = (const bf16_t*)(a->ws + WS_S); const bf16_t* KN = (const bf16_t*)(a->ws + WS_S + SZ_T1K); const bf16_t* VS = (const bf16_t*)(a->ws + WS_S + 2 * SZ_T1K);
  const float* BG = (const float*)(a->ws + WS_BG);
  constexpr int BUF_F = 32 * 128 * 2 + 32 * 32 + 64;
  float* sb = (float*)lds; float* ob = sb + 2 * BUF_F;
  const int tid = tidx(), lane = tid & 63, wid = tid >> 6, j = lane & 15, col = wid * 4 + (lane >> 4);
  const int tl = tid >> 4, c8 = (tid & 15) * 8, tlv = (tid >> 2) & 31, cv = (tid & 3) * 8;
  for (int item = blockIdx.x; item < 256; item += gridDim.x) {
    const int cb = item & 3, dir = (item >> 2) & 1, h = (item >> 3) & 7, b = item >> 6;
    bf16_t* OD = (bf16_t*)(a->ws + WS_S + (3 + dir) * SZ_T1K);
    float S[8];
#pragma unroll
    for (int i = 0; i < 8; ++i) S[i] = 0.f;
    u32x4 kr, qr, vr; float ar = 0.f, br = 0.f;
#define SC_TOK(c, t) (b * SEQ + (dir ? (SEQ - 1 - ((c) * 32 + (t))) : ((c) * 32 + (t))))
#define SC_LOAD(c) do { const size_t tk = (size_t)SC_TOK(c, tl); kr = *(const u32x4*)(KN + tk * 1024 + h * 128 + c8); qr = *(const u32x4*)(QN + tk * 1024 + h * 128 + c8); \
      if (tid < 128) vr = *(const u32x4*)(VS + (size_t)SC_TOK(c, tlv) * 1024 + h * 128 + cb * 32 + cv); \
      else if (tid < 160) { const size_t t2 = (size_t)SC_TOK(c, tid - 128); br = BG[t2 * 32 + dir * 8 + h]; ar = BG[t2 * 32 + 16 + dir * 8 + h]; } } while (0)
#define SC_WRITE(bi) do { float* kb = sb + (bi) * BUF_F; float* qb = kb + 4096; float* vb = qb + 4096; float* abp = vb + 1024; \
      *(f32x4*)(kb + tl * 128 + c8) = (f32x4){bflo(kr[0]), bfhi(kr[0]), bflo(kr[1]), bfhi(kr[1])}; *(f32x4*)(kb + tl * 128 + c8 + 4) = (f32x4){bflo(kr[2]), bfhi(kr[2]), bflo(kr[3]), bfhi(kr[3])}; \
      *(f32x4*)(qb + tl * 128 + c8) = (f32x4){bflo(qr[0]), bfhi(qr[0]), bflo(qr[1]), bfhi(qr[1])}; *(f32x4*)(qb + tl * 128 + c8 + 4) = (f32x4){bflo(qr[2]), bfhi(qr[2]), bflo(qr[3]), bfhi(qr[3])}; \
      if (tid < 128) { *(f32x4*)(vb + tlv * 32 + cv) = (f32x4){bflo(vr[0]), bfhi(vr[0]), bflo(vr[1]), bfhi(vr[1])}; *(f32x4*)(vb + tlv * 32 + cv + 4) = (f32x4){bflo(vr[2]), bfhi(vr[2]), bflo(vr[3]), bfhi(vr[3])}; } \
      else if (tid < 160) { abp[(tid - 128) * 2] = ar; abp[(tid - 128) * 2 + 1] = br; } } while (0)
#define SC_FLUSH(c) do { if (tid < 128) { const float* op = ob + ((c) & 1) * 1024 + tlv * 32 + cv; const f32x4 x0 = *(const f32x4*)op, x1 = *(const f32x4*)(op + 4); \
      u32x4 w; w[0] = cvt_pk_bf16(x0[0], x0[1]); w[1] = cvt_pk_bf16(x0[2], x0[3]); w[2] = cvt_pk_bf16(x1[0], x1[1]); w[3] = cvt_pk_bf16(x1[2], x1[3]); \
      *(u32x4*)(OD + (size_t)SC_TOK(c, tlv) * 1024 + h * 128 + cb * 32 + cv) = w; } } while (0)
    __syncthreads();
    SC_LOAD(0); SC_WRITE(0); __syncthreads();
    for (int c = 0; c < SEQ / 32; ++c) {
      if (c + 1 < SEQ / 32) SC_LOAD(c + 1);
      if (c > 0) SC_FLUSH(c - 1);
      const float* kb = sb + (c & 1) * BUF_F; const float* qb = kb + 4096; const float* vb = qb + 4096; const float* abp = vb + 1024; float* obc = ob + (c & 1) * 1024;
#pragma unroll 4
      for (int t = 0; t < 32; ++t) {
        const f32x4 k0 = *(const f32x4*)(kb + t * 128 + 8 * j), k1 = *(const f32x4*)(kb + t * 128 + 8 * j + 4);
        const f32x4 q0 = *(const f32x4*)(qb + t * 128 + 8 * j), q1 = *(const f32x4*)(qb + t * 128 + 8 * j + 4);
        const float vv = vb[t * 32 + col], al = abp[t * 2], bt = abp[t * 2 + 1];
        float d = S[0] * k0[0] + S[1] * k0[1] + S[2] * k0[2] + S[3] * k0[3] + S[4] * k1[0] + S[5] * k1[1] + S[6] * k1[2] + S[7] * k1[3];
        d += __shfl_xor(d, 1, 64); d += __shfl_xor(d, 2, 64); d += __shfl_xor(d, 4, 64); d += __shfl_xor(d, 8, 64);
        const float dl = bt * (vv - al * d);
        S[0] = al * S[0] + k0[0] * dl; S[1] = al * S[1] + k0[1] * dl; S[2] = al * S[2] + k0[2] * dl; S[3] = al * S[3] + k0[3] * dl;
        S[4] = al * S[4] + k1[0] * dl; S[5] = al * S[5] + k1[1] * dl; S[6] = al * S[6] + k1[2] * dl; S[7] = al * S[7] + k1[3] * dl;
        float od = S[0] * q0[0] + S[1] * q0[1] + S[2] * q0[2] + S[3] * q0[3] + S[4] * q1[0] + S[5] * q1[1] + S[6] * q1[2] + S[7] * q1[3];
        od += __shfl_xor(od, 1, 64); od += __shfl_xor(od, 2, 64); od += __shfl_xor(od, 4, 64); od += __shfl_xor(od, 8, 64);
        if (j == 0) obc[t * 32 + col] = od;
      }
      if (c + 1 < SEQ / 32) SC_WRITE((c + 1) & 1);
      __syncthreads();
    }
    SC_FLUSH(SEQ / 32 - 1);
    __syncthreads();
#undef SC_TOK
#undef SC_LOAD
#undef SC_WRITE
#undef SC_FLUSH
  }
}

__device__ __forceinline__ void gnorm_phase(AP a) {
  const bf16_t* P = (const bf16_t*)(a->ws + WS_H); bf16_t* CAT = (bf16_t*)(a->ws + WS_XN);
  const bf16_t* OF = (const bf16_t*)(a->ws + WS_S + 3 * SZ_T1K); const bf16_t* OB = (const bf16_t*)(a->ws + WS_S + 4 * SZ_T1K);
  const int lane = tidx() & 63, wid = tidx() >> 6;
  const f32x2 g = *(const f32x2*)(a->in[19] + 2 * lane);
  for (int task = blockIdx.x * 8 + wid; task < T * 8; task += gridDim.x * 8) {
    const int tok = task >> 3, h = task & 7;
    const size_t o = (size_t)tok * 1024 + h * 128 + 2 * lane;
    const unsigned uf = *(const unsigned*)(OF + o), ub = *(const unsigned*)(OB + o), uz = *(const unsigned*)(P + (size_t)tok * NIN + 5120 + h * 128 + 2 * lane);
    const float o0 = bflo(uf) + bflo(ub), o1 = bfhi(uf) + bfhi(ub);
    const float ss = wave_sum(o0 * o0 + o1 * o1), rstd = rsqrtf(ss * (1.f / 128.f) + EPS);
    const float y0 = o0 * rstd * g[0] * silu(bflo(uz)), y1 = o1 * rstd * g[1] * silu(bfhi(uz));
    *(unsigned*)(CAT + (size_t)tok * DM + 1024 + h * 128 + 2 * lane) = cvt_pk_bf16(y0, y1);
  }
}

__device__ __forceinline__ void attn_phase(AP a, unsigned char* lds) {
  const bf16_t* QKV = (const bf16_t*)(a->ws + WS_H); float* OA = (float*)(a->ws + WS_S);
  const int lane = tidx() & 63;
  const float s1 = wave_sum(a->in[22][lane] * a->in[23][lane] + a->in[22][lane + 64] * a->in[23][lane + 64]);
  const float s2 = wave_sum(a->in[24][lane] * a->in[25][lane] + a->in[24][lane + 64] * a->in[25][lane + 64]);
  const float lam = expf(s1) - expf(s2) + LAMBDA_INIT;
  int seq = SEQ; asm volatile("" : "+s"(seq));
  const int nk = (1024 - (int)blockIdx.x + (int)gridDim.x - 1) / (int)gridDim.x;
#pragma unroll 1
  for (int it = 0; it < 2 * nk; ++it) {
    const int item = blockIdx.x + gridDim.x * (it >> 1), m = it & 1;
    const int h = item & 7, qb = (item >> 3) & 15, vh = (item >> 7) & 1, b = item >> 8;
    const size_t tok0 = (size_t)b * SEQ + qb * 256, kv0 = (size_t)b * SEQ;
    att::attn_dense_body<att::bf16>(QKV + tok0 * NQKV + h * 256 + m * 128, QKV + kv0 * NQKV + 2048 + h * 256 + m * 128, QKV + kv0 * NQKV + 4096 + h * 256 + vh * 128,
                                    OA + tok0 * DM + h * 256 + vh * 128, seq, (char*)lds, m, lam);
    __syncthreads();
  }
}
__device__ __forceinline__ void subln_phase(AP a) {
  const float* OA = (const float*)(a->ws + WS_S); bf16_t* CAT = (bf16_t*)(a->ws + WS_XN);
  const int lane = tidx() & 63, wid = tidx() >> 6;
  const f32x4 g = *(const f32x4*)(a->in[26] + 4 * lane);
  for (int task = blockIdx.x * 8 + wid; task < T * 8; task += gridDim.x * 8) {
    const size_t o = (size_t)(task >> 3) * DM + (task & 7) * 256 + 4 * lane;
    const f32x4 v = *(const f32x4*)(OA + o);
    const float ss = wave_sum(v[0] * v[0] + v[1] * v[1] + v[2] * v[2] + v[3] * v[3]), r = rsqrtf(ss * (1.f / 256.f) + EPS) * (1.f - LAMBDA_INIT);
    u32x2 w; w[0] = cvt_pk_bf16(v[0] * r * g[0], v[1] * r * g[1]); w[1] = cvt_pk_bf16(v[2] * r * g[2], v[3] * r * g[3]);
    *(u32x2*)(CAT + o) = w;
  }
}

enum { PT_PRO, PT_GU, PT_RES, PT_NORM, PT_IN, PT_CONV, PT_SCAN, PT_GNORM, PT_QKV, PT_ATTN, PT_SUBLN, PT_FINAL };

__global__ void __launch_bounds__(512, 2) mega(Args a_kernarg) {
  extern __shared__ __attribute__((aligned(16))) unsigned char lds[];
  cg::grid_group grid = cg::this_grid();
  const AP a0 = (AP)__builtin_amdgcn_kernarg_segment_ptr();
  const int ph_lo = a0->ph_lo, ph_hi = a0->ph_hi;
  for (int ph = ph_lo; ph < ph_hi; ++ph) {
    unsigned long long apv = (unsigned long long)a0; asm volatile("" : "+s"(apv)); const AP a = (AP)apv;
    unsigned char* ws = a->ws;
    int type = PT_PRO, f = 0; const float* nrm = nullptr;
    const bf16_t* gA = (const bf16_t*)(ws + WS_XN); const bf16_t* gB = nullptr; int gK = DM; const float* rin = a->out; float rscale = 0.5f;
    switch (ph) {
      case 0: type = PT_PRO; break;
      case 1: type = PT_GU; f = 0; break;
      case 2: type = PT_RES; gA = (const bf16_t*)(ws + WS_H); gB = (const bf16_t*)(ws + WS_WD); gK = FF; rin = a->in[0]; break;
      case 3: type = PT_NORM; nrm = a->in[6]; break;
      case 4: type = PT_IN; break;
      case 5: type = PT_CONV; break;
      case 6: type = PT_SCAN; break;
      case 7: type = PT_GNORM; break;
      case 8: type = PT_RES; gB = (const bf16_t*)(ws + WS_WOUT); rscale = 1.f; break;
      case 9: type = PT_NORM; nrm = a->in[7]; break;
      case 10: type = PT_GU; f = 1; break;
      case 11: type = PT_RES; gA = (const bf16_t*)(ws + WS_H); gB = (const bf16_t*)(ws + WS_WD + 1 * SZ_D); gK = FF; break;
      case 12: type = PT_NORM; nrm = a->in[2] + DM; break;
      case 13: type = PT_GU; f = 2; break;
      case 14: type = PT_RES; gA = (const bf16_t*)(ws + WS_H); gB = (const bf16_t*)(ws + WS_WD + 2 * SZ_D); gK = FF; break;
      case 15: type = PT_NORM; nrm = a->in[6] + DM; break;
      case 16: type = PT_QKV; break;
      case 17: type = PT_ATTN; break;
      case 18: type = PT_SUBLN; break;
      case 19: type = PT_RES; gB = (const bf16_t*)(ws + WS_WO); rscale = 1.f; break;
      case 20: type = PT_NORM; nrm = a->in[7] + DM; break;
      case 21: type = PT_GU; f = 3; break;
      case 22: type = PT_RES; gA = (const bf16_t*)(ws + WS_H); gB = (const bf16_t*)(ws + WS_WD + 3 * SZ_D); gK = FF; break;
      default: type = PT_FINAL; break;
    }
    pg8::StaticOrder S;
#ifndef MK_ENABLE
#define MK_ENABLE 0xFFFF
#endif
    if (!((MK_ENABLE >> type) & 1)) continue;
    switch (type) {
      case PT_PRO: prologue(a, lds); break;
      case PT_GU: { pg8::Gemm g{(const bf16_t*)(ws + WS_XN), (const bf16_t*)(ws + WS_WGU + (size_t)f * SZ_GU), T, 2 * FF, DM}; S.init(T, 2 * FF, gridDim.x, blockIdx.x);
        EpiSwiglu E{(bf16_t*)(ws + WS_H)}; pg8::gemm_phase<EpiSwiglu, pg8::StaticOrder>((PG8_LAS unsigned char*)lds, g, S, E, nullptr); } break;
      case PT_RES: { pg8::Gemm g{gA, gB, T, DM, gK}; S.init(T, DM, gridDim.x, blockIdx.x);
        EpiResid E{rin, a->out, rscale}; pg8::gemm_phase<EpiResid, pg8::StaticOrder>((PG8_LAS unsigned char*)lds, g, S, E, nullptr); } break;
      case PT_NORM: rmsnorm_phase<false>(a->out, nrm, ws + WS_XN); break;
      case PT_IN: { pg8::Gemm g{(const bf16_t*)(ws + WS_XN), (const bf16_t*)(ws + WS_WIN), T, NIN, DM}; S.init(T, NIN, gridDim.x, blockIdx.x);
        EpiP E{(bf16_t*)(ws + WS_H), (float*)(ws + WS_BA)}; pg8::gemm_phase<EpiP, pg8::StaticOrder>((PG8_LAS unsigned char*)lds, g, S, E, nullptr); } break;
      case PT_CONV: conv_module(a, lds); dn_prep(a); break;
      case PT_SCAN: scan_phase(a, lds); break;
      case PT_GNORM: gnorm_phase(a); break;
      case PT_QKV: { pg8::Gemm g{(const bf16_t*)(ws + WS_XN), (const bf16_t*)(ws + WS_WQKV), T, NQKV, DM}; S.init(T, NQKV, gridDim.x, blockIdx.x);
        EpiQKV E{(bf16_t*)(ws + WS_H), (const float*)(ws + WS_ROPE)}; pg8::gemm_phase<EpiQKV, pg8::StaticOrder>((PG8_LAS unsigned char*)lds, g, S, E, nullptr); } break;
      case PT_ATTN: attn_phase(a, lds); break;
      case PT_SUBLN: subln_phase(a); break;
      default: rmsnorm_phase<true>(a->out, a->in[28], a->out); break;
    }
    if (ph + 1 < ph_hi) grid.sync();
  }
}
}

#ifndef MK_MULTI
#define MK_MULTI 1
#endif
extern "C" void kernel_launch(void* const* d_in, const int* in_sizes, int n_in, void* d_out, int out_size, void* d_ws, size_t ws_size, hipStream_t stream) {
  static int grid = 0;
  if (grid == 0) {
    if (n_in != 29 || out_size != mk::T * mk::DM || ws_size < mk::WS_END) { fprintf(stderr, "kernel_launch: unexpected shapes n_in %d out %d ws %zu (need %zu)\n", n_in, out_size, ws_size, (size_t)mk::WS_END); grid = -1; return; }
    int dev = 0, cus = 0, per_cu = 0;
    hipGetDevice(&dev); hipDeviceGetAttribute(&cus, hipDeviceAttributeMultiprocessorCount, dev);
    if (hipFuncSetAttribute((const void*)mk::mega, hipFuncAttributeMaxDynamicSharedMemorySize, mk::LDS_BYTES) != hipSuccess) { fprintf(stderr, "kernel_launch: hipFuncSetAttribute failed\n"); grid = -1; return; }
    hipOccupancyMaxActiveBlocksPerMultiprocessor(&per_cu, (const void*)mk::mega, 512, mk::LDS_BYTES);
    if (per_cu < 1) per_cu = 1;
    grid = cus * per_cu;
    (void)hipGetLastError();
  }
  if (grid < 0) return;
  mk::Args a{};
  for (int i = 0; i < 29; ++i) a.in[i] = (const float*)d_in[i];
  a.out = (float*)d_out; a.ws = (unsigned char*)d_ws;
#if MK_MULTI
  for (int ph = 0; ph < mk::NPHASE; ++ph) { a.ph_lo = ph; a.ph_hi = ph + 1; hipLaunchKernelGGL(mk::mega, dim3(grid), dim3(512), mk::LDS_BYTES, stream, a); }
#else
  a.ph_lo = 0; a.ph_hi = mk::NPHASE;
  void* args[] = {&a};
  hipError_t e = hipLaunchCooperativeKernel((const void*)mk::mega, dim3(grid), dim3(512), args, mk::LDS_BYTES, stream);
  if (e != hipSuccess) fprintf(stderr, "cooperative launch failed: %s (grid %d)\n", hipGetErrorString(e), grid);
#endif
}
```

```cpp
#include <hip/hip_runtime.h>
#include <hip/hip_cooperative_groups.h>
#include <cstdio>
#include <cstdint>
namespace cg = cooperative_groups;
__device__ __forceinline__ int tidx() { int t = threadIdx.x; asm volatile("" : "+v"(t)); return t; }
namespace pg8 {
#define PG8_LAS __attribute__((address_space(3)))
typedef unsigned short bf16_t;
typedef short bf16x8 __attribute__((ext_vector_type(8)));
typedef float f32x4 __attribute__((ext_vector_type(4)));
typedef unsigned u32x4 __attribute__((ext_vector_type(4)));
constexpr int BM = 256, BK = 64, HALF = 128, HTB = HALF * BK * 2  , STAGE_BYTES = 8 * HTB, NXCD = 8, WGM = 4;

__host__ __device__ __forceinline__ int lds_byte(int r, int c) { const int st = (r >> 4) * 2 + (c >> 5), rr = r & 15, cc = c & 31, ob = rr * 64 + cc * 2; return st * 1024 + (ob ^ (((ob >> 9) & 1) << 5)); }
__host__ __device__ __forceinline__ void stage_rc(int b, int& R, int& C) { const int st = b / 1024, sb = b % 1024, swz = sb ^ (((sb >> 9) & 1) << 5); R = (st >> 1) * 16 + swz / 64; C = (st & 1) * 32 + (swz % 64) / 2; }
__host__ __device__ __forceinline__ int perm32(int rho) { const int n = rho >> 4, i = rho & 15; return 8 * (i >> 2) + 4 * n + (i & 3); }
struct Unit { int pm, pn; };
struct Gemm { const bf16_t* A; const bf16_t* Bt; int M, N, K; };

struct StaticOrder {
    int nM, nN, nwg, G, c;
    __host__ __device__ void init(int M, int N, int G_, int c_) { nM = M / BM; nN = N / BM; nwg = nM * nN; G = G_; c = c_; }
    __host__ __device__ bool next(int i, Unit& u) const {
        const long L = (long)i * G + c; if (L >= nwg) return false;
        int wgid = (int)L; { const int q = nwg / NXCD, r = nwg % NXCD, xcd = wgid % NXCD, off = wgid / NXCD; wgid = (xcd < r ? xcd * (q + 1) : r * (q + 1) + (xcd - r) * q) + off; }
        const int nig = WGM * nN, gid = wgid / nig, fm = gid * WGM, gsz = (nM - fm) < WGM ? (nM - fm) : WGM;
        u.pm = fm + ((wgid % nig) % gsz); u.pn = (wgid % nig) / gsz; return true;
    }
    __device__ __forceinline__ void a_ready(const Unit&) const {}
    __device__ __forceinline__ void done(const Unit&) const {}
};
__device__ __forceinline__ unsigned cvt_pk_bf16(float lo, float hi) { unsigned r; asm volatile("v_cvt_pk_bf16_f32 %0, %1, %2" : "=v"(r) : "v"(lo), "v"(hi)); return r; }
template <class Epi, class Sched, bool STAMP = false>
__device__ __forceinline__ void gemm_phase(PG8_LAS unsigned char* lds, const Gemm g, const Sched& S, const Epi& E, unsigned long long* stamps) {
    const int tid = tidx(), wid = __builtin_amdgcn_readfirstlane(tid >> 6), lane = tid & 63, wr = wid >> 2, wc = wid & 3, fr = lane & 15, fq = lane >> 4;
    const int K = g.K, nt = K / BK;
    int ts_lo = 0, ts_hi = 0, nts = 0; const unsigned long long rt_entry = STAMP ? (unsigned long long)wall_clock64() : 0ull;
#define PG8_STAMP() do { if (STAMP && wid == 0 && nts < 64) { const unsigned long long _c = (unsigned long long)clock64(); \
        ts_lo = (lane == nts) ? (int)(unsigned)_c : ts_lo; ts_hi = (lane == nts) ? (int)(unsigned)(_c >> 32) : ts_hi; ++nts; } } while (0)
    PG8_STAMP();
    unsigned voffA[2], voffB[2];
#pragma unroll
    for (int i = 0; i < 2; ++i) { int R, C; stage_rc(tid * 16 + i * 8192, R, C); const int Rb = Epi::PERM ? ((R & ~31) + perm32(R & 31)) : R;
        voffA[i] = (unsigned)(R * K + C) * 2u; voffB[i] = (unsigned)(Rb * K + C) * 2u; }
    const size_t kstep = (size_t)(BK * 2);
    const size_t hstep = (size_t)HALF * K * 2;
    const size_t tstep = 2 * hstep;
    const unsigned ldsw = (unsigned)wid * 1024u;
    const int aoff = lds_byte(wr * 64 + fr, fq * 8), boff = lds_byte(wc * 32 + fr, fq * 8);
#define PG8_SA(b, h) (((b) * 2 + (h)) * HTB)
#define PG8_SB(b, h) ((4 + (b) * 2 + (h)) * HTB)
#define PG8_STAGE(bufoff, gbase, voff) do { _Pragma("unroll") for (int _i = 0; _i < 2; ++_i) \
        __builtin_amdgcn_global_load_lds((const unsigned*)((const char*)(gbase) + (voff)[_i]), (PG8_LAS unsigned*)(lds + (bufoff) + ldsw + _i * 8192), 16, 0, 0); } while (0)
#define PG8_LDA(dst, b, h) do { _Pragma("unroll") for (int m = 0; m < 4; ++m) _Pragma("unroll") for (int k = 0; k < 2; ++k) dst[m][k] = *(const PG8_LAS bf16x8*)(lds + PG8_SA(b, h) + aoff + m * 2048 + k * 1024); } while (0)
#define PG8_LDB(dst, b, h) do { _Pragma("unroll") for (int n = 0; n < 2; ++n) _Pragma("unroll") for (int k = 0; k < 2; ++k) dst[n][k] = *(const PG8_LAS bf16x8*)(lds + PG8_SB(b, h) + boff + n * 2048 + k * 1024); } while (0)
#define PG8_MMA(ai, bj, At, Bt) do { __builtin_amdgcn_s_setprio(1); _Pragma("unroll") for (int m = 0; m < 4; ++m) _Pragma("unroll") for (int n = 0; n < 2; ++n) _Pragma("unroll") for (int k = 0; k < 2; ++k) \
        acc[ai][bj][m][n] = __builtin_amdgcn_mfma_f32_16x16x32_bf16(Bt[n][k], At[m][k], acc[ai][bj][m][n], 0, 0, 0); __builtin_amdgcn_s_setprio(0); } while (0)
#define PG8_WAIT_V(n) asm volatile("s_waitcnt vmcnt(" #n ")" ::: "memory")
#define PG8_WAIT_L(n) asm volatile("s_waitcnt lgkmcnt(" #n ")" ::: "memory")
#define PG8_BAR __builtin_amdgcn_s_barrier()
#define PG8_SCHED __builtin_amdgcn_sched_barrier(0)
    Unit cur, nxt; int ui = 0;
    if (!S.next(0, cur)) return;
    f32x4 acc[2][2][4][2];
#pragma unroll
    for (int a = 0; a < 2; ++a)
#pragma unroll
        for (int b = 0; b < 2; ++b)
#pragma unroll
            for (int m = 0; m < 4; ++m)
#pragma unroll
                for (int n = 0; n < 2; ++n) acc[a][b][m][n] = (f32x4){0.f, 0.f, 0.f, 0.f};
    bf16x8 At[4][2], B0[2][2], B1[2][2];
    const char* cA = (const char*)g.A + (size_t)cur.pm * tstep; const char* cB = (const char*)g.Bt + (size_t)cur.pn * tstep;
    S.a_ready(cur);
    PG8_STAGE(PG8_SB(0, 0), cB, voffB); PG8_STAGE(PG8_SA(0, 0), cA, voffA); PG8_STAGE(PG8_SB(0, 1), cB + hstep, voffB); PG8_STAGE(PG8_SA(0, 1), cA + hstep, voffA);
    if (wr == 1) PG8_BAR;
    PG8_WAIT_V(4); PG8_BAR;
    PG8_STAGE(PG8_SB(1, 0), cB + kstep, voffB); PG8_STAGE(PG8_SA(1, 0), cA + kstep, voffA); PG8_STAGE(PG8_SB(1, 1), cB + hstep + kstep, voffB);
    PG8_WAIT_V(6); PG8_BAR;
    PG8_STAMP();
    for (;;) {
        const bool has_next = S.next(ui + 1, nxt);
        const char* nA = has_next ? (const char*)g.A + (size_t)nxt.pm * tstep : cA; const char* nB = has_next ? (const char*)g.Bt + (size_t)nxt.pn * tstep : cB;
        for (int t = 0; t < nt; t += 2) {
            const bool last = (t == nt - 2);
            const char* a1 = cA + (size_t)(t + 1) * kstep;
            const char* a2 = last ? nA : cA + (size_t)(t + 2) * kstep; const char* b2 = last ? nB : cB + (size_t)(t + 2) * kstep;
            const char* a3 = a2 + kstep; const char* b3 = b2 + kstep;
            if (last && has_next) S.a_ready(nxt);
            PG8_LDB(B0, 0, 0); PG8_SCHED; PG8_LDA(At, 0, 0); PG8_STAGE(PG8_SA(1, 1), a1 + hstep, voffA);
            PG8_WAIT_L(8); PG8_BAR; PG8_WAIT_L(0); PG8_MMA(0, 0, At, B0); PG8_BAR; PG8_SCHED;
            PG8_LDB(B1, 0, 1); PG8_STAGE(PG8_SB(0, 0), b2, voffB);
            PG8_BAR; PG8_WAIT_L(0); PG8_MMA(0, 1, At, B1); PG8_BAR;
            PG8_LDA(At, 0, 1); PG8_STAGE(PG8_SA(0, 0), a2, voffA);
            PG8_BAR; PG8_WAIT_L(0); PG8_MMA(1, 0, At, B0); PG8_BAR; PG8_SCHED;
            PG8_STAGE(PG8_SB(0, 1), b2 + hstep, voffB);
            PG8_WAIT_V(6); PG8_BAR; PG8_MMA(1, 1, At, B1); PG8_BAR;
            PG8_LDB(B0, 1, 0); PG8_SCHED; PG8_LDA(At, 1, 0); PG8_STAGE(PG8_SA(0, 1), a2 + hstep, voffA);
            PG8_WAIT_L(8); PG8_BAR; PG8_WAIT_L(0); PG8_MMA(0, 0, At, B0); PG8_BAR; PG8_SCHED;
            PG8_LDB(B1, 1, 1); PG8_STAGE(PG8_SB(1, 0), b3, voffB);
            PG8_BAR; PG8_WAIT_L(0); PG8_MMA(0, 1, At, B1); PG8_BAR;
            PG8_LDA(At, 1, 1); PG8_STAGE(PG8_SA(1, 0), a3, voffA);
            PG8_BAR; PG8_WAIT_L(0); PG8_MMA(1, 0, At, B0); PG8_BAR; PG8_SCHED;
            PG8_STAGE(PG8_SB(1, 1), b3 + hstep, voffB);
            PG8_WAIT_V(6); PG8_BAR; PG8_MMA(1, 1, At, B1); PG8_BAR;
        }
        PG8_STAMP();
        if constexpr (!Epi::AFTER_DRAIN) { E(acc, cur, wr, wc, fr, fq); S.done(cur); }
        PG8_STAMP();
        if (!has_next) break;
#pragma unroll
        for (int a = 0; a < 2; ++a)
#pragma unroll
            for (int b = 0; b < 2; ++b)
#pragma unroll
                for (int m = 0; m < 4; ++m)
#pragma unroll
                    for (int n = 0; n < 2; ++n) acc[a][b][m][n] = (f32x4){0.f, 0.f, 0.f, 0.f};
        cur = nxt; cA = nA; cB = nB; ++ui;
    }
    PG8_WAIT_V(0);
    if (wr == 0) PG8_BAR;
    PG8_BAR;
    if constexpr (Epi::AFTER_DRAIN) { E.fused(acc, cur, wr, wc, fr, fq, lds, wid, lane); S.done(cur); }
    PG8_STAMP();
    if (STAMP && wid == 0) { stamps[lane] = lane < nts ? (((unsigned long long)(unsigned)ts_hi << 32) | (unsigned)ts_lo) : 0ull;
        if (lane == 62) stamps[62] = rt_entry; if (lane == 63) stamps[63] = (unsigned long long)wall_clock64(); }
#undef PG8_STAMP
#undef PG8_SA
#undef PG8_SB
#undef PG8_STAGE
#undef PG8_LDA
#undef PG8_LDB
#undef PG8_MMA
#undef PG8_WAIT_V
#undef PG8_WAIT_L
#undef PG8_BAR
#undef PG8_SCHED
}
}

namespace att {
using bf16 = unsigned short;
constexpr int   D = 128, NW = 8, QBLK = 32, KVBLK = 64;
constexpr float SCALE = 0.088388347648318440f;
constexpr float THR = 8.f;
constexpr int SDEPTH = 2;
constexpr int LDQ = 6144, LDK = 6144, LDO = 2048;
constexpr size_t SHM_V = KVBLK * D * 2, SHM_K = KVBLK * D * 2, SHM_ATTN = 2 * SHM_V + 2 * SHM_K + NW * 64 * 4;
using bf16x8 = __attribute__((ext_vector_type(8))) short;
using s16x4  = __attribute__((ext_vector_type(4))) short;
using f32x16 = __attribute__((ext_vector_type(16))) float;
using f32x8  = __attribute__((ext_vector_type(8))) float;
using u32x4  = __attribute__((ext_vector_type(4))) unsigned;
#define KSWZ(row, colB) ((row) * 256 + ((colB) ^ (((row) & 7) << 4)))
#define SBAR() __builtin_amdgcn_sched_barrier(0)
__device__ __forceinline__ int crow(int r, int hi) { return (r & 3) + 8 * (r >> 2) + 4 * hi; }
__device__ __forceinline__ unsigned cvtpk(float lo, float hi) {
  unsigned r; asm volatile("v_cvt_pk_bf16_f32 %0, %1, %2" : "=v"(r) : "v"(lo), "v"(hi)); return r;
}
template <typename TIn> struct Stage;
template <> struct Stage<bf16>  { using T = bf16x8;
  __device__ static __forceinline__ T ld8(const bf16* p) { return *reinterpret_cast<const bf16x8*>(p); }
  __device__ static __forceinline__ bf16x8 tobf(T x) { return x; } };
template <> struct Stage<float> { using T = f32x8;
  __device__ static __forceinline__ T ld8(const float* p) { return *reinterpret_cast<const f32x8*>(p); }
  __device__ static __forceinline__ bf16x8 tobf(T x) {
    u32x4 w = {cvtpk(x[0], x[1]), cvtpk(x[2], x[3]), cvtpk(x[4], x[5]), cvtpk(x[6], x[7])}; return *reinterpret_cast<bf16x8*>(&w); } };

__device__ __forceinline__ void partialSM(f32x16& p0, f32x16& p1, float& m_reg, float& mn, float& alpha) {
  constexpr float C = SCALE * 1.4426950408889634f;
  float pmax = p0[0]; for (int r = 1; r < 16; ++r) pmax = fmaxf(pmax, p0[r]); for (int r = 0; r < 16; ++r) pmax = fmaxf(pmax, p1[r]);
  { auto rr = __builtin_amdgcn_permlane32_swap(__float_as_uint(pmax), __float_as_uint(pmax), false, false);
    pmax = fmaxf(__uint_as_float(rr[0]), __uint_as_float(rr[1])); }
  if (__builtin_expect(__all(pmax - m_reg <= THR / SCALE), 1)) { mn = m_reg; alpha = 1.f; }
  else { mn = fmaxf(m_reg, pmax); alpha = __builtin_amdgcn_exp2f((m_reg - mn) * C); m_reg = mn; }
  float mnC = -mn * C;
  for (int r = 0; r < 16; ++r) p0[r] = fmaf(p0[r], C, mnC); for (int r = 0; r < 16; ++r) p1[r] = fmaf(p1[r], C, mnC);
  for (int r = 0; r < 16; ++r) p0[r] = __builtin_amdgcn_exp2f(p0[r]);
}
__device__ __forceinline__ void finishSM(f32x16& p0, f32x16& p1, float alpha, float& l_reg, bf16x8& pa0, bf16x8& pa1, bf16x8& pa2, bf16x8& pa3) {
  for (int r = 0; r < 16; ++r) p1[r] = __builtin_amdgcn_exp2f(p1[r]);
  float ps = 0; for (int r = 0; r < 16; ++r) ps += p0[r]; for (int r = 0; r < 16; ++r) ps += p1[r];
  { auto rr = __builtin_amdgcn_permlane32_swap(__float_as_uint(ps), __float_as_uint(ps), false, false);
    ps = __uint_as_float(rr[0]) + __uint_as_float(rr[1]); }
  l_reg = l_reg * alpha + ps;
#define PK4(P, BASE, OUT) do { unsigned a0 = cvtpk(P[BASE + 0], P[BASE + 1]), a1 = cvtpk(P[BASE + 2], P[BASE + 3]);   \
    unsigned b0 = cvtpk(P[BASE + 4], P[BASE + 5]), b1 = cvtpk(P[BASE + 6], P[BASE + 7]);                              \
    auto r0 = __builtin_amdgcn_permlane32_swap(a0, b0, false, false); auto r1 = __builtin_amdgcn_permlane32_swap(a1, b1, false, false); \
    u32x4 w = {r0[0], r1[0], r0[1], r1[1]}; OUT = *reinterpret_cast<bf16x8*>(&w); } while (0)
  PK4(p0, 0, pa0); PK4(p0, 8, pa1); PK4(p1, 0, pa2); PK4(p1, 8, pa3);
#undef PK4
}
__device__ __forceinline__ void qkt(f32x16& p0, f32x16& p1, const bf16* Ks, const bf16x8* qr, int r32, int hi) {
  p0 = f32x16{}; p1 = f32x16{};
  for (int d0 = 0; d0 < 8; ++d0) { int cb = (d0 * 16 + hi * 8) * 2;
    bf16x8 b0 = *reinterpret_cast<const bf16x8*>((const char*)Ks + KSWZ(r32, cb));
    bf16x8 b1 = *reinterpret_cast<const bf16x8*>((const char*)Ks + KSWZ(32 + r32, cb));
    p0 = __builtin_amdgcn_mfma_f32_32x32x16_bf16(b0, qr[d0], p0, 0, 0, 0);
    p1 = __builtin_amdgcn_mfma_f32_32x32x16_bf16(b1, qr[d0], p1, 0, 0, 0); }
}
__device__ __forceinline__ int v_st(int k, int c) { const int kk = (k & ~0xC) | ((k & 4) << 1) | ((k & 8) >> 1); return ((kk >> 3) * 4 + (c >> 5)) * 512 + ((kk & 7) * 32 + (c & 31)) * 2; }
__device__ __forceinline__ int v_rd_base(int lane) { return ((lane & 3) << 3) | (((lane >> 2) & 3) << 6) | (((lane >> 4) & 1) << 5) | (((lane >> 5) & 1) << 8); }
constexpr int v_rd_off(int d0, int ks, int half) { return d0 * 512 + ks * 4096 + half * 2048; }
template <int OFF> __device__ __forceinline__ s16x4 tr_read(int vb) {
  s16x4 r; asm volatile("ds_read_b64_tr_b16 %0, %1 offset:%2" : "=&v"(r) : "v"(vb), "i"(OFF) : "memory"); return r;
}
template <int D0> __device__ __forceinline__ void pv_one(f32x16& od, int vb, bf16x8 pa0, bf16x8 pa1, bf16x8 pa2, bf16x8 pa3) {
  const s16x4 l0 = tr_read<v_rd_off(D0, 0, 0)>(vb), h0 = tr_read<v_rd_off(D0, 0, 1)>(vb), l1 = tr_read<v_rd_off(D0, 1, 0)>(vb), h1 = tr_read<v_rd_off(D0, 1, 1)>(vb);
  const s16x4 l2 = tr_read<v_rd_off(D0, 2, 0)>(vb), h2 = tr_read<v_rd_off(D0, 2, 1)>(vb), l3 = tr_read<v_rd_off(D0, 3, 0)>(vb), h3 = tr_read<v_rd_off(D0, 3, 1)>(vb);
  asm volatile("s_waitcnt lgkmcnt(0)" ::: "memory"); SBAR();
#define PK(L, H) (bf16x8){L[0], L[1], L[2], L[3], H[0], H[1], H[2], H[3]}
  od = __builtin_amdgcn_mfma_f32_32x32x16_bf16(pa0, PK(l0, h0), od, 0, 0, 0);
  od = __builtin_amdgcn_mfma_f32_32x32x16_bf16(pa1, PK(l1, h1), od, 0, 0, 0);
  od = __builtin_amdgcn_mfma_f32_32x32x16_bf16(pa2, PK(l2, h2), od, 0, 0, 0);
  od = __builtin_amdgcn_mfma_f32_32x32x16_bf16(pa3, PK(l3, h3), od, 0, 0, 0);
#undef PK
}
__device__ __forceinline__ void pv_d0(f32x16* o, int vb, bf16x8 pa0, bf16x8 pa1, bf16x8 pa2, bf16x8 pa3) {
  pv_one<0>(o[0], vb, pa0, pa1, pa2, pa3); pv_one<1>(o[1], vb, pa0, pa1, pa2, pa3); pv_one<2>(o[2], vb, pa0, pa1, pa2, pa3); pv_one<3>(o[3], vb, pa0, pa1, pa2, pa3);
}

template <typename TQ>
__device__ __forceinline__ void attn_dense_body(const TQ* __restrict__ Qb, const bf16* __restrict__ Kh, const bf16* __restrict__ Vh,
                                                float* __restrict__ Ob, int seq, char* lds, int mode, float lam, unsigned short* o1buf) {
  using St = Stage<bf16>; using SQ = Stage<TQ>;
  const int tid = tidx(), wid = tid >> 6, lane = tid & 63, r32 = lane & 31, hi = lane >> 5;
  bf16* V_lds = (bf16*)lds; bf16* K_lds = (bf16*)(lds + 2 * SHM_V);
  float* ws = (float*)(lds + 2 * SHM_V + 2 * SHM_K) + wid * 64; float* li_l = ws; float* al_l = ws + 32;
  float m_reg = -1e30f, l_reg = 0; f32x16 o[4] = {}; bf16x8 qr[8];
  const TQ* Qw = Qb + (long)(wid * QBLK + r32) * LDQ + hi * 8;
#pragma unroll
  for (int d0 = 0; d0 < 8; ++d0) qr[d0] = SQ::tobf(SQ::ld8(Qw + d0 * 16));
  const int sr = tid >> 4, sc = (tid & 15) * 8, vst0 = v_st(sr, sc), vst1 = v_st(32 + sr, sc);
  const int vb0 = (int)(uintptr_t)V_lds + v_rd_base(lane);
  struct { typename St::T vs0, vs1, ks0, ks1; } sr_[SDEPTH];
#define SLOAD(i, k0) do { sr_[i].vs0 = St::ld8(&Vh[(long)((k0) + sr) * LDK + sc]); sr_[i].vs1 = St::ld8(&Vh[(long)((k0) + 32 + sr) * LDK + sc]); \
    sr_[i].ks0 = St::ld8(&Kh[(long)((k0) + sr) * LDK + sc]); sr_[i].ks1 = St::ld8(&Kh[(long)((k0) + 32 + sr) * LDK + sc]); } while (0)
#define SWRITE(b, i) do { *(bf16x8*)((char*)V_lds + (b) * SHM_V + vst0) = St::tobf(sr_[i].vs0);          \
    *(bf16x8*)((char*)V_lds + (b) * SHM_V + vst1) = St::tobf(sr_[i].vs1); int kc = sc * 2;               \
    *(bf16x8*)((char*)K_lds + (b) * SHM_K + KSWZ(sr, kc)) = St::tobf(sr_[i].ks0);                       \
    *(bf16x8*)((char*)K_lds + (b) * SHM_K + KSWZ(32 + sr, kc)) = St::tobf(sr_[i].ks1); } while (0)
#define SWAIT() do { if constexpr (SDEPTH == 2) asm volatile("s_waitcnt vmcnt(4)" ::: "memory"); else asm volatile("s_waitcnt vmcnt(0)" ::: "memory"); } while (0)
#define RESC(a) do { if (__any((a) < 1.f)) { if (hi == 0) al_l[r32] = (a); asm volatile("s_waitcnt lgkmcnt(0)" ::: "memory"); \
    for (int d = 0; d < 4; ++d) for (int r = 0; r < 16; ++r) o[d][r] *= al_l[crow(r, hi)]; } } while (0)
  f32x16 pA0, pA1, pB0, pB1; float mnA, mnB, alA, alB; bf16x8 pa0, pa1, pa2, pa3; const int NT = seq / KVBLK;
  constexpr int SE = 0, SO = SDEPTH - 1;
  SLOAD(SE, 0); asm volatile("s_waitcnt vmcnt(0)" ::: "memory"); SWRITE(0, SE); __syncthreads();
  qkt(pA0, pA1, K_lds, qr, r32, hi); partialSM(pA0, pA1, m_reg, mnA, alA);
  SLOAD(SO, KVBLK); if constexpr (SDEPTH == 2) { if (2 < NT) SLOAD(SE, 2 * KVBLK); }
  SWAIT(); SWRITE(1, SO); __syncthreads();
  for (int j = 1; j + 1 < NT; j += 2) {
    SBAR(); qkt(pB0, pB1, (bf16*)((char*)K_lds + SHM_K), qr, r32, hi);
    finishSM(pA0, pA1, alA, l_reg, pa0, pa1, pa2, pa3); SBAR();
    SLOAD(SO, (j + SDEPTH) * KVBLK); SBAR();
    pv_d0(o, vb0, pa0, pa1, pa2, pa3); partialSM(pB0, pB1, m_reg, mnB, alB);
    __syncthreads(); SWAIT(); SWRITE(0, SE);
    RESC(alB); __syncthreads();
    SBAR(); qkt(pA0, pA1, K_lds, qr, r32, hi);
    finishSM(pB0, pB1, alB, l_reg, pa0, pa1, pa2, pa3); SBAR();
    if (SDEPTH == 1 || j + 3 < NT) SLOAD(SE, (j + 1 + SDEPTH) * KVBLK); SBAR();
    pv_d0(o, vb0 + (int)SHM_V, pa0, pa1, pa2, pa3); partialSM(pA0, pA1, m_reg, mnA, alA);
    __syncthreads(); SWAIT(); SWRITE(1, SO);
    RESC(alA); __syncthreads();
  }
  SBAR(); qkt(pB0, pB1, (bf16*)((char*)K_lds + SHM_K), qr, r32, hi);
  finishSM(pA0, pA1, alA, l_reg, pa0, pa1, pa2, pa3); SBAR();
  pv_d0(o, vb0, pa0, pa1, pa2, pa3); partialSM(pB0, pB1, m_reg, mnB, alB);
  __syncthreads(); RESC(alB);
  finishSM(pB0, pB1, alB, l_reg, pa0, pa1, pa2, pa3); SBAR();
  pv_d0(o, vb0 + (int)SHM_V, pa0, pa1, pa2, pa3);
  if (hi == 0) li_l[r32] = l_reg; asm volatile("s_waitcnt lgkmcnt(0)" ::: "memory");
  float rli[16];
#pragma unroll
  for (int r = 0; r < 16; ++r) rli[r] = __builtin_amdgcn_rcpf(li_l[crow(r, hi)]);
  float* Ow = Ob + (long)(wid * QBLK) * LDO;
#pragma unroll
  for (int r = 0; r < 16; ++r) { int orow = crow(r, hi);
    for (int d0 = 0; d0 < 4; ++d0) { const float val = o[d0][r] * rli[r]; unsigned short* lp = o1buf + (wid * QBLK + orow) * 128 + d0 * 32 + r32;
      if (mode == 0) { *lp = (unsigned short)(cvtpk(val, val) & 0xffffu); } else { Ow[(long)orow * LDO + d0 * 32 + r32] = __uint_as_float(((unsigned)*lp) << 16) - lam * val; } } }
#undef SLOAD
#undef SWRITE
#undef SWAIT
#undef RESC
}

#undef KSWZ
#undef SBAR
}
#ifndef MK_NO_HELPER
#define MK_NO_HELPER 0
#endif
namespace mk {
using pg8::bf16_t; using pg8::f32x4; using pg8::u32x4; using pg8::cvt_pk_bf16; using pg8::Unit;
typedef unsigned u32x2 __attribute__((ext_vector_type(2)));
typedef float f32x2 __attribute__((ext_vector_type(2)));
constexpr int T = 16384, DM = 2048, FF = 5632, SEQ = 4096;
constexpr int NIN_REAL = 6176, NIN = 6400, NQKV = 6144;
constexpr int LDS_BYTES = 155648;
constexpr float EPS = 1e-6f;
constexpr float LAMBDA_INIT = 0.35550906759096924f;
#ifdef MK_DUP_PH
constexpr int NPHASE = 20;
#else
constexpr int NPHASE = 19;
#endif

constexpr size_t SZ_SMALL = (size_t)T * 32 * 4;
constexpr size_t SZ_GU = (size_t)2 * FF * DM * 2, SZ_D = (size_t)DM * FF * 2;
constexpr size_t WS_ROPE = 0, WS_BA = WS_ROPE + SZ_SMALL, WS_BG = WS_BA + SZ_SMALL;
constexpr size_t WS_SS = WS_BG + SZ_SMALL;
constexpr size_t WS_WGU = WS_SS + (size_t)1024 * 1024, WS_WD = WS_WGU + 4 * SZ_GU;
typedef unsigned long long u64;
constexpr float SSQ = 1048576.f, SSQ_INV = 1.f / 1048576.f;
constexpr size_t WS_WIN = WS_WD + 4 * SZ_D, WS_WOUT = WS_WIN + (size_t)NIN * DM * 2;
constexpr size_t WS_WQKV = WS_WOUT + (size_t)DM * DM * 2, WS_WO = WS_WQKV + (size_t)NQKV * DM * 2;
constexpr size_t WS_XN = WS_WO + (size_t)DM * DM * 2;
constexpr size_t WS_H = WS_XN + (size_t)T * DM * 2;
constexpr size_t WS_S = WS_H + (size_t)T * NIN * 2;
constexpr size_t SZ_T1K = (size_t)T * 1024 * 2;
constexpr size_t WS_END = WS_S + 5 * SZ_T1K;

struct Args { const float* in[29]; float* out; unsigned char* ws; int ph_lo, ph_hi; };
typedef const __attribute__((address_space(4))) Args* AP;

__device__ __forceinline__ float bflo(unsigned w) { return __uint_as_float(w << 16); }
__device__ __forceinline__ float bfhi(unsigned w) { return __uint_as_float(w & 0xffff0000u); }
__device__ __forceinline__ float sigm(float x) { return __builtin_amdgcn_rcpf(1.f + __expf(-x)); }
__device__ __forceinline__ float silu(float x) { return x * sigm(x); }
__device__ __forceinline__ float wave_sum(float v) {
#pragma unroll
  for (int m = 32; m >= 1; m >>= 1) v += __shfl_xor(v, m, 64);
  return v;
}

template <int CTRL> __device__ __forceinline__ float dpp_mov(float v) { return __int_as_float(__builtin_amdgcn_update_dpp(0, __float_as_int(v), CTRL, 0xF, 0xF, true)); }
__device__ __forceinline__ float row_sum8(float v) { v += dpp_mov<0xB1>(v); v += dpp_mov<0x4E>(v); v += dpp_mov<0x141>(v); return v; }
__device__ __forceinline__ float row_sum16(float v) { v += dpp_mov<0xB1>(v); v += dpp_mov<0x4E>(v); v += dpp_mov<0x141>(v); v += dpp_mov<0x140>(v); return v; }
__device__ __forceinline__ float dpp_row_bcast_sum4(float v) { float t = v + __shfl_xor(v, 16, 64); return t + __shfl_xor(t, 32, 64) - v; }
#define EPI_PIN() __builtin_amdgcn_sched_barrier(0)
struct EpiSwiglu { static constexpr bool PERM = true, AFTER_DRAIN = false; bf16_t* H; const u64* ss; int dup;
  __device__ __forceinline__ void operator()(const f32x4 (&acc)[2][2][4][2], const Unit& u, int wr, int wc, int fr, int fq) const {
    const int row0 = u.pm * 256 + wr * 64 + fr, col0 = u.pn * 128 + wc * 32 + 8 * fq;
    float rsv[2][4];
#pragma unroll
    for (int ai = 0; ai < 2; ++ai)
#pragma unroll
      for (int m = 0; m < 4; ++m) rsv[ai][m] = (float)ss[row0 + ai * 128 + m * 16] * SSQ_INV;
    EPI_PIN();
#pragma unroll
    for (int ai = 0; ai < 2; ++ai)
#pragma unroll
      for (int m = 0; m < 4; ++m) {
        const float rs = rsqrtf(rsv[ai][m] * (1.f / DM) + EPS);
        const f32x4 g0 = acc[ai][0][m][0] * rs, g1 = acc[ai][0][m][1] * rs, u0 = acc[ai][1][m][0] * rs, u1 = acc[ai][1][m][1] * rs;
        float h[8];
#pragma unroll
        for (int j = 0; j < 4; ++j) { h[j] = silu(g0[j]) * u0[j]; h[4 + j] = silu(g1[j]) * u1[j]; }
        u32x4 w; w[0] = cvt_pk_bf16(h[0], h[1]); w[1] = cvt_pk_bf16(h[2], h[3]); w[2] = cvt_pk_bf16(h[4], h[5]); w[3] = cvt_pk_bf16(h[6], h[7]);
#if MK_PROBE_NOSTORE
        if (!dup || w[0] == 0x12345678u)
#endif
        __builtin_nontemporal_store(w, (u32x4*)(H + (size_t)(row0 + ai * 128 + m * 16) * FF + col0));
      }
  }
};
struct EpiResid { static constexpr bool PERM = false, AFTER_DRAIN = false; AP a; int ph; int dup;
  __device__ __forceinline__ void operator()(const f32x4 (&acc)[2][2][4][2], const Unit& u, int wr, int wc, int fr, int fq) const {
    bf16_t* xb = (bf16_t*)(a->ws + WS_XN); const float* xin = a->in[0];
    const float scale = (ph == 7 || ph == 15) ? 1.f : 0.5f;
    const int nss = (ph == 2) ? 0 : (ph == 7) ? 1 : (ph == 9) ? 2 : (ph == 11) ? 3 : (ph == 15) ? 4 : 6;
    u64* ss = (u64*)(a->ws + WS_SS) + (size_t)nss * T;
    const int row0 = u.pm * 256 + wr * 64 + fr, col0 = u.pn * 256 + wc * 32 + 4 * fq;
#pragma unroll
    for (int ai = 0; ai < 2; ++ai)
#pragma unroll
    for (int mh = 0; mh < 2; ++mh) {
      f32x4 r[2][2][2];
      if (ph == 2) {
#pragma unroll
        for (int m2 = 0; m2 < 2; ++m2)
#pragma unroll
          for (int bj = 0; bj < 2; ++bj)
#pragma unroll
            for (int n = 0; n < 2; ++n) r[m2][bj][n] = *(const f32x4*)(xin + (size_t)(row0 + ai * 128 + (mh * 2 + m2) * 16) * DM + col0 + bj * 128 + n * 16);
      } else {
        u32x2 rb[2][2][2];
#pragma unroll
        for (int m2 = 0; m2 < 2; ++m2)
#pragma unroll
          for (int bj = 0; bj < 2; ++bj)
#pragma unroll
            for (int n = 0; n < 2; ++n) rb[m2][bj][n] = *(const u32x2*)(xb + (size_t)(row0 + ai * 128 + (mh * 2 + m2) * 16) * DM + col0 + bj * 128 + n * 16);
#pragma unroll
        for (int m2 = 0; m2 < 2; ++m2)
#pragma unroll
          for (int bj = 0; bj < 2; ++bj)
#pragma unroll
            for (int n = 0; n < 2; ++n) r[m2][bj][n] = (f32x4){bflo(rb[m2][bj][n][0]), bfhi(rb[m2][bj][n][0]), bflo(rb[m2][bj][n][1]), bfhi(rb[m2][bj][n][1])};
      }
      EPI_PIN();
#pragma unroll
      for (int m2 = 0; m2 < 2; ++m2) {
        const int m = mh * 2 + m2;
        const size_t off = (size_t)(row0 + ai * 128 + m * 16) * DM + col0; float sq = 0.f;
#pragma unroll
        for (int bj = 0; bj < 2; ++bj)
#pragma unroll
          for (int n = 0; n < 2; ++n) { const f32x4 rr = r[m2][bj][n] + acc[ai][bj][m][n] * scale;
            u32x2 w; w[0] = cvt_pk_bf16(rr[0], rr[1]); w[1] = cvt_pk_bf16(rr[2], rr[3]); *(u32x2*)(xb + off + bj * 128 + n * 16) = w;
            const float y0 = bflo(w[0]), y1 = bfhi(w[0]), y2 = bflo(w[1]), y3 = bfhi(w[1]); sq += y0 * y0 + y1 * y1 + y2 * y2 + y3 * y3; }
        sq += dpp_row_bcast_sum4(sq); if (fq == 0) atomicAdd(ss + row0 + ai * 128 + m * 16, (u64)(sq * SSQ + 0.5f));
      }
      EPI_PIN();
    }
  }
};
struct EpiP { static constexpr bool PERM = true, AFTER_DRAIN = false; bf16_t* P; float* BA; const u64* ss;
  __device__ __forceinline__ void operator()(const f32x4 (&acc)[2][2][4][2], const Unit& u, int wr, int wc, int fr, int fq) const {
    const int row0 = u.pm * 256 + wr * 64 + fr, col0 = u.pn * 256 + wc * 32 + 8 * fq;
    float rsv[2][4];
#pragma unroll
    for (int ai = 0; ai < 2; ++ai)
#pragma unroll
      for (int m = 0; m < 4; ++m) rsv[ai][m] = (float)ss[row0 + ai * 128 + m * 16] * SSQ_INV;
    EPI_PIN();
#pragma unroll
    for (int ai = 0; ai < 2; ++ai)
#pragma unroll
      for (int m = 0; m < 4; ++m) {
        const int row = row0 + ai * 128 + m * 16;
        const float rs = rsqrtf(rsv[ai][m] * (1.f / DM) + EPS);
#pragma unroll
        for (int bj = 0; bj < 2; ++bj) {
          const f32x4 a0 = acc[ai][bj][m][0] * rs, a1 = acc[ai][bj][m][1] * rs;
          u32x4 w; w[0] = cvt_pk_bf16(a0[0], a0[1]); w[1] = cvt_pk_bf16(a0[2], a0[3]); w[2] = cvt_pk_bf16(a1[0], a1[1]); w[3] = cvt_pk_bf16(a1[2], a1[3]);
          *(u32x4*)(P + (size_t)row * NIN + col0 + bj * 128) = w;
        }
        if (u.pn == 24 && wc == 0) { *(f32x4*)(BA + (size_t)row * 32 + 8 * fq) = acc[ai][0][m][0] * rs; *(f32x4*)(BA + (size_t)row * 32 + 8 * fq + 4) = acc[ai][0][m][1] * rs; }
      }
  }
};
struct EpiQKV { static constexpr bool PERM = false, AFTER_DRAIN = false; bf16_t* O; const float* rope; const u64* ss;
  __device__ __forceinline__ void operator()(const f32x4 (&acc)[2][2][4][2], const Unit& u, int wr, int wc, int fr, int fq) const {
    const int row0 = u.pm * 256 + wr * 64 + fr, col0 = u.pn * 256 + wc * 32 + 4 * fq;
    const bool rot = (wc == 0) && (u.pn < 16);
    float rsv[2][4];
#pragma unroll
    for (int ai = 0; ai < 2; ++ai)
#pragma unroll
      for (int m = 0; m < 4; ++m) rsv[ai][m] = (float)ss[row0 + ai * 128 + m * 16] * SSQ_INV;
#pragma unroll
    for (int ai = 0; ai < 2; ++ai) {
      f32x4 cv[4], sv[4];
#pragma unroll
      for (int m = 0; m < 4; ++m) { const size_t ro = (size_t)(row0 + ai * 128 + m * 16) * 32 + 4 * fq;
        cv[m] = rot ? *(const f32x4*)(rope + ro) : (f32x4){1.f, 1.f, 1.f, 1.f}; sv[m] = rot ? *(const f32x4*)(rope + ro + 16) : (f32x4){0.f, 0.f, 0.f, 0.f}; }
      EPI_PIN();
#pragma unroll
      for (int m = 0; m < 4; ++m) {
        const int row = row0 + ai * 128 + m * 16;
        const float rs = rsqrtf(rsv[ai][m] * (1.f / DM) + EPS);
#pragma unroll
        for (int bj = 0; bj < 2; ++bj) {
          f32x4 v0 = acc[ai][bj][m][0] * rs, v1 = acc[ai][bj][m][1] * rs;
          const f32x4 n0 = v0 * cv[m] - v1 * sv[m], n1 = v1 * cv[m] + v0 * sv[m];
          u32x2 w0, w1; w0[0] = cvt_pk_bf16(n0[0], n0[1]); w0[1] = cvt_pk_bf16(n0[2], n0[3]); w1[0] = cvt_pk_bf16(n1[0], n1[1]); w1[1] = cvt_pk_bf16(n1[2], n1[3]);
          bf16_t* p = O + (size_t)row * NQKV + col0 + bj * 128;
          *(u32x2*)p = w0; *(u32x2*)(p + 16) = w1;
        }
      }
      EPI_PIN();
    }
  }
};

__device__ __forceinline__ void xpose_mat(const float* __restrict__ W, int K, int N, bf16_t* __restrict__ Wt, int mode, float* tile, const float* __restrict__ gk = nullptr) {
  (void)tile;
  const int lane = tidx() & 63, wid = tidx() >> 6;
  const int nkt = K / 64, ntiles = nkt * (N / 32);
  for (int t = blockIdx.x * 8 + wid; t < ntiles; t += gridDim.x * 8) {
    const int nt = t / nkt, kt = t - nt * nkt, n = nt * 32 + (lane & 31), kb = kt * 64 + (lane >> 5) * 32;
    const float* src = W + (size_t)kb * N + n;
    float v[32];
#pragma unroll
    for (int i = 0; i < 32; ++i) v[i] = src[(size_t)i * N];
    int nd = n; if (mode == 1) nd = (n >> 7) * 256 + (n & 127); else if (mode == 2) nd = (n >> 7) * 256 + 128 + (n & 127);
#pragma unroll
    for (int q = 0; q < 4; ++q) {
      f32x4 g0 = {1.f, 1.f, 1.f, 1.f}, g1 = g0;
      if (gk) { g0 = *(const f32x4*)(gk + kb + 8 * q); g1 = *(const f32x4*)(gk + kb + 8 * q + 4); }
      u32x4 w; w[0] = cvt_pk_bf16(v[8 * q] * g0[0], v[8 * q + 1] * g0[1]); w[1] = cvt_pk_bf16(v[8 * q + 2] * g0[2], v[8 * q + 3] * g0[3]);
      w[2] = cvt_pk_bf16(v[8 * q + 4] * g1[0], v[8 * q + 5] * g1[1]); w[3] = cvt_pk_bf16(v[8 * q + 6] * g1[2], v[8 * q + 7] * g1[3]);
      *(u32x4*)(Wt + (size_t)nd * K + kb + 8 * q) = w;
    }
  }
}

constexpr int HT_FFN = (DM / 64) * (FF / 32);
constexpr int HT_SQ = (DM / 64) * (DM / 32), HT_QKV = (DM / 64) * (NQKV / 32);
#if MK_NO_HELPER
constexpr int HT_TOTAL = 0;
#else
constexpr int HT_TOTAL = 9 * HT_FFN + 2 * HT_SQ + HT_QKV;
#endif
struct HTile { const float* W; bf16_t* Wt; int gi; int K, N, mode, k0, n0; };
__device__ __forceinline__ HTile helper_decode(AP a, int id) {
  HTile t; t.mode = 0; t.gi = -1; int lt; unsigned char* ws = a->ws;
  if (id < 9 * HT_FFN) {
    const int mi = id / HT_FFN; lt = id - mi * HT_FFN; const int f = 1 + mi / 3, which = mi - (mi / 3) * 3, layer = f >> 1, second = f & 1;
    if (which == 2) { t.W = a->in[second ? 10 : 5] + (size_t)layer * DM * FF; t.K = FF; t.N = DM; t.Wt = (bf16_t*)(ws + WS_WD + (size_t)f * SZ_D); }
    else { t.W = a->in[which ? (second ? 9 : 4) : (second ? 8 : 3)] + (size_t)layer * DM * FF; t.K = DM; t.N = FF; t.Wt = (bf16_t*)(ws + WS_WGU + (size_t)f * SZ_GU); t.mode = 1 + which; t.gi = f - 1; }
  } else if (id < 9 * HT_FFN + HT_SQ) { lt = id - 9 * HT_FFN; t.W = a->in[20]; t.K = DM; t.N = DM; t.Wt = (bf16_t*)(ws + WS_WOUT); }
  else if (id < 9 * HT_FFN + HT_SQ + HT_QKV) { lt = id - 9 * HT_FFN - HT_SQ; t.W = a->in[21]; t.K = DM; t.N = NQKV; t.Wt = (bf16_t*)(ws + WS_WQKV); t.gi = 3; }
  else { lt = id - 9 * HT_FFN - HT_SQ - HT_QKV; t.W = a->in[27]; t.K = DM; t.N = DM; t.Wt = (bf16_t*)(ws + WS_WO); }
  const int nkt = t.K / 64, nt = lt / nkt, kt = lt - nt * nkt; t.k0 = kt * 64; t.n0 = nt * 32;
  return t;
}
__device__ __forceinline__ void helper_issue(AP a, int id, float (&v)[32], int lane) {
  const HTile t = helper_decode(a, id);
  const float* src = t.W + (size_t)(t.k0 + (lane >> 5) * 32) * t.N + t.n0 + (lane & 31);
#pragma unroll
  for (int i = 0; i < 32; ++i) v[i] = src[(size_t)i * t.N];
}
__device__ __forceinline__ void helper_finish(AP a, int id, const float (&v)[32], float* wtile, const float* gains, int lane) {
  const HTile t = helper_decode(a, id); (void)wtile;
  const int n = t.n0 + (lane & 31), kb = t.k0 + (lane >> 5) * 32;
  int nd = n; if (t.mode == 1) nd = (n >> 7) * 256 + (n & 127); else if (t.mode == 2) nd = (n >> 7) * 256 + 128 + (n & 127);
#pragma unroll
  for (int q = 0; q < 4; ++q) {
    f32x4 g0 = {1.f, 1.f, 1.f, 1.f}, g1 = g0;
    if (t.gi >= 0) { const float* gp = gains + t.gi * DM + kb + 8 * q; g0 = *(const f32x4*)gp; g1 = *(const f32x4*)(gp + 4); }
    u32x4 w; w[0] = cvt_pk_bf16(v[8 * q] * g0[0], v[8 * q + 1] * g0[1]); w[1] = cvt_pk_bf16(v[8 * q + 2] * g0[2], v[8 * q + 3] * g0[3]);
    w[2] = cvt_pk_bf16(v[8 * q + 4] * g1[0], v[8 * q + 5] * g1[1]); w[3] = cvt_pk_bf16(v[8 * q + 6] * g1[2], v[8 * q + 7] * g1[3]);
    *(u32x4*)(t.Wt + (size_t)nd * t.K + kb + 8 * q) = w;
  }
}

__device__ __forceinline__ void cast_phase(const float* __restrict__ X, bf16_t* __restrict__ XB, u64* __restrict__ ss) {
  const int lane = tidx() & 63, wid = tidx() >> 6;
  for (int row = blockIdx.x * 8 + wid; row < T; row += gridDim.x * 8) {
    const float* xr = X + (size_t)row * DM;
    f32x4 v[8]; float sq = 0.f;
#pragma unroll
    for (int i = 0; i < 8; ++i) v[i] = *(const f32x4*)(xr + (i * 64 + lane) * 4);
#pragma unroll
    for (int i = 0; i < 8; ++i) { u32x2 w; w[0] = cvt_pk_bf16(v[i][0], v[i][1]); w[1] = cvt_pk_bf16(v[i][2], v[i][3]); *(u32x2*)(XB + (size_t)row * DM + (i * 64 + lane) * 4) = w;
      const float y0 = bflo(w[0]), y1 = bfhi(w[0]), y2 = bflo(w[1]), y3 = bfhi(w[1]); sq += y0 * y0 + y1 * y1 + y2 * y2 + y3 * y3; }
    sq = wave_sum(sq);
    if (lane == 0) ss[row] = (u64)(sq * SSQ + 0.5f);
  }
}
__device__ __forceinline__ void final_phase(const bf16_t* __restrict__ XB, const u64* __restrict__ ss, const float* __restrict__ g, float* __restrict__ out) {
  const int lane = tidx() & 63, wid = tidx() >> 6;
  for (int row = blockIdx.x * 8 + wid; row < T; row += gridDim.x * 8) {
    const float rstd = rsqrtf((float)ss[row] * SSQ_INV * (1.f / DM) + EPS);
    u32x4 xv[4];
#pragma unroll
    for (int i = 0; i < 4; ++i) xv[i] = *(const u32x4*)(XB + (size_t)row * DM + (i * 64 + lane) * 8);
#pragma unroll
    for (int i = 0; i < 4; ++i) { const int c = (i * 64 + lane) * 8; const f32x4 g0 = *(const f32x4*)(g + c), g1 = *(const f32x4*)(g + c + 4);
      const f32x4 y0 = (f32x4){bflo(xv[i][0]), bfhi(xv[i][0]), bflo(xv[i][1]), bfhi(xv[i][1])} * rstd * g0, y1 = (f32x4){bflo(xv[i][2]), bfhi(xv[i][2]), bflo(xv[i][3]), bfhi(xv[i][3])} * rstd * g1;
      *(f32x4*)(out + (size_t)row * DM + c) = y0; *(f32x4*)(out + (size_t)row * DM + c + 4) = y1; }
  }
}

__device__ __forceinline__ void prologue(AP a, unsigned char* lds) {
  unsigned char* ws = a->ws;
  float* tile = (float*)lds;
  for (int f = 0; f < (MK_NO_HELPER ? 4 : 1); ++f) {
    const int layer = f >> 1, which = f & 1;
    const float* wg = a->in[which ? 8 : 3] + (size_t)layer * DM * FF; const float* wu = a->in[which ? 9 : 4] + (size_t)layer * DM * FF; const float* wd = a->in[which ? 10 : 5] + (size_t)layer * DM * FF;
    const float* gn = a->in[which ? 7 : 2] + (size_t)layer * DM;
    xpose_mat(wg, DM, FF, (bf16_t*)(ws + WS_WGU + f * SZ_GU), 1, tile, gn);
    xpose_mat(wu, DM, FF, (bf16_t*)(ws + WS_WGU + f * SZ_GU), 2, tile, gn);
    xpose_mat(wd, FF, DM, (bf16_t*)(ws + WS_WD + f * SZ_D), 0, tile);
  }
  xpose_mat(a->in[11], DM, NIN_REAL, (bf16_t*)(ws + WS_WIN), 0, tile, a->in[6]);
#if MK_NO_HELPER
  xpose_mat(a->in[20], DM, DM, (bf16_t*)(ws + WS_WOUT), 0, tile);
  xpose_mat(a->in[21], DM, NQKV, (bf16_t*)(ws + WS_WQKV), 0, tile, a->in[6] + DM);
  xpose_mat(a->in[27], DM, DM, (bf16_t*)(ws + WS_WO), 0, tile);
#endif
  const size_t gtid = (size_t)blockIdx.x * 512 + tidx(), gn = (size_t)gridDim.x * 512;
  { u32x4* p = (u32x4*)(ws + WS_WIN + (size_t)NIN_REAL * DM * 2); const size_t n16 = (size_t)(NIN - NIN_REAL) * DM * 2 / 16; unsigned zz = 0u; asm volatile("" : "+v"(zz)); const u32x4 z = {zz, zz, zz, zz};
    for (size_t i = gtid; i < n16; i += gn) p[i] = z; }
  { u64* ssz = (u64*)(ws + WS_SS); for (size_t i = gtid; i < (size_t)6 * T; i += gn) ssz[i < (size_t)5 * T ? i : i + T] = 0ull; }
  { float* rope = (float*)(ws + WS_ROPE); const int* pos = (const int*)a->in[1];
    for (size_t i = gtid; i < (size_t)T * 16; i += gn) {
      const int tok = (int)(i >> 4), j = (int)(i & 15);
      const float inv = exp2f(-(float)j * (18.931568569324174f / 16.f));
      double rev = (double)pos[tok] * (double)inv * 0.15915494309189535; rev -= floor(rev);
      const float fr = (float)rev;
      rope[(size_t)tok * 32 + j] = __builtin_amdgcn_cosf(fr); rope[(size_t)tok * 32 + 16 + j] = __builtin_amdgcn_sinf(fr);
    } }
  cast_phase(a->in[0], (bf16_t*)(ws + WS_XN), (u64*)(ws + WS_SS) + (size_t)5 * T);
}

__device__ __forceinline__ void conv_module(AP a, unsigned char* lds) {
  const bf16_t* P = (const bf16_t*)(a->ws + WS_H); bf16_t* CAT = (bf16_t*)(a->ws + WS_S);
  unsigned* glu = (unsigned*)lds; float* part = (float*)(lds + 62 * 512 * 4); float* stats = part + 512;
  const int tid = tidx(), lane = tid & 63, wid = tid >> 6, c0 = 2 * tid;
  const float* cw = a->in[12];
  float w0[31], w1[31];
#pragma unroll
  for (int j = 0; j < 31; ++j) { const f32x2 t = *(const f32x2*)(cw + j * 1024 + c0); w0[j] = t[0]; w1[j] = t[1]; }
  const f32x2 cb = *(const f32x2*)(a->in[13] + c0), lg = *(const f32x2*)(a->in[14] + c0), lb = *(const f32x2*)(a->in[15] + c0);
  for (int tile = blockIdx.x; tile < T / 32; tile += gridDim.x) {
    const int tok0 = tile * 32, s0 = tok0 & (SEQ - 1);
    for (int r0 = 0; r0 < 64; r0 += 8) {
      unsigned pv[8], pg[8];
#pragma unroll
      for (int i = 0; i < 8; ++i) { const int r = r0 + i, s = s0 - 15 + r; const bool ok = (r < 62) && s >= 0 && s < SEQ;
        const bf16_t* pr = P + (size_t)(ok ? tok0 - 15 + r : tok0) * NIN + c0; pv[i] = *(const unsigned*)pr; pg[i] = *(const unsigned*)(pr + 1024); }
#pragma unroll
      for (int i = 0; i < 8; ++i) { const int r = r0 + i, s = s0 - 15 + r; const bool ok = s >= 0 && s < SEQ;
        const unsigned val = ok ? cvt_pk_bf16(bflo(pv[i]) * sigm(bflo(pg[i])), bfhi(pv[i]) * sigm(bfhi(pg[i]))) : 0u;
        if (r < 62) glu[r * 512 + tid] = val; }
    }
#pragma unroll 1
    for (int tt = 0; tt < 32; ++tt) {
      float o0 = cb[0], o1 = cb[1];
#pragma unroll
      for (int j = 0; j < 31; ++j) { const unsigned u = glu[(tt + j) * 512 + tid]; o0 += w0[j] * bflo(u); o1 += w1[j] * bfhi(u); }
      const float s = wave_sum(o0 + o1), q = wave_sum(o0 * o0 + o1 * o1);
      if (lane == 0) { part[(wid * 32 + tt) * 2] = s; part[(wid * 32 + tt) * 2 + 1] = q; }
    }
    __syncthreads();
    if (tid < 32) { float s = 0.f, q = 0.f;
      for (int w = 0; w < 8; ++w) { s += part[(w * 32 + tid) * 2]; q += part[(w * 32 + tid) * 2 + 1]; }
      const float mean = s * (1.f / 1024.f), var = fmaxf(q * (1.f / 1024.f) - mean * mean, 0.f);
      stats[tid * 2] = mean; stats[tid * 2 + 1] = rsqrtf(var + EPS); }
    __syncthreads();
#pragma unroll 1
    for (int tt = 0; tt < 32; ++tt) {
      float o0 = cb[0], o1 = cb[1];
#pragma unroll
      for (int j = 0; j < 31; ++j) { const unsigned u = glu[(tt + j) * 512 + tid]; o0 += w0[j] * bflo(u); o1 += w1[j] * bfhi(u); }
      const float mean = stats[tt * 2], rstd = stats[tt * 2 + 1];
      const float y0 = (o0 - mean) * rstd * lg[0] + lb[0], y1 = (o1 - mean) * rstd * lg[1] + lb[1];
      *(unsigned*)(CAT + (size_t)(tok0 + tt) * DM + c0) = cvt_pk_bf16(silu(y0), silu(y1));
    }
    __syncthreads();
  }
}

__device__ __forceinline__ void dn_prep(AP a) {
  const bf16_t* P = (const bf16_t*)(a->ws + WS_H);
  bf16_t* QN = (bf16_t*)(a->ws + WS_S); bf16_t* KN = (bf16_t*)(a->ws + WS_S + SZ_T1K); bf16_t* VS = (bf16_t*)(a->ws + WS_S + 2 * SZ_T1K);
  const float* sw = a->in[16];
  const int lane = tidx() & 63, wid = tidx() >> 6;
  for (int tok = blockIdx.x * 8 + wid; tok < T; tok += gridDim.x * 8) {
    const int s = tok & (SEQ - 1);
#pragma unroll 1
    for (int sb = 0; sb < 24; sb += 4) {
      unsigned x0[4], xm[4], xp[4]; f32x2 wa[4], wb[4], wc[4];
#pragma unroll
      for (int i = 0; i < 4; ++i) { const int c = (sb + i) * 128 + 2 * lane; const bf16_t* pr = P + (size_t)tok * NIN + 2048 + c;
        x0[i] = *(const unsigned*)pr; xm[i] = *(const unsigned*)(pr - (s > 0 ? NIN : 0)); xp[i] = *(const unsigned*)(pr + (s < SEQ - 1 ? NIN : 0));
        wa[i] = *(const f32x2*)(sw + c); wb[i] = *(const f32x2*)(sw + 3072 + c); wc[i] = *(const f32x2*)(sw + 6144 + c); }
#pragma unroll
      for (int i = 0; i < 4; ++i) { const int slot = sb + i;
        const unsigned um = (s > 0) ? xm[i] : 0u, up = (s < SEQ - 1) ? xp[i] : 0u;
        float y0 = wa[i][0] * bflo(um) + wb[i][0] * bflo(x0[i]) + wc[i][0] * bflo(up), y1 = wa[i][1] * bfhi(um) + wb[i][1] * bfhi(x0[i]) + wc[i][1] * bfhi(up);
        y0 = silu(y0); y1 = silu(y1);
        if (slot < 16) { const float ss = wave_sum(y0 * y0 + y1 * y1); float r = rsqrtf(ss + EPS); if (slot < 8) r *= 0.08838834764831845f; y0 *= r; y1 *= r; }
        bf16_t* dst = (slot < 8 ? QN : (slot < 16 ? KN : VS)) + (size_t)tok * 1024 + (slot & 7) * 128 + 2 * lane;
        *(unsigned*)dst = cvt_pk_bf16(y0, y1); }
    }
  }
  const float* BA = (const float*)(a->ws + WS_BA); float* BG = (float*)(a->ws + WS_BG);
  for (size_t i = (size_t)blockIdx.x * 512 + tidx(); i < (size_t)T * 16; i += (size_t)gridDim.x * 512) {
    const int tok = (int)(i >> 4), j = (int)(i & 15);
    const float braw = BA[(size_t)tok * 32 + j], araw = BA[(size_t)tok * 32 + 16 + j];
    const float xx = araw + a->in[18][j]; const float sp = xx > 20.f ? xx : log1pf(expf(xx));
    const float g = -expf(a->in[17][j]) * sp;
    BG[(size_t)tok * 32 + j] = sigm(braw); BG[(size_t)tok * 32 + 16 + j] = expf(g);
  }
}

__device__ __forceinline__ void scan_phase(AP a, unsigned char* lds) {
  const bf16_t* QN = (const bf16_t*)(a->ws + WS_S); const bf16_t* KN = (const bf16_t*)(a->ws + WS_S + SZ_T1K); const bf16_t* VS = (const bf16_t*)(a->ws + WS_S + 2 * SZ_T1K);
  const float* BG = (const float*)(a->ws + WS_BG);
  constexpr int BUF_F = 32 * 128 * 2 + 32 * 32 + 64;
  float* sb = (float*)lds; float* ob = sb + 2 * BUF_F;
  float* dump = ob + 2048 + 2 * (tidx() & 255);
  float* wtile = (float*)(lds + 86016) + ((tidx() >> 6) & 3) * (64 * 33);
  int hid = (int)blockIdx.x * 4 + ((tidx() >> 6) & 3); const int hstep = (int)gridDim.x * 4;
  float* gains = (float*)(lds + 119808);
  for (int i = tidx(); i < 4 * DM; i += 512) { const int v = i >> 11, k = i & (DM - 1); gains[i] = (v == 0) ? a->in[7][k] : (v == 1) ? a->in[2][DM + k] : (v == 2) ? a->in[7][DM + k] : a->in[6][DM + k]; }
  __syncthreads();
  int hprev = -1; float hv[32];
#pragma unroll
  for (int i = 0; i < 32; ++i) hv[i] = 0.f;
  const int tid = tidx(), lane = tid & 63, wid = tid >> 6, j = lane & 15, col = (wid & 3) * 8 + (lane >> 4) * 2;
  const int tl = tid >> 4, c8 = (tid & 15) * 8, tlv = (tid >> 2) & 31, cv = (tid & 3) * 8;
  for (int item = blockIdx.x; item < 256; item += gridDim.x) {
    const int cb = item & 3, dir = (item >> 2) & 1, h = (item >> 3) & 7, b = item >> 6;
    bf16_t* OD = (bf16_t*)(a->ws + WS_S + (3 + dir) * SZ_T1K);
    f32x2 S2[8];
#pragma unroll
    for (int i = 0; i < 8; ++i) S2[i] = (f32x2){0.f, 0.f};
    u32x4 kr, qr, vr; float ar = 0.f, br = 0.f;
#define SC_TOK(c, t) (b * SEQ + (dir ? (SEQ - 1 - ((c) * 32 + (t))) : ((c) * 32 + (t))))
#define SC_LOAD(c) do { const size_t tk = (size_t)SC_TOK(c, tl); kr = *(const u32x4*)(KN + tk * 1024 + h * 128 + c8); qr = *(const u32x4*)(QN + tk * 1024 + h * 128 + c8); \
      if (tid < 128) vr = *(const u32x4*)(VS + (size_t)SC_TOK(c, tlv) * 1024 + h * 128 + cb * 32 + cv); \
      else if (tid < 160) { const size_t t2 = (size_t)SC_TOK(c, tid - 128); br = BG[t2 * 32 + dir * 8 + h]; ar = BG[t2 * 32 + 16 + dir * 8 + h]; } } while (0)
#define SC_WRITE(bi) do { float* kb = sb + (bi) * BUF_F; float* qb = kb + 4096; float* vb = qb + 4096; float* abp = vb + 1024; \
      *(f32x4*)(kb + tl * 128 + c8) = (f32x4){bflo(kr[0]), bfhi(kr[0]), bflo(kr[1]), bfhi(kr[1])}; *(f32x4*)(kb + tl * 128 + c8 + 4) = (f32x4){bflo(kr[2]), bfhi(kr[2]), bflo(kr[3]), bfhi(kr[3])}; \
      *(f32x4*)(qb + tl * 128 + c8) = (f32x4){bflo(qr[0]), bfhi(qr[0]), bflo(qr[1]), bfhi(qr[1])}; *(f32x4*)(qb + tl * 128 + c8 + 4) = (f32x4){bflo(qr[2]), bfhi(qr[2]), bflo(qr[3]), bfhi(qr[3])}; \
      if (tid < 128) { *(f32x4*)(vb + tlv * 32 + cv) = (f32x4){bflo(vr[0]), bfhi(vr[0]), bflo(vr[1]), bfhi(vr[1])}; *(f32x4*)(vb + tlv * 32 + cv + 4) = (f32x4){bflo(vr[2]), bfhi(vr[2]), bflo(vr[3]), bfhi(vr[3])}; } \
      else if (tid < 160) { abp[(tid - 128) * 2] = ar; abp[(tid - 128) * 2 + 1] = br; } } while (0)
#define SC_FLUSH(c) do { if (tid < 128) { const float* op = ob + ((c) & 1) * 1024 + tlv * 32 + cv; const f32x4 x0 = *(const f32x4*)op, x1 = *(const f32x4*)(op + 4); \
      u32x4 w; w[0] = cvt_pk_bf16(x0[0], x0[1]); w[1] = cvt_pk_bf16(x0[2], x0[3]); w[2] = cvt_pk_bf16(x1[0], x1[1]); w[3] = cvt_pk_bf16(x1[2], x1[3]); \
      *(u32x4*)(OD + (size_t)SC_TOK(c, tlv) * 1024 + h * 128 + cb * 32 + cv) = w; } } while (0)
    __syncthreads();
    SC_LOAD(0); SC_WRITE(0); __syncthreads();
    for (int c = 0; c < SEQ / 32; ++c) {
      if (c + 1 < SEQ / 32) SC_LOAD(c + 1);
      if (c > 0) SC_FLUSH(c - 1);
      const float* kb = sb + (c & 1) * BUF_F; const float* qb = kb + 4096; const float* vb = qb + 4096; const float* abp = vb + 1024; float* obc = ob + (c & 1) * 1024;
      if (wid < 4) {
        f32x4 kv[2], qv[2]; f32x2 ab2, vv2;
#define SC_LD(t) do { _Pragma("unroll") for (int i = 0; i < 2; ++i) { kv[i] = *(const f32x4*)(kb + (t) * 128 + 8 * j + 4 * i); qv[i] = *(const f32x4*)(qb + (t) * 128 + 8 * j + 4 * i); } \
          ab2 = *(const f32x2*)(abp + (t) * 2); vv2 = *(const f32x2*)(vb + (t) * 32 + col); } while (0)
        SC_LD(0);
#pragma unroll 8
        for (int t = 0; t < 32; ++t) {
          f32x2 kk[4], qq[4];
#pragma unroll
          for (int i = 0; i < 2; ++i) { kk[2 * i] = (f32x2){kv[i][0], kv[i][1]}; kk[2 * i + 1] = (f32x2){kv[i][2], kv[i][3]}; qq[2 * i] = (f32x2){qv[i][0], qv[i][1]}; qq[2 * i + 1] = (f32x2){qv[i][2], qv[i][3]}; }
          const float al = ab2[0], bt = ab2[1], vA = vv2[0], vB = vv2[1];
          SC_LD((t + 1) & 31);
          f32x2 xa = S2[0] * kk[0], xb = S2[4] * kk[0];
#pragma unroll
          for (int i = 1; i < 4; ++i) { xa = S2[i] * kk[i] + xa; xb = S2[4 + i] * kk[i] + xb; }
          const float dA = row_sum16(xa[0] + xa[1]), dB = row_sum16(xb[0] + xb[1]);
          const float lA = bt * (vA - al * dA), lB = bt * (vB - al * dB);
          const f32x2 lA2 = {lA, lA}, lB2 = {lB, lB}, al2 = {al, al};
#pragma unroll
          for (int i = 0; i < 4; ++i) { S2[i] = kk[i] * lA2 + S2[i] * al2; S2[4 + i] = kk[i] * lB2 + S2[4 + i] * al2; }
          f32x2 ya = S2[0] * qq[0], yb = S2[4] * qq[0];
#pragma unroll
          for (int i = 1; i < 4; ++i) { ya = S2[i] * qq[i] + ya; yb = S2[4 + i] * qq[i] + yb; }
          const f32x2 o2 = {row_sum16(ya[0] + ya[1]), row_sum16(yb[0] + yb[1])};
          *(f32x2*)((j == 0) ? (obc + t * 32 + col) : dump) = o2;
        }
#undef SC_LD
      } else {
        if (hprev >= 0) helper_finish(a, hprev, hv, wtile, gains, lane);
        if (hid < HT_TOTAL) { helper_issue(a, hid, hv, lane); hprev = hid; hid += hstep; } else hprev = -1;
      }
      if (c + 1 < SEQ / 32) SC_WRITE((c + 1) & 1);
      asm volatile("s_waitcnt lgkmcnt(0)" ::: "memory"); __builtin_amdgcn_s_barrier(); asm volatile("" ::: "memory");
    }
    SC_FLUSH(SEQ / 32 - 1);
    __syncthreads();
#undef SC_TOK
#undef SC_LOAD
#undef SC_WRITE
#undef SC_FLUSH
  }
  if (wid >= 4) { if (hprev >= 0) helper_finish(a, hprev, hv, wtile, gains, lane); for (; hid < HT_TOTAL; hid += hstep) { helper_issue(a, hid, hv, lane); helper_finish(a, hid, hv, wtile, gains, lane); } }
}

__device__ __forceinline__ void gnorm_phase(AP a) {
  const bf16_t* P = (const bf16_t*)(a->ws + WS_H); bf16_t* CAT = (bf16_t*)(a->ws + WS_S);
  const bf16_t* OF = (const bf16_t*)(a->ws + WS_S + 3 * SZ_T1K); const bf16_t* OB = (const bf16_t*)(a->ws + WS_S + 4 * SZ_T1K);
  const int lane = tidx() & 63, wid = tidx() >> 6;
  const f32x2 g = *(const f32x2*)(a->in[19] + 2 * lane);
  for (int tok = blockIdx.x * 8 + wid; tok < T; tok += gridDim.x * 8) {
    unsigned uf[8], ub[8], uz[8];
#pragma unroll
    for (int h = 0; h < 8; ++h) { const size_t o = (size_t)tok * 1024 + h * 128 + 2 * lane;
      uf[h] = *(const unsigned*)(OF + o); ub[h] = *(const unsigned*)(OB + o); uz[h] = *(const unsigned*)(P + (size_t)tok * NIN + 5120 + h * 128 + 2 * lane); }
#pragma unroll
    for (int h = 0; h < 8; ++h) {
      const float o0 = bflo(uf[h]) + bflo(ub[h]), o1 = bfhi(uf[h]) + bfhi(ub[h]);
      const float ss = wave_sum(o0 * o0 + o1 * o1), rstd = rsqrtf(ss * (1.f / 128.f) + EPS);
      const float y0 = o0 * rstd * g[0] * silu(bflo(uz[h])), y1 = o1 * rstd * g[1] * silu(bfhi(uz[h]));
      *(unsigned*)(CAT + (size_t)tok * DM + 1024 + h * 128 + 2 * lane) = cvt_pk_bf16(y0, y1);
    }
  }
}

__device__ __forceinline__ void attn_phase(AP a, unsigned char* lds) {
  const bf16_t* QKV = (const bf16_t*)(a->ws + WS_H); float* OA = (float*)(a->ws + WS_S);
  const int lane = tidx() & 63;
  const float s1 = wave_sum(a->in[22][lane] * a->in[23][lane] + a->in[22][lane + 64] * a->in[23][lane + 64]);
  const float s2 = wave_sum(a->in[24][lane] * a->in[25][lane] + a->in[24][lane + 64] * a->in[25][lane + 64]);
  const float lam = __int_as_float(__builtin_amdgcn_readfirstlane(__float_as_int(expf(s1) - expf(s2) + LAMBDA_INIT)));
  int seq = SEQ; asm volatile("" : "+s"(seq));
  const int nk = (512 - (int)blockIdx.x + (int)gridDim.x - 1) / (int)gridDim.x;
#pragma unroll 1
  for (int it = 0; it < 4 * nk; ++it) {
    const int item = blockIdx.x + gridDim.x * (it >> 2), m = it & 1, vh = (it >> 1) & 1;
    const int h = item & 7, qb = (item >> 3) & 15, b = item >> 7;
    const size_t tok0 = (size_t)b * SEQ + qb * 256, kv0 = (size_t)b * SEQ;
    att::attn_dense_body<att::bf16>(QKV + tok0 * NQKV + h * 256 + m * 128, QKV + kv0 * NQKV + 2048 + h * 256 + m * 128, QKV + kv0 * NQKV + 4096 + h * 256 + vh * 128,
                                    OA + tok0 * DM + h * 256 + vh * 128, seq, (char*)lds, m, lam, (unsigned short*)(lds + 69632));
    __syncthreads();
    if ((it & 3) == 3) {
      asm volatile("s_waitcnt vmcnt(0)" ::: "memory");
      const int wv = tidx() >> 6, ln = tidx() & 63; bf16_t* CAT = (bf16_t*)a->out;
      const f32x4 sg = *(const f32x4*)(a->in[26] + 4 * ln);
#pragma unroll 4
      for (int r = 0; r < 32; ++r) {
        const size_t o = (tok0 + wv * 32 + r) * DM + h * 256 + 4 * ln;
        const f32x4 v = *(const f32x4*)(OA + o);
        const float ss = wave_sum(v[0] * v[0] + v[1] * v[1] + v[2] * v[2] + v[3] * v[3]), rr = rsqrtf(ss * (1.f / 256.f) + EPS) * (1.f - LAMBDA_INIT);
        u32x2 w; w[0] = cvt_pk_bf16(v[0] * rr * sg[0], v[1] * rr * sg[1]); w[1] = cvt_pk_bf16(v[2] * rr * sg[2], v[3] * rr * sg[3]);
        *(u32x2*)(CAT + o) = w;
      }
    }
  }
}
__device__ __forceinline__ void subln_phase(AP a) {
  const float* OA = (const float*)(a->ws + WS_S); bf16_t* CAT = (bf16_t*)(a->ws + WS_H);
  const int lane = tidx() & 63, wid = tidx() >> 6;
  const f32x4 g = *(const f32x4*)(a->in[26] + 4 * lane);
  for (int task = blockIdx.x * 8 + wid; task < T * 8; task += gridDim.x * 8) {
    const size_t o = (size_t)(task >> 3) * DM + (task & 7) * 256 + 4 * lane;
    const f32x4 v = *(const f32x4*)(OA + o);
    const float ss = wave_sum(v[0] * v[0] + v[1] * v[1] + v[2] * v[2] + v[3] * v[3]), r = rsqrtf(ss * (1.f / 256.f) + EPS) * (1.f - LAMBDA_INIT);
    u32x2 w; w[0] = cvt_pk_bf16(v[0] * r * g[0], v[1] * r * g[1]); w[1] = cvt_pk_bf16(v[2] * r * g[2], v[3] * r * g[3]);
    *(u32x2*)(CAT + o) = w;
  }
}

enum { PT_PRO, PT_GU, PT_RES, PT_NORM, PT_IN, PT_CONV, PT_SCAN, PT_GNORM, PT_QKV, PT_ATTN, PT_SUBLN, PT_FINAL };

__global__ void __launch_bounds__(512, 2) mega(Args a_kernarg) {
  extern __shared__ __attribute__((aligned(16))) unsigned char lds[];
  cg::grid_group grid = cg::this_grid();
  const AP a0 = (AP)__builtin_amdgcn_kernarg_segment_ptr();
  const int ph_lo = a0->ph_lo, ph_hi = a0->ph_hi;
  for (int php = ph_lo; php < ph_hi; ++php) {
    int ph = php;
#ifndef MK_DUP_PH
#define DUP2 0
#else
#define DUP2 (int)dup2
#endif
#ifdef MK_DUP_PH
    bool dup2 = false;
    if (php > MK_DUP_PH) { ph = php - 1; dup2 = (php == MK_DUP_PH + 1); }
#endif
    unsigned long long apv = (unsigned long long)a0; asm volatile("" : "+s"(apv)); const AP a = (AP)apv;
    unsigned char* ws = a->ws;
    int type = PT_PRO, f = 0, nss = -1;
    const bf16_t* gA = (const bf16_t*)(ws + WS_H); const bf16_t* gB = nullptr; int gK = FF;
    switch (ph) {
      case 0: type = PT_PRO; break;
      case 1: type = PT_GU; f = 0; nss = 5; break;
      case 2: type = PT_RES; gB = (const bf16_t*)(ws + WS_WD); nss = 0; break;
      case 3: type = PT_IN; nss = 0; break;
      case 4: type = PT_CONV; break;
      case 5: type = PT_SCAN; break;
      case 6: type = PT_GNORM; break;
      case 7: type = PT_RES; gA = (const bf16_t*)(ws + WS_S); gB = (const bf16_t*)(ws + WS_WOUT); gK = DM; nss = 1; break;
      case 8: type = PT_GU; f = 1; nss = 1; break;
      case 9: type = PT_RES; gB = (const bf16_t*)(ws + WS_WD + 1 * SZ_D); nss = 2; break;
      case 10: type = PT_GU; f = 2; nss = 2; break;
      case 11: type = PT_RES; gB = (const bf16_t*)(ws + WS_WD + 2 * SZ_D); nss = 3; break;
      case 12: type = PT_QKV; nss = 3; break;
      case 13: type = PT_ATTN; break;
      case 14: type = PT_SUBLN; break;
      case 15: type = PT_RES; gA = (const bf16_t*)a->out; gB = (const bf16_t*)(ws + WS_WO); gK = DM; nss = 4; break;
      case 16: type = PT_GU; f = 3; nss = 4; break;
      case 17: type = PT_RES; gB = (const bf16_t*)(ws + WS_WD + 3 * SZ_D); break;
      default: type = PT_FINAL; break;
    }
    const u64* ssp = (const u64*)(ws + WS_SS) + (size_t)(nss >= 0 ? nss : 0) * T;
    pg8::StaticOrder S;
#ifndef MK_ENABLE
#define MK_ENABLE 0xFFFF
#endif
    if (!((MK_ENABLE >> type) & 1)) continue;
    if (type == PT_SUBLN) continue;
    switch (type) {
      case PT_PRO: prologue(a, lds); break;
      case PT_GU: {
#ifdef MK_STAGGER
        if ((blockIdx.x >> 3) & 1) { const unsigned long long t0 = __builtin_amdgcn_s_memrealtime(); while (__builtin_amdgcn_s_memrealtime() - t0 < MK_STAGGER) __builtin_amdgcn_s_sleep(32); }
#endif
        pg8::Gemm g{(const bf16_t*)(ws + WS_XN), (const bf16_t*)(ws + WS_WGU + (size_t)f * SZ_GU), T, 2 * FF, DM}; S.init(T, 2 * FF, gridDim.x, blockIdx.x);
        EpiSwiglu E{(bf16_t*)(ws + WS_H), ssp, DUP2}; pg8::gemm_phase<EpiSwiglu, pg8::StaticOrder>((PG8_LAS unsigned char*)lds, g, S, E, nullptr); } break;
      case PT_RES: { pg8::Gemm g{gA, gB, T, DM, gK}; S.init(T, DM, gridDim.x, blockIdx.x);
        EpiResid E{a, ph, DUP2}; pg8::gemm_phase<EpiResid, pg8::StaticOrder>((PG8_LAS unsigned char*)lds, g, S, E, nullptr); } break;
      case PT_IN: { pg8::Gemm g{(const bf16_t*)(ws + WS_XN), (const bf16_t*)(ws + WS_WIN), T, NIN, DM}; S.init(T, NIN, gridDim.x, blockIdx.x);
        EpiP E{(bf16_t*)(ws + WS_H), (float*)(ws + WS_BA), ssp}; pg8::gemm_phase<EpiP, pg8::StaticOrder>((PG8_LAS unsigned char*)lds, g, S, E, nullptr); } break;
      case PT_CONV: dn_prep(a); break;
      case PT_SCAN: scan_phase(a, lds); break;
      case PT_GNORM: gnorm_phase(a); conv_module(a, lds); break;
      case PT_QKV: { pg8::Gemm g{(const bf16_t*)(ws + WS_XN), (const bf16_t*)(ws + WS_WQKV), T, NQKV, DM}; S.init(T, NQKV, gridDim.x, blockIdx.x);
        EpiQKV E{(bf16_t*)(ws + WS_H), (const float*)(ws + WS_ROPE), ssp}; pg8::gemm_phase<EpiQKV, pg8::StaticOrder>((PG8_LAS unsigned char*)lds, g, S, E, nullptr); } break;
      case PT_ATTN: attn_phase(a, lds); break;
      case PT_SUBLN: break;
      default: final_phase((const bf16_t*)(ws + WS_XN), (const u64*)(ws + WS_SS) + (size_t)6 * T, a->in[28], a->out); break;
    }
    if (php + 1 < ph_hi) grid.sync();
  }
}
}

#ifndef MK_MULTI
#define MK_MULTI 0
#endif
extern "C" void kernel_launch(void* const* d_in, const int* in_sizes, int n_in, void* d_out, int out_size, void* d_ws, size_t ws_size, hipStream_t stream) {
  static int grid = 0;
  if (grid == 0) {
    if (n_in != 29 || out_size != mk::T * mk::DM || ws_size < mk::WS_END) { fprintf(stderr, "kernel_launch: unexpected shapes n_in %d out %d ws %zu (need %zu)\n", n_in, out_size, ws_size, (size_t)mk::WS_END); grid = -1; return; }
    int dev = 0, cus = 0, per_cu = 0;
    hipGetDevice(&dev); hipDeviceGetAttribute(&cus, hipDeviceAttributeMultiprocessorCount, dev);
    if (hipFuncSetAttribute((const void*)mk::mega, hipFuncAttributeMaxDynamicSharedMemorySize, mk::LDS_BYTES) != hipSuccess) { fprintf(stderr, "kernel_launch: hipFuncSetAttribute failed\n"); grid = -1; return; }
    hipOccupancyMaxActiveBlocksPerMultiprocessor(&per_cu, (const void*)mk::mega, 512, mk::LDS_BYTES);
    if (per_cu < 1) per_cu = 1;
    grid = cus * per_cu;
    (void)hipGetLastError();
  }
  if (grid < 0) return;
  mk::Args a{};
  for (int i = 0; i < 29; ++i) a.in[i] = (const float*)d_in[i];
  a.out = (float*)d_out; a.ws = (unsigned char*)d_ws;
#if MK_MULTI
  for (int ph = 0; ph < mk::NPHASE; ++ph) { a.ph_lo = ph; a.ph_hi = ph + 1; hipLaunchKernelGGL(mk::mega, dim3(grid), dim3(512), mk::LDS_BYTES, stream, a); }
#else
  a.ph_lo = 0; a.ph_hi = mk::NPHASE;
  void* args[] = {&a};
  hipError_t e = hipLaunchCooperativeKernel((const void*)mk::mega, dim3(grid), dim3(512), args, mk::LDS_BYTES, stream);
  if (e != hipSuccess) fprintf(stderr, "cooperative launch failed: %s (grid %d)\n", hipGetErrorString(e), grid);
#endif
}
```

```cpp
#include <hip/hip_runtime.h>
#include <hip/hip_cooperative_groups.h>
#include <cstdio>
#include <cstdint>
namespace cg = cooperative_groups;
__device__ __forceinline__ int tidx() { int t = threadIdx.x; asm volatile("" : "+v"(t)); return t; }
namespace pg8 {
#define PG8_LAS __attribute__((address_space(3)))
typedef unsigned short bf16_t;
typedef short bf16x8 __attribute__((ext_vector_type(8)));
typedef float f32x4 __attribute__((ext_vector_type(4)));
typedef unsigned u32x4 __attribute__((ext_vector_type(4)));
constexpr int BM = 256, BK = 64, HALF = 128, HTB = HALF * BK * 2  , STAGE_BYTES = 8 * HTB, NXCD = 8, WGM = 4;

__host__ __device__ __forceinline__ int lds_byte(int r, int c) { const int st = (r >> 4) * 2 + (c >> 5), rr = r & 15, cc = c & 31, ob = rr * 64 + cc * 2; return st * 1024 + (ob ^ (((ob >> 9) & 1) << 5)); }
__host__ __device__ __forceinline__ void stage_rc(int b, int& R, int& C) { const int st = b / 1024, sb = b % 1024, swz = sb ^ (((sb >> 9) & 1) << 5); R = (st >> 1) * 16 + swz / 64; C = (st & 1) * 32 + (swz % 64) / 2; }
__host__ __device__ __forceinline__ int perm32(int rho) { const int n = rho >> 4, i = rho & 15; return 8 * (i >> 2) + 4 * n + (i & 3); }
struct Unit { int pm, pn; };
struct Gemm { const bf16_t* A; const bf16_t* Bt; int M, N, K; };

struct StaticOrder {
    int nM, nN, nwg, G, c;
    __host__ __device__ void init(int M, int N, int G_, int c_) { nM = M / BM; nN = N / BM; nwg = nM * nN; G = G_; c = c_; }
    __host__ __device__ bool next(int i, Unit& u) const {
        const long L = (long)i * G + c; if (L >= nwg) return false;
        int wgid = (int)L; { const int q = nwg / NXCD, r = nwg % NXCD, xcd = wgid % NXCD, off = wgid / NXCD; wgid = (xcd < r ? xcd * (q + 1) : r * (q + 1) + (xcd - r) * q) + off; }
        const int nig = WGM * nN, gid = wgid / nig, fm = gid * WGM, gsz = (nM - fm) < WGM ? (nM - fm) : WGM;
        u.pm = fm + ((wgid % nig) % gsz); u.pn = (wgid % nig) / gsz; return true;
    }
    __device__ __forceinline__ void a_ready(const Unit&) const {}
    __device__ __forceinline__ void done(const Unit&) const {}
};
__device__ __forceinline__ unsigned cvt_pk_bf16(float lo, float hi) { unsigned r; asm volatile("v_cvt_pk_bf16_f32 %0, %1, %2" : "=v"(r) : "v"(lo), "v"(hi)); return r; }
template <class Epi, class Sched, bool STAMP = false>
__device__ __forceinline__ void gemm_phase(PG8_LAS unsigned char* lds, const Gemm g, const Sched& S, const Epi& E, unsigned long long* stamps) {
    const int tid = tidx(), wid = __builtin_amdgcn_readfirstlane(tid >> 6), lane = tid & 63, wr = wid >> 2, wc = wid & 3, fr = lane & 15, fq = lane >> 4;
    const int K = g.K, nt = K / BK;
    int ts_lo = 0, ts_hi = 0, nts = 0; const unsigned long long rt_entry = STAMP ? (unsigned long long)wall_clock64() : 0ull;
#define PG8_STAMP() do { if (STAMP && wid == 0 && nts < 64) { const unsigned long long _c = (unsigned long long)clock64(); \
        ts_lo = (lane == nts) ? (int)(unsigned)_c : ts_lo; ts_hi = (lane == nts) ? (int)(unsigned)(_c >> 32) : ts_hi; ++nts; } } while (0)
    PG8_STAMP();
    unsigned voffA[2], voffB[2];
#pragma unroll
    for (int i = 0; i < 2; ++i) { int R, C; stage_rc(tid * 16 + i * 8192, R, C); const int Rb = Epi::PERM ? ((R & ~31) + perm32(R & 31)) : R;
        voffA[i] = (unsigned)(R * K + C) * 2u; voffB[i] = (unsigned)(Rb * K + C) * 2u; }
    const size_t kstep = (size_t)(BK * 2);
    const size_t hstep = (size_t)HALF * K * 2;
    const size_t tstep = 2 * hstep;
    const unsigned ldsw = (unsigned)wid * 1024u;
    const int aoff = lds_byte(wr * 64 + fr, fq * 8), boff = lds_byte(wc * 32 + fr, fq * 8);
#define PG8_SA(b, h) (((b) * 2 + (h)) * HTB)
#define PG8_SB(b, h) ((4 + (b) * 2 + (h)) * HTB)
#define PG8_STAGE(bufoff, gbase, voff) do { _Pragma("unroll") for (int _i = 0; _i < 2; ++_i) \
        __builtin_amdgcn_global_load_lds((const unsigned*)((const char*)(gbase) + (voff)[_i]), (PG8_LAS unsigned*)(lds + (bufoff) + ldsw + _i * 8192), 16, 0, 0); } while (0)
#define PG8_LDA(dst, b, h) do { _Pragma("unroll") for (int m = 0; m < 4; ++m) _Pragma("unroll") for (int k = 0; k < 2; ++k) dst[m][k] = *(const PG8_LAS bf16x8*)(lds + PG8_SA(b, h) + aoff + m * 2048 + k * 1024); } while (0)
#define PG8_LDB(dst, b, h) do { _Pragma("unroll") for (int n = 0; n < 2; ++n) _Pragma("unroll") for (int k = 0; k < 2; ++k) dst[n][k] = *(const PG8_LAS bf16x8*)(lds + PG8_SB(b, h) + boff + n * 2048 + k * 1024); } while (0)
#define PG8_MMA(ai, bj, At, Bt) do { __builtin_amdgcn_s_setprio(1); _Pragma("unroll") for (int m = 0; m < 4; ++m) _Pragma("unroll") for (int n = 0; n < 2; ++n) _Pragma("unroll") for (int k = 0; k < 2; ++k) \
        acc[ai][bj][m][n] = __builtin_amdgcn_mfma_f32_16x16x32_bf16(Bt[n][k], At[m][k], acc[ai][bj][m][n], 0, 0, 0); __builtin_amdgcn_s_setprio(0); } while (0)
#define PG8_WAIT_V(n) asm volatile("s_waitcnt vmcnt(" #n ")" ::: "memory")
#define PG8_WAIT_L(n) asm volatile("s_waitcnt lgkmcnt(" #n ")" ::: "memory")
#define PG8_BAR __builtin_amdgcn_s_barrier()
#define PG8_SCHED __builtin_amdgcn_sched_barrier(0)
    Unit cur, nxt; int ui = 0;
    if (!S.next(0, cur)) return;
    f32x4 acc[2][2][4][2];
#pragma unroll
    for (int a = 0; a < 2; ++a)
#pragma unroll
        for (int b = 0; b < 2; ++b)
#pragma unroll
            for (int m = 0; m < 4; ++m)
#pragma unroll
                for (int n = 0; n < 2; ++n) acc[a][b][m][n] = (f32x4){0.f, 0.f, 0.f, 0.f};
    bf16x8 At[4][2], B0[2][2], B1[2][2];
    const char* cA = (const char*)g.A + (size_t)cur.pm * tstep; const char* cB = (const char*)g.Bt + (size_t)cur.pn * tstep;
    S.a_ready(cur);
    PG8_STAGE(PG8_SB(0, 0), cB, voffB); PG8_STAGE(PG8_SA(0, 0), cA, voffA); PG8_STAGE(PG8_SB(0, 1), cB + hstep, voffB); PG8_STAGE(PG8_SA(0, 1), cA + hstep, voffA);
    if (wr == 1) PG8_BAR;
    PG8_WAIT_V(4); PG8_BAR;
    PG8_STAGE(PG8_SB(1, 0), cB + kstep, voffB); PG8_STAGE(PG8_SA(1, 0), cA + kstep, voffA); PG8_STAGE(PG8_SB(1, 1), cB + hstep + kstep, voffB);
    PG8_WAIT_V(6); PG8_BAR;
    PG8_STAMP();
    for (;;) {
        const bool has_next = S.next(ui + 1, nxt);
        const char* nA = has_next ? (const char*)g.A + (size_t)nxt.pm * tstep : cA; const char* nB = has_next ? (const char*)g.Bt + (size_t)nxt.pn * tstep : cB;
        for (int t = 0; t < nt; t += 2) {
            const bool last = (t == nt - 2);
            const char* a1 = cA + (size_t)(t + 1) * kstep;
            const char* a2 = last ? nA : cA + (size_t)(t + 2) * kstep; const char* b2 = last ? nB : cB + (size_t)(t + 2) * kstep;
            const char* a3 = a2 + kstep; const char* b3 = b2 + kstep;
            if (last && has_next) S.a_ready(nxt);
            PG8_LDB(B0, 0, 0); PG8_SCHED; PG8_LDA(At, 0, 0); PG8_STAGE(PG8_SA(1, 1), a1 + hstep, voffA);
            PG8_WAIT_L(8); PG8_BAR; PG8_WAIT_L(0); PG8_MMA(0, 0, At, B0); PG8_BAR; PG8_SCHED;
            PG8_LDB(B1, 0, 1); PG8_STAGE(PG8_SB(0, 0), b2, voffB);
            PG8_BAR; PG8_WAIT_L(0); PG8_MMA(0, 1, At, B1); PG8_BAR;
            PG8_LDA(At, 0, 1); PG8_STAGE(PG8_SA(0, 0), a2, voffA);
            PG8_BAR; PG8_WAIT_L(0); PG8_MMA(1, 0, At, B0); PG8_BAR; PG8_SCHED;
            PG8_STAGE(PG8_SB(0, 1), b2 + hstep, voffB);
            PG8_WAIT_V(6); PG8_BAR; PG8_MMA(1, 1, At, B1); PG8_BAR;
            PG8_LDB(B0, 1, 0); PG8_SCHED; PG8_LDA(At, 1, 0); PG8_STAGE(PG8_SA(0, 1), a2 + hstep, voffA);
            PG8_WAIT_L(8); PG8_BAR; PG8_WAIT_L(0); PG8_MMA(0, 0, At, B0); PG8_BAR; PG8_SCHED;
            PG8_LDB(B1, 1, 1); PG8_STAGE(PG8_SB(1, 0), b3, voffB);
            PG8_BAR; PG8_WAIT_L(0); PG8_MMA(0, 1, At, B1); PG8_BAR;
            PG8_LDA(At, 1, 1); PG8_STAGE(PG8_SA(1, 0), a3, voffA);
            PG8_BAR; PG8_WAIT_L(0); PG8_MMA(1, 0, At, B0); PG8_BAR; PG8_SCHED;
            PG8_STAGE(PG8_SB(1, 1), b3 + hstep, voffB);
            PG8_WAIT_V(6); PG8_BAR; PG8_MMA(1, 1, At, B1); PG8_BAR;
        }
        PG8_STAMP();
        if constexpr (!Epi::AFTER_DRAIN) { E(acc, cur, wr, wc, fr, fq); S.done(cur); }
        PG8_STAMP();
        if (!has_next) break;
#pragma unroll
        for (int a = 0; a < 2; ++a)
#pragma unroll
            for (int b = 0; b < 2; ++b)
#pragma unroll
                for (int m = 0; m < 4; ++m)
#pragma unroll
                    for (int n = 0; n < 2; ++n) acc[a][b][m][n] = (f32x4){0.f, 0.f, 0.f, 0.f};
        cur = nxt; cA = nA; cB = nB; ++ui;
    }
    PG8_WAIT_V(0);
    if (wr == 0) PG8_BAR;
    PG8_BAR;
    if constexpr (Epi::AFTER_DRAIN) { E.fused(acc, cur, wr, wc, fr, fq, lds, wid, lane); S.done(cur); }
    PG8_STAMP();
    if (STAMP && wid == 0) { stamps[lane] = lane < nts ? (((unsigned long long)(unsigned)ts_hi << 32) | (unsigned)ts_lo) : 0ull;
        if (lane == 62) stamps[62] = rt_entry; if (lane == 63) stamps[63] = (unsigned long long)wall_clock64(); }
#undef PG8_STAMP
#undef PG8_SA
#undef PG8_SB
#undef PG8_STAGE
#undef PG8_LDA
#undef PG8_LDB
#undef PG8_MMA
#undef PG8_WAIT_V
#undef PG8_WAIT_L
#undef PG8_BAR
#undef PG8_SCHED
}
}

namespace att {
using bf16 = unsigned short;
constexpr int   D = 128, NW = 8, QBLK = 32, KVBLK = 64;
constexpr float SCALE = 0.088388347648318440f;
constexpr float THR = 8.f;
constexpr int SDEPTH = 2;
constexpr int LDQ = 6144, LDK = 6144, LDO = 2048;
constexpr size_t SHM_V = KVBLK * D * 2, SHM_K = KVBLK * D * 2, SHM_ATTN = 2 * SHM_V + 2 * SHM_K + NW * 64 * 4;
using bf16x8 = __attribute__((ext_vector_type(8))) short;
using s16x4  = __attribute__((ext_vector_type(4))) short;
using f32x16 = __attribute__((ext_vector_type(16))) float;
using f32x8  = __attribute__((ext_vector_type(8))) float;
using u32x4  = __attribute__((ext_vector_type(4))) unsigned;
#define KSWZ(row, colB) ((row) * 256 + ((colB) ^ (((row) & 7) << 4)))
#define SBAR() __builtin_amdgcn_sched_barrier(0)
__device__ __forceinline__ int crow(int r, int hi) { return (r & 3) + 8 * (r >> 2) + 4 * hi; }
__device__ __forceinline__ unsigned cvtpk(float lo, float hi) {
  unsigned r; asm volatile("v_cvt_pk_bf16_f32 %0, %1, %2" : "=v"(r) : "v"(lo), "v"(hi)); return r;
}
template <typename TIn> struct Stage;
template <> struct Stage<bf16>  { using T = bf16x8;
  __device__ static __forceinline__ T ld8(const bf16* p) { return *reinterpret_cast<const bf16x8*>(p); }
  __device__ static __forceinline__ bf16x8 tobf(T x) { return x; } };
template <> struct Stage<float> { using T = f32x8;
  __device__ static __forceinline__ T ld8(const float* p) { return *reinterpret_cast<const f32x8*>(p); }
  __device__ static __forceinline__ bf16x8 tobf(T x) {
    u32x4 w = {cvtpk(x[0], x[1]), cvtpk(x[2], x[3]), cvtpk(x[4], x[5]), cvtpk(x[6], x[7])}; return *reinterpret_cast<bf16x8*>(&w); } };

__device__ __forceinline__ void partialSM(f32x16& p0, f32x16& p1, float& m_reg, float& mn, float& alpha) {
  constexpr float C = SCALE * 1.4426950408889634f;
  float pmax = p0[0]; for (int r = 1; r < 16; ++r) pmax = fmaxf(pmax, p0[r]); for (int r = 0; r < 16; ++r) pmax = fmaxf(pmax, p1[r]);
  { auto rr = __builtin_amdgcn_permlane32_swap(__float_as_uint(pmax), __float_as_uint(pmax), false, false);
    pmax = fmaxf(__uint_as_float(rr[0]), __uint_as_float(rr[1])); }
  if (__builtin_expect(__all(pmax - m_reg <= THR / SCALE), 1)) { mn = m_reg; alpha = 1.f; }
  else { mn = fmaxf(m_reg, pmax); alpha = __builtin_amdgcn_exp2f((m_reg - mn) * C); m_reg = mn; }
  float mnC = -mn * C;
  for (int r = 0; r < 16; ++r) p0[r] = fmaf(p0[r], C, mnC); for (int r = 0; r < 16; ++r) p1[r] = fmaf(p1[r], C, mnC);
  for (int r = 0; r < 16; ++r) p0[r] = __builtin_amdgcn_exp2f(p0[r]);
}
__device__ __forceinline__ void finishSM(f32x16& p0, f32x16& p1, float alpha, float& l_reg, bf16x8& pa0, bf16x8& pa1, bf16x8& pa2, bf16x8& pa3) {
  for (int r = 0; r < 16; ++r) p1[r] = __builtin_amdgcn_exp2f(p1[r]);
  float ps = 0; for (int r = 0; r < 16; ++r) ps += p0[r]; for (int r = 0; r < 16; ++r) ps += p1[r];
  { auto rr = __builtin_amdgcn_permlane32_swap(__float_as_uint(ps), __float_as_uint(ps), false, false);
    ps = __uint_as_float(rr[0]) + __uint_as_float(rr[1]); }
  l_reg = l_reg * alpha + ps;
#define PK4(P, BASE, OUT) do { unsigned a0 = cvtpk(P[BASE + 0], P[BASE + 1]), a1 = cvtpk(P[BASE + 2], P[BASE + 3]);   \
    unsigned b0 = cvtpk(P[BASE + 4], P[BASE + 5]), b1 = cvtpk(P[BASE + 6], P[BASE + 7]);                              \
    auto r0 = __builtin_amdgcn_permlane32_swap(a0, b0, false, false); auto r1 = __builtin_amdgcn_permlane32_swap(a1, b1, false, false); \
    u32x4 w = {r0[0], r1[0], r0[1], r1[1]}; OUT = *reinterpret_cast<bf16x8*>(&w); } while (0)
  PK4(p0, 0, pa0); PK4(p0, 8, pa1); PK4(p1, 0, pa2); PK4(p1, 8, pa3);
#undef PK4
}
__device__ __forceinline__ void qkt(f32x16& p0, f32x16& p1, const bf16* Ks, const bf16x8* qr, int r32, int hi) {
  p0 = f32x16{}; p1 = f32x16{};
  for (int d0 = 0; d0 < 8; ++d0) { int cb = (d0 * 16 + hi * 8) * 2;
    bf16x8 b0 = *reinterpret_cast<const bf16x8*>((const char*)Ks + KSWZ(r32, cb));
    bf16x8 b1 = *reinterpret_cast<const bf16x8*>((const char*)Ks + KSWZ(32 + r32, cb));
    p0 = __builtin_amdgcn_mfma_f32_32x32x16_bf16(b0, qr[d0], p0, 0, 0, 0);
    p1 = __builtin_amdgcn_mfma_f32_32x32x16_bf16(b1, qr[d0], p1, 0, 0, 0); }
}
__device__ __forceinline__ int v_st(int k, int c) { const int kk = (k & ~0xC) | ((k & 4) << 1) | ((k & 8) >> 1); return ((kk >> 3) * 4 + (c >> 5)) * 512 + ((kk & 7) * 32 + (c & 31)) * 2; }
__device__ __forceinline__ int v_rd_base(int lane) { return ((lane & 3) << 3) | (((lane >> 2) & 3) << 6) | (((lane >> 4) & 1) << 5) | (((lane >> 5) & 1) << 8); }
constexpr int v_rd_off(int d0, int ks, int half) { return d0 * 512 + ks * 4096 + half * 2048; }
template <int OFF> __device__ __forceinline__ s16x4 tr_read(int vb) {
  s16x4 r; asm volatile("ds_read_b64_tr_b16 %0, %1 offset:%2" : "=&v"(r) : "v"(vb), "i"(OFF) : "memory"); return r;
}
template <int D0> __device__ __forceinline__ void pv_one(f32x16& od, int vb, bf16x8 pa0, bf16x8 pa1, bf16x8 pa2, bf16x8 pa3) {
  const s16x4 l0 = tr_read<v_rd_off(D0, 0, 0)>(vb), h0 = tr_read<v_rd_off(D0, 0, 1)>(vb), l1 = tr_read<v_rd_off(D0, 1, 0)>(vb), h1 = tr_read<v_rd_off(D0, 1, 1)>(vb);
  const s16x4 l2 = tr_read<v_rd_off(D0, 2, 0)>(vb), h2 = tr_read<v_rd_off(D0, 2, 1)>(vb), l3 = tr_read<v_rd_off(D0, 3, 0)>(vb), h3 = tr_read<v_rd_off(D0, 3, 1)>(vb);
  asm volatile("s_waitcnt lgkmcnt(0)" ::: "memory"); SBAR();
#define PK(L, H) (bf16x8){L[0], L[1], L[2], L[3], H[0], H[1], H[2], H[3]}
  od = __builtin_amdgcn_mfma_f32_32x32x16_bf16(pa0, PK(l0, h0), od, 0, 0, 0);
  od = __builtin_amdgcn_mfma_f32_32x32x16_bf16(pa1, PK(l1, h1), od, 0, 0, 0);
  od = __builtin_amdgcn_mfma_f32_32x32x16_bf16(pa2, PK(l2, h2), od, 0, 0, 0);
  od = __builtin_amdgcn_mfma_f32_32x32x16_bf16(pa3, PK(l3, h3), od, 0, 0, 0);
#undef PK
}
__device__ __forceinline__ void pv_d0(f32x16* o, int vb, bf16x8 pa0, bf16x8 pa1, bf16x8 pa2, bf16x8 pa3) {
  pv_one<0>(o[0], vb, pa0, pa1, pa2, pa3); pv_one<1>(o[1], vb, pa0, pa1, pa2, pa3); pv_one<2>(o[2], vb, pa0, pa1, pa2, pa3); pv_one<3>(o[3], vb, pa0, pa1, pa2, pa3);
}

template <typename TQ>
__device__ __forceinline__ void attn_dense_body(const TQ* __restrict__ Qb, const bf16* __restrict__ Kh, const bf16* __restrict__ Vh,
                                                float* __restrict__ Ob, int seq, char* lds, int mode, float lam, unsigned short* o1buf) {
  using St = Stage<bf16>; using SQ = Stage<TQ>;
  const int tid = tidx(), wid = tid >> 6, lane = tid & 63, r32 = lane & 31, hi = lane >> 5;
  bf16* V_lds = (bf16*)lds; bf16* K_lds = (bf16*)(lds + 2 * SHM_V);
  float* ws = (float*)(lds + 2 * SHM_V + 2 * SHM_K) + wid * 64; float* li_l = ws; float* al_l = ws + 32;
  float m_reg = -1e30f, l_reg = 0; f32x16 o[4] = {}; bf16x8 qr[8];
  const TQ* Qw = Qb + (long)(wid * QBLK + r32) * LDQ + hi * 8;
#pragma unroll
  for (int d0 = 0; d0 < 8; ++d0) qr[d0] = SQ::tobf(SQ::ld8(Qw + d0 * 16));
  const int sr = tid >> 4, sc = (tid & 15) * 8, vst0 = v_st(sr, sc), vst1 = v_st(32 + sr, sc);
  const int vb0 = (int)(uintptr_t)V_lds + v_rd_base(lane);
  struct { typename St::T vs0, vs1, ks0, ks1; } sr_[SDEPTH];
#define SLOAD(i, k0) do { sr_[i].vs0 = St::ld8(&Vh[(long)((k0) + sr) * LDK + sc]); sr_[i].vs1 = St::ld8(&Vh[(long)((k0) + 32 + sr) * LDK + sc]); \
    sr_[i].ks0 = St::ld8(&Kh[(long)((k0) + sr) * LDK + sc]); sr_[i].ks1 = St::ld8(&Kh[(long)((k0) + 32 + sr) * LDK + sc]); } while (0)
#define SWRITE(b, i) do { *(bf16x8*)((char*)V_lds + (b) * SHM_V + vst0) = St::tobf(sr_[i].vs0);          \
    *(bf16x8*)((char*)V_lds + (b) * SHM_V + vst1) = St::tobf(sr_[i].vs1); int kc = sc * 2;               \
    *(bf16x8*)((char*)K_lds + (b) * SHM_K + KSWZ(sr, kc)) = St::tobf(sr_[i].ks0);                       \
    *(bf16x8*)((char*)K_lds + (b) * SHM_K + KSWZ(32 + sr, kc)) = St::tobf(sr_[i].ks1); } while (0)
#define SWAIT() do { if constexpr (SDEPTH == 2) asm volatile("s_waitcnt vmcnt(4)" ::: "memory"); else asm volatile("s_waitcnt vmcnt(0)" ::: "memory"); } while (0)
#define RESC(a) do { if (__any((a) < 1.f)) { if (hi == 0) al_l[r32] = (a); asm volatile("s_waitcnt lgkmcnt(0)" ::: "memory"); \
    for (int d = 0; d < 4; ++d) for (int r = 0; r < 16; ++r) o[d][r] *= al_l[crow(r, hi)]; } } while (0)
  f32x16 pA0, pA1, pB0, pB1; float mnA, mnB, alA, alB; bf16x8 pa0, pa1, pa2, pa3; const int NT = seq / KVBLK;
  constexpr int SE = 0, SO = SDEPTH - 1;
  SLOAD(SE, 0); asm volatile("s_waitcnt vmcnt(0)" ::: "memory"); SWRITE(0, SE); __syncthreads();
  qkt(pA0, pA1, K_lds, qr, r32, hi); partialSM(pA0, pA1, m_reg, mnA, alA);
  SLOAD(SO, KVBLK); if constexpr (SDEPTH == 2) { if (2 < NT) SLOAD(SE, 2 * KVBLK); }
  SWAIT(); SWRITE(1, SO); __syncthreads();
  for (int j = 1; j + 1 < NT; j += 2) {
    SBAR(); qkt(pB0, pB1, (bf16*)((char*)K_lds + SHM_K), qr, r32, hi);
    finishSM(pA0, pA1, alA, l_reg, pa0, pa1, pa2, pa3); SBAR();
    SLOAD(SO, (j + SDEPTH) * KVBLK); SBAR();
    pv_d0(o, vb0, pa0, pa1, pa2, pa3); partialSM(pB0, pB1, m_reg, mnB, alB);
    __syncthreads(); SWAIT(); SWRITE(0, SE);
    RESC(alB); __syncthreads();
    SBAR(); qkt(pA0, pA1, K_lds, qr, r32, hi);
    finishSM(pB0, pB1, alB, l_reg, pa0, pa1, pa2, pa3); SBAR();
    if (SDEPTH == 1 || j + 3 < NT) SLOAD(SE, (j + 1 + SDEPTH) * KVBLK); SBAR();
    pv_d0(o, vb0 + (int)SHM_V, pa0, pa1, pa2, pa3); partialSM(pA0, pA1, m_reg, mnA, alA);
    __syncthreads(); SWAIT(); SWRITE(1, SO);
    RESC(alA); __syncthreads();
  }
  SBAR(); qkt(pB0, pB1, (bf16*)((char*)K_lds + SHM_K), qr, r32, hi);
  finishSM(pA0, pA1, alA, l_reg, pa0, pa1, pa2, pa3); SBAR();
  pv_d0(o, vb0, pa0, pa1, pa2, pa3); partialSM(pB0, pB1, m_reg, mnB, alB);
  __syncthreads(); RESC(alB);
  finishSM(pB0, pB1, alB, l_reg, pa0, pa1, pa2, pa3); SBAR();
  pv_d0(o, vb0 + (int)SHM_V, pa0, pa1, pa2, pa3);
  if (hi == 0) li_l[r32] = l_reg; asm volatile("s_waitcnt lgkmcnt(0)" ::: "memory");
  float rli[16];
#pragma unroll
  for (int r = 0; r < 16; ++r) rli[r] = __builtin_amdgcn_rcpf(li_l[crow(r, hi)]);
  float* Ow = Ob + (long)(wid * QBLK) * LDO;
#pragma unroll
  for (int r = 0; r < 16; ++r) { int orow = crow(r, hi);
    for (int d0 = 0; d0 < 4; ++d0) { const float val = o[d0][r] * rli[r]; unsigned short* lp = o1buf + (wid * QBLK + orow) * 128 + d0 * 32 + r32;
      if (mode == 0) { *lp = (unsigned short)(cvtpk(val, val) & 0xffffu); } else { Ow[(long)orow * LDO + d0 * 32 + r32] = __uint_as_float(((unsigned)*lp) << 16) - lam * val; } } }
#undef SLOAD
#undef SWRITE
#undef SWAIT
#undef RESC
}

#undef KSWZ
#undef SBAR
}
#ifndef MK_NO_HELPER
#define MK_NO_HELPER 0
#endif
namespace mk {
using pg8::bf16_t; using pg8::f32x4; using pg8::u32x4; using pg8::cvt_pk_bf16; using pg8::Unit;
typedef unsigned u32x2 __attribute__((ext_vector_type(2)));
typedef float f32x2 __attribute__((ext_vector_type(2)));
constexpr int T = 16384, DM = 2048, FF = 5632, SEQ = 4096;
constexpr int NIN_REAL = 6176, NIN = 6400, NQKV = 6144;
constexpr int LDS_BYTES = 155648;
constexpr float EPS = 1e-6f;
constexpr float LAMBDA_INIT = 0.35550906759096924f;
#ifdef MK_DUP_PH
constexpr int NPHASE = 20;
#else
constexpr int NPHASE = 19;
#endif

constexpr size_t SZ_SMALL = (size_t)T * 32 * 4;
constexpr size_t SZ_GU = (size_t)2 * FF * DM * 2, SZ_D = (size_t)DM * FF * 2;
constexpr size_t WS_ROPE = 0, WS_BA = WS_ROPE + SZ_SMALL, WS_BG = WS_BA + SZ_SMALL;
constexpr size_t WS_SS = WS_BG + SZ_SMALL;
constexpr size_t WS_WGU = WS_SS + (size_t)1024 * 1024, WS_WD = WS_WGU + 4 * SZ_GU;
typedef unsigned long long u64;
constexpr float SSQ = 1048576.f, SSQ_INV = 1.f / 1048576.f;
constexpr size_t WS_WIN = WS_WD + 4 * SZ_D, WS_WOUT = WS_WIN + (size_t)NIN * DM * 2;
constexpr size_t WS_WQKV = WS_WOUT + (size_t)DM * DM * 2, WS_WO = WS_WQKV + (size_t)NQKV * DM * 2;
constexpr size_t WS_XN = WS_WO + (size_t)DM * DM * 2;
constexpr size_t WS_H = WS_XN + (size_t)T * DM * 2;
constexpr size_t WS_S = WS_H + (size_t)T * NIN * 2;
constexpr size_t SZ_T1K = (size_t)T * 1024 * 2;
constexpr size_t WS_END = WS_S + 5 * SZ_T1K;

struct Args { const float* in[29]; float* out; unsigned char* ws; int ph_lo, ph_hi; };
typedef const __attribute__((address_space(4))) Args* AP;

__device__ __forceinline__ float bflo(unsigned w) { return __uint_as_float(w << 16); }
__device__ __forceinline__ float bfhi(unsigned w) { return __uint_as_float(w & 0xffff0000u); }
__device__ __forceinline__ float sigm(float x) { return __builtin_amdgcn_rcpf(1.f + __expf(-x)); }
__device__ __forceinline__ float silu(float x) { return x * sigm(x); }
__device__ __forceinline__ float wave_sum(float v) {
#pragma unroll
  for (int m = 32; m >= 1; m >>= 1) v += __shfl_xor(v, m, 64);
  return v;
}

template <int CTRL> __device__ __forceinline__ float dpp_mov(float v) { return __int_as_float(__builtin_amdgcn_update_dpp(0, __float_as_int(v), CTRL, 0xF, 0xF, true)); }
__device__ __forceinline__ float row_sum8(float v) { v += dpp_mov<0xB1>(v); v += dpp_mov<0x4E>(v); v += dpp_mov<0x141>(v); return v; }
__device__ __forceinline__ float row_sum16(float v) { v += dpp_mov<0xB1>(v); v += dpp_mov<0x4E>(v); v += dpp_mov<0x141>(v); v += dpp_mov<0x140>(v); return v; }
__device__ __forceinline__ float dpp_row_bcast_sum4(float v) { float t = v + __shfl_xor(v, 16, 64); return t + __shfl_xor(t, 32, 64) - v; }
#define EPI_PIN() __builtin_amdgcn_sched_barrier(0)
struct EpiSwiglu { static constexpr bool PERM = true, AFTER_DRAIN = false; bf16_t* H; const u64* ss; int dup;
  __device__ __forceinline__ void operator()(const f32x4 (&acc)[2][2][4][2], const Unit& u, int wr, int wc, int fr, int fq) const {
    const int row0 = u.pm * 256 + wr * 64 + fr, col0 = u.pn * 128 + wc * 32 + 8 * fq;
    float rsv[2][4];
#pragma unroll
    for (int ai = 0; ai < 2; ++ai)
#pragma unroll
      for (int m = 0; m < 4; ++m) rsv[ai][m] = (float)ss[row0 + ai * 128 + m * 16] * SSQ_INV;
    EPI_PIN();
#pragma unroll
    for (int ai = 0; ai < 2; ++ai)
#pragma unroll
      for (int m = 0; m < 4; ++m) {
        const float rs = rsqrtf(rsv[ai][m] * (1.f / DM) + EPS);
        const f32x4 g0 = acc[ai][0][m][0] * rs, g1 = acc[ai][0][m][1] * rs, u0 = acc[ai][1][m][0] * rs, u1 = acc[ai][1][m][1] * rs;
        float h[8];
#pragma unroll
        for (int j = 0; j < 4; ++j) { h[j] = silu(g0[j]) * u0[j]; h[4 + j] = silu(g1[j]) * u1[j]; }
        u32x4 w; w[0] = cvt_pk_bf16(h[0], h[1]); w[1] = cvt_pk_bf16(h[2], h[3]); w[2] = cvt_pk_bf16(h[4], h[5]); w[3] = cvt_pk_bf16(h[6], h[7]);
#if MK_PROBE_NOSTORE
        if (!dup || w[0] == 0x12345678u)
#endif
        __builtin_nontemporal_store(w, (u32x4*)(H + (size_t)(row0 + ai * 128 + m * 16) * FF + col0));
      }
  }
};
struct EpiResid { static constexpr bool PERM = false, AFTER_DRAIN = false; AP a; int ph; int dup;
  __device__ __forceinline__ void operator()(const f32x4 (&acc)[2][2][4][2], const Unit& u, int wr, int wc, int fr, int fq) const {
    bf16_t* xb = (bf16_t*)(a->ws + WS_XN); const float* xin = a->in[0];
    const float scale = (ph == 7 || ph == 15) ? 1.f : 0.5f;
    const int nss = (ph == 2) ? 0 : (ph == 7) ? 1 : (ph == 9) ? 2 : (ph == 11) ? 3 : (ph == 15) ? 4 : 6;
    u64* ss = (u64*)(a->ws + WS_SS) + (size_t)nss * T;
    const int row0 = u.pm * 256 + wr * 64 + fr, col0 = u.pn * 256 + wc * 32 + 4 * fq;
#pragma unroll
    for (int ai = 0; ai < 2; ++ai) {
    u32x2 rb[4][2][2];
    if (ph != 2) {
#pragma unroll
      for (int m = 0; m < 4; ++m)
#pragma unroll
        for (int bj = 0; bj < 2; ++bj)
#pragma unroll
          for (int n = 0; n < 2; ++n) rb[m][bj][n] = *(const u32x2*)(xb + (size_t)(row0 + ai * 128 + m * 16) * DM + col0 + bj * 128 + n * 16);
    }
    EPI_PIN();
#pragma unroll
    for (int mh = 0; mh < 2; ++mh) {
      f32x4 r[2][2][2];
      if (ph == 2) {
#pragma unroll
        for (int m2 = 0; m2 < 2; ++m2)
#pragma unroll
          for (int bj = 0; bj < 2; ++bj)
#pragma unroll
            for (int n = 0; n < 2; ++n) r[m2][bj][n] = *(const f32x4*)(xin + (size_t)(row0 + ai * 128 + (mh * 2 + m2) * 16) * DM + col0 + bj * 128 + n * 16);
      } else {
#pragma unroll
        for (int m2 = 0; m2 < 2; ++m2)
#pragma unroll
          for (int bj = 0; bj < 2; ++bj)
#pragma unroll
            for (int n = 0; n < 2; ++n) { const u32x2 q = rb[mh * 2 + m2][bj][n]; r[m2][bj][n] = (f32x4){bflo(q[0]), bfhi(q[0]), bflo(q[1]), bfhi(q[1])}; }
      }
      EPI_PIN();
#pragma unroll
      for (int m2 = 0; m2 < 2; ++m2) {
        const int m = mh * 2 + m2;
        const size_t off = (size_t)(row0 + ai * 128 + m * 16) * DM + col0; float sq = 0.f;
#pragma unroll
        for (int bj = 0; bj < 2; ++bj)
#pragma unroll
          for (int n = 0; n < 2; ++n) { const f32x4 rr = r[m2][bj][n] + acc[ai][bj][m][n] * scale;
            u32x2 w; w[0] = cvt_pk_bf16(rr[0], rr[1]); w[1] = cvt_pk_bf16(rr[2], rr[3]); *(u32x2*)(xb + off + bj * 128 + n * 16) = w;
            const float y0 = bflo(w[0]), y1 = bfhi(w[0]), y2 = bflo(w[1]), y3 = bfhi(w[1]); sq += y0 * y0 + y1 * y1 + y2 * y2 + y3 * y3; }
        sq += dpp_row_bcast_sum4(sq); if (fq == 0) atomicAdd(ss + row0 + ai * 128 + m * 16, (u64)(sq * SSQ + 0.5f));
      }
      EPI_PIN();
    }
    }
  }
};
struct EpiP { static constexpr bool PERM = true, AFTER_DRAIN = false; bf16_t* P; float* BA; const u64* ss;
  __device__ __forceinline__ void operator()(const f32x4 (&acc)[2][2][4][2], const Unit& u, int wr, int wc, int fr, int fq) const {
    const int row0 = u.pm * 256 + wr * 64 + fr, col0 = u.pn * 256 + wc * 32 + 8 * fq;
    float rsv[2][4];
#pragma unroll
    for (int ai = 0; ai < 2; ++ai)
#pragma unroll
      for (int m = 0; m < 4; ++m) rsv[ai][m] = (float)ss[row0 + ai * 128 + m * 16] * SSQ_INV;
    EPI_PIN();
#pragma unroll
    for (int ai = 0; ai < 2; ++ai)
#pragma unroll
      for (int m = 0; m < 4; ++m) {
        const int row = row0 + ai * 128 + m * 16;
        const float rs = rsqrtf(rsv[ai][m] * (1.f / DM) + EPS);
#pragma unroll
        for (int bj = 0; bj < 2; ++bj) {
          const f32x4 a0 = acc[ai][bj][m][0] * rs, a1 = acc[ai][bj][m][1] * rs;
          u32x4 w; w[0] = cvt_pk_bf16(a0[0], a0[1]); w[1] = cvt_pk_bf16(a0[2], a0[3]); w[2] = cvt_pk_bf16(a1[0], a1[1]); w[3] = cvt_pk_bf16(a1[2], a1[3]);
          *(u32x4*)(P + (size_t)row * NIN + col0 + bj * 128) = w;
        }
        if (u.pn == 24 && wc == 0) { *(f32x4*)(BA + (size_t)row * 32 + 8 * fq) = acc[ai][0][m][0] * rs; *(f32x4*)(BA + (size_t)row * 32 + 8 * fq + 4) = acc[ai][0][m][1] * rs; }
      }
  }
};
struct EpiQKV { static constexpr bool PERM = false, AFTER_DRAIN = false; bf16_t* O; const float* rope; const u64* ss;
  __device__ __forceinline__ void operator()(const f32x4 (&acc)[2][2][4][2], const Unit& u, int wr, int wc, int fr, int fq) const {
    const int row0 = u.pm * 256 + wr * 64 + fr, col0 = u.pn * 256 + wc * 32 + 4 * fq;
    const bool rot = (wc == 0) && (u.pn < 16);
    float rsv[2][4];
#pragma unroll
    for (int ai = 0; ai < 2; ++ai)
#pragma unroll
      for (int m = 0; m < 4; ++m) rsv[ai][m] = (float)ss[row0 + ai * 128 + m * 16] * SSQ_INV;
#pragma unroll
    for (int ai = 0; ai < 2; ++ai) {
      f32x4 cv[4], sv[4];
#pragma unroll
      for (int m = 0; m < 4; ++m) { const size_t ro = (size_t)(row0 + ai * 128 + m * 16) * 32 + 4 * fq;
        cv[m] = rot ? *(const f32x4*)(rope + ro) : (f32x4){1.f, 1.f, 1.f, 1.f}; sv[m] = rot ? *(const f32x4*)(rope + ro + 16) : (f32x4){0.f, 0.f, 0.f, 0.f}; }
      EPI_PIN();
#pragma unroll
      for (int m = 0; m < 4; ++m) {
        const int row = row0 + ai * 128 + m * 16;
        const float rs = rsqrtf(rsv[ai][m] * (1.f / DM) + EPS);
#pragma unroll
        for (int bj = 0; bj < 2; ++bj) {
          f32x4 v0 = acc[ai][bj][m][0] * rs, v1 = acc[ai][bj][m][1] * rs;
          const f32x4 n0 = v0 * cv[m] - v1 * sv[m], n1 = v1 * cv[m] + v0 * sv[m];
          u32x2 w0, w1; w0[0] = cvt_pk_bf16(n0[0], n0[1]); w0[1] = cvt_pk_bf16(n0[2], n0[3]); w1[0] = cvt_pk_bf16(n1[0], n1[1]); w1[1] = cvt_pk_bf16(n1[2], n1[3]);
          bf16_t* p = O + (size_t)row * NQKV + col0 + bj * 128;
          *(u32x2*)p = w0; *(u32x2*)(p + 16) = w1;
        }
      }
      EPI_PIN();
    }
  }
};

__device__ __forceinline__ void xpose_mat(const float* __restrict__ W, int K, int N, bf16_t* __restrict__ Wt, int mode, float* tile, const float* __restrict__ gk = nullptr) {
  (void)tile;
  const int lane = tidx() & 63, wid = tidx() >> 6;
  const int nkt = K / 64, ntiles = nkt * (N / 32);
  for (int t = blockIdx.x * 8 + wid; t < ntiles; t += gridDim.x * 8) {
    const int nt = t / nkt, kt = t - nt * nkt, n = nt * 32 + (lane & 31), kb = kt * 64 + (lane >> 5) * 32;
    const float* src = W + (size_t)kb * N + n;
    float v[32];
#pragma unroll
    for (int i = 0; i < 32; ++i) v[i] = src[(size_t)i * N];
    int nd = n; if (mode == 1) nd = (n >> 7) * 256 + (n & 127); else if (mode == 2) nd = (n >> 7) * 256 + 128 + (n & 127);
#pragma unroll
    for (int q = 0; q < 4; ++q) {
      f32x4 g0 = {1.f, 1.f, 1.f, 1.f}, g1 = g0;
      if (gk) { g0 = *(const f32x4*)(gk + kb + 8 * q); g1 = *(const f32x4*)(gk + kb + 8 * q + 4); }
      u32x4 w; w[0] = cvt_pk_bf16(v[8 * q] * g0[0], v[8 * q + 1] * g0[1]); w[1] = cvt_pk_bf16(v[8 * q + 2] * g0[2], v[8 * q + 3] * g0[3]);
      w[2] = cvt_pk_bf16(v[8 * q + 4] * g1[0], v[8 * q + 5] * g1[1]); w[3] = cvt_pk_bf16(v[8 * q + 6] * g1[2], v[8 * q + 7] * g1[3]);
      *(u32x4*)(Wt + (size_t)nd * K + kb + 8 * q) = w;
    }
  }
}

constexpr int HT_FFN = (DM / 64) * (FF / 32);
constexpr int HT_SQ = (DM / 64) * (DM / 32), HT_QKV = (DM / 64) * (NQKV / 32);
#if MK_NO_HELPER
constexpr int HT_TOTAL = 0;
#else
constexpr int HT_TOTAL = 9 * HT_FFN + 2 * HT_SQ + HT_QKV;
#endif
struct HTile { const float* W; bf16_t* Wt; int gi; int K, N, mode, k0, n0; };
__device__ __forceinline__ HTile helper_decode(AP a, int id) {
  HTile t; t.mode = 0; t.gi = -1; int lt; unsigned char* ws = a->ws;
  if (id < 9 * HT_FFN) {
    const int mi = id / HT_FFN; lt = id - mi * HT_FFN; const int f = 1 + mi / 3, which = mi - (mi / 3) * 3, layer = f >> 1, second = f & 1;
    if (which == 2) { t.W = a->in[second ? 10 : 5] + (size_t)layer * DM * FF; t.K = FF; t.N = DM; t.Wt = (bf16_t*)(ws + WS_WD + (size_t)f * SZ_D); }
    else { t.W = a->in[which ? (second ? 9 : 4) : (second ? 8 : 3)] + (size_t)layer * DM * FF; t.K = DM; t.N = FF; t.Wt = (bf16_t*)(ws + WS_WGU + (size_t)f * SZ_GU); t.mode = 1 + which; t.gi = f - 1; }
  } else if (id < 9 * HT_FFN + HT_SQ) { lt = id - 9 * HT_FFN; t.W = a->in[20]; t.K = DM; t.N = DM; t.Wt = (bf16_t*)(ws + WS_WOUT); }
  else if (id < 9 * HT_FFN + HT_SQ + HT_QKV) { lt = id - 9 * HT_FFN - HT_SQ; t.W = a->in[21]; t.K = DM; t.N = NQKV; t.Wt = (bf16_t*)(ws + WS_WQKV); t.gi = 3; }
  else { lt = id - 9 * HT_FFN - HT_SQ - HT_QKV; t.W = a->in[27]; t.K = DM; t.N = DM; t.Wt = (bf16_t*)(ws + WS_WO); }
  const int nkt = t.K / 64, nt = lt / nkt, kt = lt - nt * nkt; t.k0 = kt * 64; t.n0 = nt * 32;
  return t;
}
__device__ __forceinline__ void helper_issue(AP a, int id, float (&v)[32], int lane) {
  const HTile t = helper_decode(a, id);
  const float* src = t.W + (size_t)(t.k0 + (lane >> 5) * 32) * t.N + t.n0 + (lane & 31);
#pragma unroll
  for (int i = 0; i < 32; ++i) v[i] = src[(size_t)i * t.N];
}
__device__ __forceinline__ void helper_finish(AP a, int id, const float (&v)[32], float* wtile, const float* gains, int lane) {
  const HTile t = helper_decode(a, id); (void)wtile;
  const int n = t.n0 + (lane & 31), kb = t.k0 + (lane >> 5) * 32;
  int nd = n; if (t.mode == 1) nd = (n >> 7) * 256 + (n & 127); else if (t.mode == 2) nd = (n >> 7) * 256 + 128 + (n & 127);
#pragma unroll
  for (int q = 0; q < 4; ++q) {
    f32x4 g0 = {1.f, 1.f, 1.f, 1.f}, g1 = g0;
    if (t.gi >= 0) { const float* gp = gains + t.gi * DM + kb + 8 * q; g0 = *(const f32x4*)gp; g1 = *(const f32x4*)(gp + 4); }
    u32x4 w; w[0] = cvt_pk_bf16(v[8 * q] * g0[0], v[8 * q + 1] * g0[1]); w[1] = cvt_pk_bf16(v[8 * q + 2] * g0[2], v[8 * q + 3] * g0[3]);
    w[2] = cvt_pk_bf16(v[8 * q + 4] * g1[0], v[8 * q + 5] * g1[1]); w[3] = cvt_pk_bf16(v[8 * q + 6] * g1[2], v[8 * q + 7] * g1[3]);
    *(u32x4*)(t.Wt + (size_t)nd * t.K + kb + 8 * q) = w;
  }
}

__device__ __forceinline__ void cast_phase(const float* __restrict__ X, bf16_t* __restrict__ XB, u64* __restrict__ ss) {
  const int lane = tidx() & 63, wid = tidx() >> 6;
  for (int row = blockIdx.x * 8 + wid; row < T; row += gridDim.x * 8) {
    const float* xr = X + (size_t)row * DM;
    f32x4 v[8]; float sq = 0.f;
#pragma unroll
    for (int i = 0; i < 8; ++i) v[i] = *(const f32x4*)(xr + (i * 64 + lane) * 4);
#pragma unroll
    for (int i = 0; i < 8; ++i) { u32x2 w; w[0] = cvt_pk_bf16(v[i][0], v[i][1]); w[1] = cvt_pk_bf16(v[i][2], v[i][3]); *(u32x2*)(XB + (size_t)row * DM + (i * 64 + lane) * 4) = w;
      const float y0 = bflo(w[0]), y1 = bfhi(w[0]), y2 = bflo(w[1]), y3 = bfhi(w[1]); sq += y0 * y0 + y1 * y1 + y2 * y2 + y3 * y3; }
    sq = wave_sum(sq);
    if (lane == 0) ss[row] = (u64)(sq * SSQ + 0.5f);
  }
}
__device__ __forceinline__ void final_phase(const bf16_t* __restrict__ XB, const u64* __restrict__ ss, const float* __restrict__ g, float* __restrict__ out) {
  const int lane = tidx() & 63, wid = tidx() >> 6;
  for (int row = blockIdx.x * 8 + wid; row < T; row += gridDim.x * 8) {
    const float rstd = rsqrtf((float)ss[row] * SSQ_INV * (1.f / DM) + EPS);
    u32x4 xv[4];
#pragma unroll
    for (int i = 0; i < 4; ++i) xv[i] = *(const u32x4*)(XB + (size_t)row * DM + (i * 64 + lane) * 8);
#pragma unroll
    for (int i = 0; i < 4; ++i) { const int c = (i * 64 + lane) * 8; const f32x4 g0 = *(const f32x4*)(g + c), g1 = *(const f32x4*)(g + c + 4);
      const f32x4 y0 = (f32x4){bflo(xv[i][0]), bfhi(xv[i][0]), bflo(xv[i][1]), bfhi(xv[i][1])} * rstd * g0, y1 = (f32x4){bflo(xv[i][2]), bfhi(xv[i][2]), bflo(xv[i][3]), bfhi(xv[i][3])} * rstd * g1;
      *(f32x4*)(out + (size_t)row * DM + c) = y0; *(f32x4*)(out + (size_t)row * DM + c + 4) = y1; }
  }
}

__device__ __forceinline__ void prologue(AP a, unsigned char* lds) {
  unsigned char* ws = a->ws;
  float* tile = (float*)lds;
  for (int f = 0; f < (MK_NO_HELPER ? 4 : 1); ++f) {
    const int layer = f >> 1, which = f & 1;
    const float* wg = a->in[which ? 8 : 3] + (size_t)layer * DM * FF; const float* wu = a->in[which ? 9 : 4] + (size_t)layer * DM * FF; const float* wd = a->in[which ? 10 : 5] + (size_t)layer * DM * FF;
    const float* gn = a->in[which ? 7 : 2] + (size_t)layer * DM;
    xpose_mat(wg, DM, FF, (bf16_t*)(ws + WS_WGU + f * SZ_GU), 1, tile, gn);
    xpose_mat(wu, DM, FF, (bf16_t*)(ws + WS_WGU + f * SZ_GU), 2, tile, gn);
    xpose_mat(wd, FF, DM, (bf16_t*)(ws + WS_WD + f * SZ_D), 0, tile);
  }
  xpose_mat(a->in[11], DM, NIN_REAL, (bf16_t*)(ws + WS_WIN), 0, tile, a->in[6]);
#if MK_NO_HELPER
  xpose_mat(a->in[20], DM, DM, (bf16_t*)(ws + WS_WOUT), 0, tile);
  xpose_mat(a->in[21], DM, NQKV, (bf16_t*)(ws + WS_WQKV), 0, tile, a->in[6] + DM);
  xpose_mat(a->in[27], DM, DM, (bf16_t*)(ws + WS_WO), 0, tile);
#endif
  const size_t gtid = (size_t)blockIdx.x * 512 + tidx(), gn = (size_t)gridDim.x * 512;
  { u32x4* p = (u32x4*)(ws + WS_WIN + (size_t)NIN_REAL * DM * 2); const size_t n16 = (size_t)(NIN - NIN_REAL) * DM * 2 / 16; unsigned zz = 0u; asm volatile("" : "+v"(zz)); const u32x4 z = {zz, zz, zz, zz};
    for (size_t i = gtid; i < n16; i += gn) p[i] = z; }
  { u64* ssz = (u64*)(ws + WS_SS); for (size_t i = gtid; i < (size_t)6 * T; i += gn) ssz[i < (size_t)5 * T ? i : i + T] = 0ull; }
  { float* rope = (float*)(ws + WS_ROPE); const int* pos = (const int*)a->in[1];
    for (size_t i = gtid; i < (size_t)T * 16; i += gn) {
      const int tok = (int)(i >> 4), j = (int)(i & 15);
      const float inv = exp2f(-(float)j * (18.931568569324174f / 16.f));
      double rev = (double)pos[tok] * (double)inv * 0.15915494309189535; rev -= floor(rev);
      const float fr = (float)rev;
      rope[(size_t)tok * 32 + j] = __builtin_amdgcn_cosf(fr); rope[(size_t)tok * 32 + 16 + j] = __builtin_amdgcn_sinf(fr);
    } }
  cast_phase(a->in[0], (bf16_t*)(ws + WS_XN), (u64*)(ws + WS_SS) + (size_t)5 * T);
}

__device__ __forceinline__ void conv_module(AP a, unsigned char* lds) {
  const bf16_t* P = (const bf16_t*)(a->ws + WS_H); bf16_t* CAT = (bf16_t*)(a->ws + WS_S);
  unsigned* glu = (unsigned*)lds; float* part = (float*)(lds + 62 * 512 * 4); float* stats = part + 512;
  const int tid = tidx(), lane = tid & 63, wid = tid >> 6, c0 = 2 * tid;
  const float* cw = a->in[12];
  float w0[31], w1[31];
#pragma unroll
  for (int j = 0; j < 31; ++j) { const f32x2 t = *(const f32x2*)(cw + j * 1024 + c0); w0[j] = t[0]; w1[j] = t[1]; }
  const f32x2 cb = *(const f32x2*)(a->in[13] + c0), lg = *(const f32x2*)(a->in[14] + c0), lb = *(const f32x2*)(a->in[15] + c0);
  for (int tile = blockIdx.x; tile < T / 32; tile += gridDim.x) {
    const int tok0 = tile * 32, s0 = tok0 & (SEQ - 1);
    for (int r0 = 0; r0 < 64; r0 += 8) {
      unsigned pv[8], pg[8];
#pragma unroll
      for (int i = 0; i < 8; ++i) { const int r = r0 + i, s = s0 - 15 + r; const bool ok = (r < 62) && s >= 0 && s < SEQ;
        const bf16_t* pr = P + (size_t)(ok ? tok0 - 15 + r : tok0) * NIN + c0; pv[i] = *(const unsigned*)pr; pg[i] = *(const unsigned*)(pr + 1024); }
#pragma unroll
      for (int i = 0; i < 8; ++i) { const int r = r0 + i, s = s0 - 15 + r; const bool ok = s >= 0 && s < SEQ;
        const unsigned val = ok ? cvt_pk_bf16(bflo(pv[i]) * sigm(bflo(pg[i])), bfhi(pv[i]) * sigm(bfhi(pg[i]))) : 0u;
        if (r < 62) glu[r * 512 + tid] = val; }
    }
#pragma unroll 1
    for (int tt = 0; tt < 32; ++tt) {
      float o0 = cb[0], o1 = cb[1];
#pragma unroll
      for (int j = 0; j < 31; ++j) { const unsigned u = glu[(tt + j) * 512 + tid]; o0 += w0[j] * bflo(u); o1 += w1[j] * bfhi(u); }
      const float s = wave_sum(o0 + o1), q = wave_sum(o0 * o0 + o1 * o1);
      if (lane == 0) { part[(wid * 32 + tt) * 2] = s; part[(wid * 32 + tt) * 2 + 1] = q; }
    }
    __syncthreads();
    if (tid < 32) { float s = 0.f, q = 0.f;
      for (int w = 0; w < 8; ++w) { s += part[(w * 32 + tid) * 2]; q += part[(w * 32 + tid) * 2 + 1]; }
      const float mean = s * (1.f / 1024.f), var = fmaxf(q * (1.f / 1024.f) - mean * mean, 0.f);
      stats[tid * 2] = mean; stats[tid * 2 + 1] = rsqrtf(var + EPS); }
    __syncthreads();
#pragma unroll 1
    for (int tt = 0; tt < 32; ++tt) {
      float o0 = cb[0], o1 = cb[1];
#pragma unroll
      for (int j = 0; j < 31; ++j) { const unsigned u = glu[(tt + j) * 512 + tid]; o0 += w0[j] * bflo(u); o1 += w1[j] * bfhi(u); }
      const float mean = stats[tt * 2], rstd = stats[tt * 2 + 1];
      const float y0 = (o0 - mean) * rstd * lg[0] + lb[0], y1 = (o1 - mean) * rstd * lg[1] + lb[1];
      *(unsigned*)(CAT + (size_t)(tok0 + tt) * DM + c0) = cvt_pk_bf16(silu(y0), silu(y1));
    }
    __syncthreads();
  }
}

__device__ __forceinline__ void dn_prep(AP a) {
  const bf16_t* P = (const bf16_t*)(a->ws + WS_H);
  bf16_t* QN = (bf16_t*)(a->ws + WS_S); bf16_t* KN = (bf16_t*)(a->ws + WS_S + SZ_T1K); bf16_t* VS = (bf16_t*)(a->ws + WS_S + 2 * SZ_T1K);
  const float* sw = a->in[16];
  const int lane = tidx() & 63, wid = tidx() >> 6;
  for (int tok = blockIdx.x * 8 + wid; tok < T; tok += gridDim.x * 8) {
    const int s = tok & (SEQ - 1);
#pragma unroll 1
    for (int sb = 0; sb < 24; sb += 4) {
      unsigned x0[4], xm[4], xp[4]; f32x2 wa[4], wb[4], wc[4];
#pragma unroll
      for (int i = 0; i < 4; ++i) { const int c = (sb + i) * 128 + 2 * lane; const bf16_t* pr = P + (size_t)tok * NIN + 2048 + c;
        x0[i] = *(const unsigned*)pr; xm[i] = *(const unsigned*)(pr - (s > 0 ? NIN : 0)); xp[i] = *(const unsigned*)(pr + (s < SEQ - 1 ? NIN : 0));
        wa[i] = *(const f32x2*)(sw + c); wb[i] = *(const f32x2*)(sw + 3072 + c); wc[i] = *(const f32x2*)(sw + 6144 + c); }
#pragma unroll
      for (int i = 0; i < 4; ++i) { const int slot = sb + i;
        const unsigned um = (s > 0) ? xm[i] : 0u, up = (s < SEQ - 1) ? xp[i] : 0u;
        float y0 = wa[i][0] * bflo(um) + wb[i][0] * bflo(x0[i]) + wc[i][0] * bflo(up), y1 = wa[i][1] * bfhi(um) + wb[i][1] * bfhi(x0[i]) + wc[i][1] * bfhi(up);
        y0 = silu(y0); y1 = silu(y1);
        if (slot < 16) { const float ss = wave_sum(y0 * y0 + y1 * y1); float r = rsqrtf(ss + EPS); if (slot < 8) r *= 0.08838834764831845f; y0 *= r; y1 *= r; }
        bf16_t* dst = (slot < 8 ? QN : (slot < 16 ? KN : VS)) + (size_t)tok * 1024 + (slot & 7) * 128 + 2 * lane;
        *(unsigned*)dst = cvt_pk_bf16(y0, y1); }
    }
  }
  const float* BA = (const float*)(a->ws + WS_BA); float* BG = (float*)(a->ws + WS_BG);
  for (size_t i = (size_t)blockIdx.x * 512 + tidx(); i < (size_t)T * 16; i += (size_t)gridDim.x * 512) {
    const int tok = (int)(i >> 4), j = (int)(i & 15);
    const float braw = BA[(size_t)tok * 32 + j], araw = BA[(size_t)tok * 32 + 16 + j];
    const float xx = araw + a->in[18][j]; const float sp = xx > 20.f ? xx : log1pf(expf(xx));
    const float g = -expf(a->in[17][j]) * sp;
    BG[(size_t)tok * 32 + j] = sigm(braw); BG[(size_t)tok * 32 + 16 + j] = expf(g);
  }
}

__device__ __forceinline__ void scan_phase(AP a, unsigned char* lds) {
  const bf16_t* QN = (const bf16_t*)(a->ws + WS_S); const bf16_t* KN = (const bf16_t*)(a->ws + WS_S + SZ_T1K); const bf16_t* VS = (const bf16_t*)(a->ws + WS_S + 2 * SZ_T1K);
  const float* BG = (const float*)(a->ws + WS_BG);
  constexpr int BUF_F = 32 * 128 * 2 + 32 * 32 + 64;
  float* sb = (float*)lds; float* ob = sb + 2 * BUF_F;
  float* dump = ob + 2048 + (tidx() & 255);
  float* wtile = (float*)(lds + 86016) + ((tidx() >> 6) & 3) * (64 * 33);
  int hid = (int)blockIdx.x * 4 + ((tidx() >> 6) & 3); const int hstep = (int)gridDim.x * 4;
  float* gains = (float*)(lds + 119808);
  for (int i = tidx(); i < 4 * DM; i += 512) { const int v = i >> 11, k = i & (DM - 1); gains[i] = (v == 0) ? a->in[7][k] : (v == 1) ? a->in[2][DM + k] : (v == 2) ? a->in[7][DM + k] : a->in[6][DM + k]; }
  __syncthreads();
  int hprev = -1; float hv[32];
#pragma unroll
  for (int i = 0; i < 32; ++i) hv[i] = 0.f;
  const int tid = tidx(), lane = tid & 63, wid = tid >> 6, j = lane & 7, col = (wid & 3) * 8 + (lane >> 3);
  const int tl = tid >> 4, c8 = (tid & 15) * 8, tlv = (tid >> 2) & 31, cv = (tid & 3) * 8;
  for (int item = blockIdx.x; item < 256; item += gridDim.x) {
    const int cb = item & 3, dir = (item >> 2) & 1, h = (item >> 3) & 7, b = item >> 6;
    bf16_t* OD = (bf16_t*)(a->ws + WS_S + (3 + dir) * SZ_T1K);
    f32x2 S2[8];
#pragma unroll
    for (int i = 0; i < 8; ++i) S2[i] = (f32x2){0.f, 0.f};
    u32x4 kr, qr, vr; float ar = 0.f, br = 0.f;
#define SC_TOK(c, t) (b * SEQ + (dir ? (SEQ - 1 - ((c) * 32 + (t))) : ((c) * 32 + (t))))
#define SC_LOAD(c) do { const size_t tk = (size_t)SC_TOK(c, tl); kr = *(const u32x4*)(KN + tk * 1024 + h * 128 + c8); qr = *(const u32x4*)(QN + tk * 1024 + h * 128 + c8); \
      if (tid < 128) vr = *(const u32x4*)(VS + (size_t)SC_TOK(c, tlv) * 1024 + h * 128 + cb * 32 + cv); \
      else if (tid < 160) { const size_t t2 = (size_t)SC_TOK(c, tid - 128); br = BG[t2 * 32 + dir * 8 + h]; ar = BG[t2 * 32 + 16 + dir * 8 + h]; } } while (0)
#define SC_WRITE(bi) do { float* kb = sb + (bi) * BUF_F; float* qb = kb + 4096; float* vb = qb + 4096; float* abp = vb + 1024; \
      *(f32x4*)(kb + tl * 128 + c8) = (f32x4){bflo(kr[0]), bfhi(kr[0]), bflo(kr[1]), bfhi(kr[1])}; *(f32x4*)(kb + tl * 128 + c8 + 4) = (f32x4){bflo(kr[2]), bfhi(kr[2]), bflo(kr[3]), bfhi(kr[3])}; \
      *(f32x4*)(qb + tl * 128 + c8) = (f32x4){bflo(qr[0]), bfhi(qr[0]), bflo(qr[1]), bfhi(qr[1])}; *(f32x4*)(qb + tl * 128 + c8 + 4) = (f32x4){bflo(qr[2]), bfhi(qr[2]), bflo(qr[3]), bfhi(qr[3])}; \
      if (tid < 128) { *(f32x4*)(vb + tlv * 32 + cv) = (f32x4){bflo(vr[0]), bfhi(vr[0]), bflo(vr[1]), bfhi(vr[1])}; *(f32x4*)(vb + tlv * 32 + cv + 4) = (f32x4){bflo(vr[2]), bfhi(vr[2]), bflo(vr[3]), bfhi(vr[3])}; } \
      else if (tid < 160) { abp[(tid - 128) * 2] = ar; abp[(tid - 128) * 2 + 1] = br; } } while (0)
#define SC_FLUSH(c) do { if (tid < 128) { const float* op = ob + ((c) & 1) * 1024 + tlv * 32 + cv; const f32x4 x0 = *(const f32x4*)op, x1 = *(const f32x4*)(op + 4); \
      u32x4 w; w[0] = cvt_pk_bf16(x0[0], x0[1]); w[1] = cvt_pk_bf16(x0[2], x0[3]); w[2] = cvt_pk_bf16(x1[0], x1[1]); w[3] = cvt_pk_bf16(x1[2], x1[3]); \
      *(u32x4*)(OD + (size_t)SC_TOK(c, tlv) * 1024 + h * 128 + cb * 32 + cv) = w; } } while (0)
    __syncthreads();
    SC_LOAD(0); SC_WRITE(0); __syncthreads();
    for (int c = 0; c < SEQ / 32; ++c) {
      if (c + 1 < SEQ / 32) SC_LOAD(c + 1);
      if (c > 0) SC_FLUSH(c - 1);
      const float* kb = sb + (c & 1) * BUF_F; const float* qb = kb + 4096; const float* vb = qb + 4096; const float* abp = vb + 1024; float* obc = ob + (c & 1) * 1024;
      if (wid < 4) {
        f32x4 kv[4], qv[4]; f32x2 ab2; float vv;
#define SC_LD(t) do { _Pragma("unroll") for (int i = 0; i < 4; ++i) { kv[i] = *(const f32x4*)(kb + (t) * 128 + 16 * j + 4 * i); qv[i] = *(const f32x4*)(qb + (t) * 128 + 16 * j + 4 * i); } \
          ab2 = *(const f32x2*)(abp + (t) * 2); vv = vb[(t) * 32 + col]; } while (0)
        SC_LD(0);
#pragma unroll 8
        for (int t = 0; t < 32; ++t) {
          f32x2 kk[8], qq[8];
#pragma unroll
          for (int i = 0; i < 4; ++i) { kk[2 * i] = (f32x2){kv[i][0], kv[i][1]}; kk[2 * i + 1] = (f32x2){kv[i][2], kv[i][3]}; qq[2 * i] = (f32x2){qv[i][0], qv[i][1]}; qq[2 * i + 1] = (f32x2){qv[i][2], qv[i][3]}; }
          const float al = ab2[0], bt = ab2[1], vc = vv;
          SC_LD((t + 1) & 31);
          f32x2 d0 = S2[0] * kk[0], d1 = S2[1] * kk[1];
#pragma unroll
          for (int i = 1; i < 4; ++i) { d0 = S2[2 * i] * kk[2 * i] + d0; d1 = S2[2 * i + 1] * kk[2 * i + 1] + d1; }
          d0 = d0 + d1;
          const float d = row_sum8(d0[0] + d0[1]);
          const float dl = bt * (vc - al * d);
          const f32x2 dl2 = {dl, dl}, al2 = {al, al};
#pragma unroll
          for (int i = 0; i < 8; ++i) S2[i] = kk[i] * dl2 + S2[i] * al2;
          f32x2 o0 = S2[0] * qq[0], o1 = S2[1] * qq[1];
#pragma unroll
          for (int i = 1; i < 4; ++i) { o0 = S2[2 * i] * qq[2 * i] + o0; o1 = S2[2 * i + 1] * qq[2 * i + 1] + o1; }
          o0 = o0 + o1;
          const float od = row_sum8(o0[0] + o0[1]);
          *((j == 0) ? (obc + t * 32 + col) : dump) = od;
        }
#undef SC_LD
      } else {
        if (hprev >= 0) helper_finish(a, hprev, hv, wtile, gains, lane);
        if (hid < HT_TOTAL) { helper_issue(a, hid, hv, lane); hprev = hid; hid += hstep; } else hprev = -1;
      }
      if (c + 1 < SEQ / 32) SC_WRITE((c + 1) & 1);
      asm volatile("s_waitcnt lgkmcnt(0)" ::: "memory"); __builtin_amdgcn_s_barrier(); asm volatile("" ::: "memory");
    }
    SC_FLUSH(SEQ / 32 - 1);
    __syncthreads();
#undef SC_TOK
#undef SC_LOAD
#undef SC_WRITE
#undef SC_FLUSH
  }
  if (wid >= 4) { if (hprev >= 0) helper_finish(a, hprev, hv, wtile, gains, lane); for (; hid < HT_TOTAL; hid += hstep) { helper_issue(a, hid, hv, lane); helper_finish(a, hid, hv, wtile, gains, lane); } }
}

__device__ __forceinline__ void gnorm_phase(AP a) {
  const bf16_t* P = (const bf16_t*)(a->ws + WS_H); bf16_t* CAT = (bf16_t*)(a->ws + WS_S);
  const bf16_t* OF = (const bf16_t*)(a->ws + WS_S + 3 * SZ_T1K); const bf16_t* OB = (const bf16_t*)(a->ws + WS_S + 4 * SZ_T1K);
  const int lane = tidx() & 63, wid = tidx() >> 6;
  const f32x2 g = *(const f32x2*)(a->in[19] + 2 * lane);
  for (int tok = blockIdx.x * 8 + wid; tok < T; tok += gridDim.x * 8) {
    unsigned uf[8], ub[8], uz[8];
#pragma unroll
    for (int h = 0; h < 8; ++h) { const size_t o = (size_t)tok * 1024 + h * 128 + 2 * lane;
      uf[h] = *(const unsigned*)(OF + o); ub[h] = *(const unsigned*)(OB + o); uz[h] = *(const unsigned*)(P + (size_t)tok * NIN + 5120 + h * 128 + 2 * lane); }
#pragma unroll
    for (int h = 0; h < 8; ++h) {
      const float o0 = bflo(uf[h]) + bflo(ub[h]), o1 = bfhi(uf[h]) + bfhi(ub[h]);
      const float ss = wave_sum(o0 * o0 + o1 * o1), rstd = rsqrtf(ss * (1.f / 128.f) + EPS);
      const float y0 = o0 * rstd * g[0] * silu(bflo(uz[h])), y1 = o1 * rstd * g[1] * silu(bfhi(uz[h]));
      *(unsigned*)(CAT + (size_t)tok * DM + 1024 + h * 128 + 2 * lane) = cvt_pk_bf16(y0, y1);
    }
  }
}

__device__ __forceinline__ void attn_phase(AP a, unsigned char* lds) {
  const bf16_t* QKV = (const bf16_t*)(a->ws + WS_H); float* OA = (float*)(a->ws + WS_S);
  const int lane = tidx() & 63;
  const float s1 = wave_sum(a->in[22][lane] * a->in[23][lane] + a->in[22][lane + 64] * a->in[23][lane + 64]);
  const float s2 = wave_sum(a->in[24][lane] * a->in[25][lane] + a->in[24][lane + 64] * a->in[25][lane + 64]);
  const float lam = __int_as_float(__builtin_amdgcn_readfirstlane(__float_as_int(expf(s1) - expf(s2) + LAMBDA_INIT)));
  int seq = SEQ; asm volatile("" : "+s"(seq));
  const int nk = (512 - (int)blockIdx.x + (int)gridDim.x - 1) / (int)gridDim.x;
#pragma unroll 1
  for (int it = 0; it < 4 * nk; ++it) {
    const int item = blockIdx.x + gridDim.x * (it >> 2), m = it & 1, vh = (it >> 1) & 1;
    const int h = item & 7, qb = (item >> 3) & 15, b = item >> 7;
    const size_t tok0 = (size_t)b * SEQ + qb * 256, kv0 = (size_t)b * SEQ;
    att::attn_dense_body<att::bf16>(QKV + tok0 * NQKV + h * 256 + m * 128, QKV + kv0 * NQKV + 2048 + h * 256 + m * 128, QKV + kv0 * NQKV + 4096 + h * 256 + vh * 128,
                                    OA + tok0 * DM + h * 256 + vh * 128, seq, (char*)lds, m, lam, (unsigned short*)(lds + 69632));
    __syncthreads();
    if ((it & 3) == 3) {
      asm volatile("s_waitcnt vmcnt(0)" ::: "memory");
      const int wv = tidx() >> 6, ln = tidx() & 63; bf16_t* CAT = (bf16_t*)a->out;
      const f32x4 sg = *(const f32x4*)(a->in[26] + 4 * ln);
#pragma unroll 4
      for (int r = 0; r < 32; ++r) {
        const size_t o = (tok0 + wv * 32 + r) * DM + h * 256 + 4 * ln;
        const f32x4 v = *(const f32x4*)(OA + o);
        const float ss = wave_sum(v[0] * v[0] + v[1] * v[1] + v[2] * v[2] + v[3] * v[3]), rr = rsqrtf(ss * (1.f / 256.f) + EPS) * (1.f - LAMBDA_INIT);
        u32x2 w; w[0] = cvt_pk_bf16(v[0] * rr * sg[0], v[1] * rr * sg[1]); w[1] = cvt_pk_bf16(v[2] * rr * sg[2], v[3] * rr * sg[3]);
        *(u32x2*)(CAT + o) = w;
      }
    }
  }
}
__device__ __forceinline__ void subln_phase(AP a) {
  const float* OA = (const float*)(a->ws + WS_S); bf16_t* CAT = (bf16_t*)(a->ws + WS_H);
  const int lane = tidx() & 63, wid = tidx() >> 6;
  const f32x4 g = *(const f32x4*)(a->in[26] + 4 * lane);
  for (int task = blockIdx.x * 8 + wid; task < T * 8; task += gridDim.x * 8) {
    const size_t o = (size_t)(task >> 3) * DM + (task & 7) * 256 + 4 * lane;
    const f32x4 v = *(const f32x4*)(OA + o);
    const float ss = wave_sum(v[0] * v[0] + v[1] * v[1] + v[2] * v[2] + v[3] * v[3]), r = rsqrtf(ss * (1.f / 256.f) + EPS) * (1.f - LAMBDA_INIT);
    u32x2 w; w[0] = cvt_pk_bf16(v[0] * r * g[0], v[1] * r * g[1]); w[1] = cvt_pk_bf16(v[2] * r * g[2], v[3] * r * g[3]);
    *(u32x2*)(CAT + o) = w;
  }
}

enum { PT_PRO, PT_GU, PT_RES, PT_NORM, PT_IN, PT_CONV, PT_SCAN, PT_GNORM, PT_QKV, PT_ATTN, PT_SUBLN, PT_FINAL };

__global__ void __launch_bounds__(512, 2) mega(Args a_kernarg) {
  extern __shared__ __attribute__((aligned(16))) unsigned char lds[];
  cg::grid_group grid = cg::this_grid();
  const AP a0 = (AP)__builtin_amdgcn_kernarg_segment_ptr();
  const int ph_lo = a0->ph_lo, ph_hi = a0->ph_hi;
  for (int php = ph_lo; php < ph_hi; ++php) {
    int ph = php;
#ifndef MK_DUP_PH
#define DUP2 0
#else
#define DUP2 (int)dup2
#endif
#ifdef MK_DUP_PH
    bool dup2 = false;
    if (php > MK_DUP_PH) { ph = php - 1; dup2 = (php == MK_DUP_PH + 1); }
#endif
    unsigned long long apv = (unsigned long long)a0; asm volatile("" : "+s"(apv)); const AP a = (AP)apv;
    unsigned char* ws = a->ws;
    int type = PT_PRO, f = 0, nss = -1;
    const bf16_t* gA = (const bf16_t*)(ws + WS_H); const bf16_t* gB = nullptr; int gK = FF;
    switch (ph) {
      case 0: type = PT_PRO; break;
      case 1: type = PT_GU; f = 0; nss = 5; break;
      case 2: type = PT_RES; gB = (const bf16_t*)(ws + WS_WD); nss = 0; break;
      case 3: type = PT_IN; nss = 0; break;
      case 4: type = PT_CONV; break;
      case 5: type = PT_SCAN; break;
      case 6: type = PT_GNORM; break;
      case 7: type = PT_RES; gA = (const bf16_t*)(ws + WS_S); gB = (const bf16_t*)(ws + WS_WOUT); gK = DM; nss = 1; break;
      case 8: type = PT_GU; f = 1; nss = 1; break;
      case 9: type = PT_RES; gB = (const bf16_t*)(ws + WS_WD + 1 * SZ_D); nss = 2; break;
      case 10: type = PT_GU; f = 2; nss = 2; break;
      case 11: type = PT_RES; gB = (const bf16_t*)(ws + WS_WD + 2 * SZ_D); nss = 3; break;
      case 12: type = PT_QKV; nss = 3; break;
      case 13: type = PT_ATTN; break;
      case 14: type = PT_SUBLN; break;
      case 15: type = PT_RES; gA = (const bf16_t*)a->out; gB = (const bf16_t*)(ws + WS_WO); gK = DM; nss = 4; break;
      case 16: type = PT_GU; f = 3; nss = 4; break;
      case 17: type = PT_RES; gB = (const bf16_t*)(ws + WS_WD + 3 * SZ_D); break;
      default: type = PT_FINAL; break;
    }
    const u64* ssp = (const u64*)(ws + WS_SS) + (size_t)(nss >= 0 ? nss : 0) * T;
    pg8::StaticOrder S;
#ifndef MK_ENABLE
#define MK_ENABLE 0xFFFF
#endif
    if (!((MK_ENABLE >> type) & 1)) continue;
    if (type == PT_SUBLN) continue;
    switch (type) {
      case PT_PRO: prologue(a, lds); break;
      case PT_GU: {
#ifdef MK_STAGGER
        if ((blockIdx.x >> 3) & 1) { const unsigned long long t0 = __builtin_amdgcn_s_memrealtime(); while (__builtin_amdgcn_s_memrealtime() - t0 < MK_STAGGER) __builtin_amdgcn_s_sleep(32); }
#endif
        pg8::Gemm g{(const bf16_t*)(ws + WS_XN), (const bf16_t*)(ws + WS_WGU + (size_t)f * SZ_GU), T, 2 * FF, DM}; S.init(T, 2 * FF, gridDim.x, blockIdx.x);
        EpiSwiglu E{(bf16_t*)(ws + WS_H), ssp, DUP2}; pg8::gemm_phase<EpiSwiglu, pg8::StaticOrder>((PG8_LAS unsigned char*)lds, g, S, E, nullptr); } break;
      case PT_RES: { pg8::Gemm g{gA, gB, T, DM, gK}; S.init(T, DM, gridDim.x, blockIdx.x);
        EpiResid E{a, ph, DUP2}; pg8::gemm_phase<EpiResid, pg8::StaticOrder>((PG8_LAS unsigned char*)lds, g, S, E, nullptr); } break;
      case PT_IN: { pg8::Gemm g{(const bf16_t*)(ws + WS_XN), (const bf16_t*)(ws + WS_WIN), T, NIN, DM}; S.init(T, NIN, gridDim.x, blockIdx.x);
        EpiP E{(bf16_t*)(ws + WS_H), (float*)(ws + WS_BA), ssp}; pg8::gemm_phase<EpiP, pg8::StaticOrder>((PG8_LAS unsigned char*)lds, g, S, E, nullptr); } break;
      case PT_CONV: dn_prep(a); break;
      case PT_SCAN: scan_phase(a, lds); break;
      case PT_GNORM: gnorm_phase(a); conv_module(a, lds); break;
      case PT_QKV: { pg8::Gemm g{(const bf16_t*)(ws + WS_XN), (const bf16_t*)(ws + WS_WQKV), T, NQKV, DM}; S.init(T, NQKV, gridDim.x, blockIdx.x);
        EpiQKV E{(bf16_t*)(ws + WS_H), (const float*)(ws + WS_ROPE), ssp}; pg8::gemm_phase<EpiQKV, pg8::StaticOrder>((PG8_LAS unsigned char*)lds, g, S, E, nullptr); } break;
      case PT_ATTN: attn_phase(a, lds); break;
      case PT_SUBLN: break;
      default: final_phase((const bf16_t*)(ws + WS_XN), (const u64*)(ws + WS_SS) + (size_t)6 * T, a->in[28], a->out); break;
    }
    if (php + 1 < ph_hi) grid.sync();
  }
}
}

#ifndef MK_MULTI
#define MK_MULTI 0
#endif
extern "C" void kernel_launch(void* const* d_in, const int* in_sizes, int n_in, void* d_out, int out_size, void* d_ws, size_t ws_size, hipStream_t stream) {
  static int grid = 0;
  if (grid == 0) {
    if (n_in != 29 || out_size != mk::T * mk::DM || ws_size < mk::WS_END) { fprintf(stderr, "kernel_launch: unexpected shapes n_in %d out %d ws %zu (need %zu)\n", n_in, out_size, ws_size, (size_t)mk::WS_END); grid = -1; return; }
    int dev = 0, cus = 0, per_cu = 0;
    hipGetDevice(&dev); hipDeviceGetAttribute(&cus, hipDeviceAttributeMultiprocessorCount, dev);
    if (hipFuncSetAttribute((const void*)mk::mega, hipFuncAttributeMaxDynamicSharedMemorySize, mk::LDS_BYTES) != hipSuccess) { fprintf(stderr, "kernel_launch: hipFuncSetAttribute failed\n"); grid = -1; return; }
    hipOccupancyMaxActiveBlocksPerMultiprocessor(&per_cu, (const void*)mk::mega, 512, mk::LDS_BYTES);
    if (per_cu < 1) per_cu = 1;
    grid = cus * per_cu;
    (void)hipGetLastError();
  }
  if (grid < 0) return;
  mk::Args a{};
  for (int i = 0; i < 29; ++i) a.in[i] = (const float*)d_in[i];
  a.out = (float*)d_out; a.ws = (unsigned char*)d_ws;
#if MK_MULTI
  for (int ph = 0; ph < mk::NPHASE; ++ph) { a.ph_lo = ph; a.ph_hi = ph + 1; hipLaunchKernelGGL(mk::mega, dim3(grid), dim3(512), mk::LDS_BYTES, stream, a); }
#else
  a.ph_lo = 0; a.ph_hi = mk::NPHASE;
  void* args[] = {&a};
  hipError_t e = hipLaunchCooperativeKernel((const void*)mk::mega, dim3(grid), dim3(512), args, mk::LDS_BYTES, stream);
  if (e != hipSuccess) fprintf(stderr, "cooperative launch failed: %s (grid %d)\n", hipGetErrorString(e), grid);
#endif
}
```

```cpp
#include <hip/hip_runtime.h>
#include <hip/hip_cooperative_groups.h>
#include <cstdio>
#include <cstdint>
namespace cg = cooperative_groups;
__device__ __forceinline__ int tidx() { int t = threadIdx.x; asm volatile("" : "+v"(t)); return t; }
namespace pg8 {
#define PG8_LAS __attribute__((address_space(3)))
typedef unsigned short bf16_t;
typedef short bf16x8 __attribute__((ext_vector_type(8)));
typedef float f32x4 __attribute__((ext_vector_type(4)));
typedef unsigned u32x4 __attribute__((ext_vector_type(4)));
constexpr int BM = 256, BK = 64, HALF = 128, HTB = HALF * BK * 2  , STAGE_BYTES = 8 * HTB, NXCD = 8, WGM = 4;

__host__ __device__ __forceinline__ int lds_byte(int r, int c) { const int st = (r >> 4) * 2 + (c >> 5), rr = r & 15, cc = c & 31, ob = rr * 64 + cc * 2; return st * 1024 + (ob ^ (((ob >> 9) & 1) << 5)); }
__host__ __device__ __forceinline__ void stage_rc(int b, int& R, int& C) { const int st = b / 1024, sb = b % 1024, swz = sb ^ (((sb >> 9) & 1) << 5); R = (st >> 1) * 16 + swz / 64; C = (st & 1) * 32 + (swz % 64) / 2; }
__host__ __device__ __forceinline__ int perm32(int rho) { const int n = rho >> 4, i = rho & 15; return 8 * (i >> 2) + 4 * n + (i & 3); }
struct Unit { int pm, pn; };
struct Gemm { const bf16_t* A; const bf16_t* Bt; int M, N, K; };

struct StaticOrder {
    int nM, nN, nwg, G, c;
    __host__ __device__ void init(int M, int N, int G_, int c_) { nM = M / BM; nN = N / BM; nwg = nM * nN; G = G_; c = c_; }
    __host__ __device__ bool next(int i, Unit& u) const {
        const long L = (long)i * G + c; if (L >= nwg) return false;
        int wgid = (int)L; { const int q = nwg / NXCD, r = nwg % NXCD, xcd = wgid % NXCD, off = wgid / NXCD; wgid = (xcd < r ? xcd * (q + 1) : r * (q + 1) + (xcd - r) * q) + off; }
        const int nig = WGM * nN, gid = wgid / nig, fm = gid * WGM, gsz = (nM - fm) < WGM ? (nM - fm) : WGM;
        u.pm = fm + ((wgid % nig) % gsz); u.pn = (wgid % nig) / gsz; return true;
    }
    __device__ __forceinline__ void a_ready(const Unit&) const {}
    __device__ __forceinline__ void done(const Unit&) const {}
};
__device__ __forceinline__ unsigned cvt_pk_bf16(float lo, float hi) { unsigned r; asm volatile("v_cvt_pk_bf16_f32 %0, %1, %2" : "=v"(r) : "v"(lo), "v"(hi)); return r; }
template <class Epi, class Sched, bool STAMP = false>
__device__ __forceinline__ void gemm_phase(PG8_LAS unsigned char* lds, const Gemm g, const Sched& S, const Epi& E, unsigned long long* stamps) {
    const int tid = tidx(), wid = __builtin_amdgcn_readfirstlane(tid >> 6), lane = tid & 63, wr = wid >> 2, wc = wid & 3, fr = lane & 15, fq = lane >> 4;
    const int K = g.K, nt = K / BK;
    int ts_lo = 0, ts_hi = 0, nts = 0; const unsigned long long rt_entry = STAMP ? (unsigned long long)wall_clock64() : 0ull;
#define PG8_STAMP() do { if (STAMP && wid == 0 && nts < 64) { const unsigned long long _c = (unsigned long long)clock64(); \
        ts_lo = (lane == nts) ? (int)(unsigned)_c : ts_lo; ts_hi = (lane == nts) ? (int)(unsigned)(_c >> 32) : ts_hi; ++nts; } } while (0)
    PG8_STAMP();
    unsigned voffA[2], voffB[2];
#pragma unroll
    for (int i = 0; i < 2; ++i) { int R, C; stage_rc(tid * 16 + i * 8192, R, C); const int Rb = Epi::PERM ? ((R & ~31) + perm32(R & 31)) : R;
        voffA[i] = (unsigned)(R * K + C) * 2u; voffB[i] = (unsigned)(Rb * K + C) * 2u; }
    const size_t kstep = (size_t)(BK * 2);
    const size_t hstep = (size_t)HALF * K * 2;
    const size_t tstep = 2 * hstep;
    const unsigned ldsw = (unsigned)wid * 1024u;
    const int aoff = lds_byte(wr * 64 + fr, fq * 8), boff = lds_byte(wc * 32 + fr, fq * 8);
#define PG8_SA(b, h) (((b) * 2 + (h)) * HTB)
#define PG8_SB(b, h) ((4 + (b) * 2 + (h)) * HTB)
#define PG8_STAGE(bufoff, gbase, voff) do { _Pragma("unroll") for (int _i = 0; _i < 2; ++_i) \
        __builtin_amdgcn_global_load_lds((const unsigned*)((const char*)(gbase) + (voff)[_i]), (PG8_LAS unsigned*)(lds + (bufoff) + ldsw + _i * 8192), 16, 0, 0); } while (0)
#define PG8_LDA(dst, b, h) do { _Pragma("unroll") for (int m = 0; m < 4; ++m) _Pragma("unroll") for (int k = 0; k < 2; ++k) dst[m][k] = *(const PG8_LAS bf16x8*)(lds + PG8_SA(b, h) + aoff + m * 2048 + k * 1024); } while (0)
#define PG8_LDB(dst, b, h) do { _Pragma("unroll") for (int n = 0; n < 2; ++n) _Pragma("unroll") for (int k = 0; k < 2; ++k) dst[n][k] = *(const PG8_LAS bf16x8*)(lds + PG8_SB(b, h) + boff + n * 2048 + k * 1024); } while (0)
#define PG8_MMA(ai, bj, At, Bt) do { __builtin_amdgcn_s_setprio(1); _Pragma("unroll") for (int m = 0; m < 4; ++m) _Pragma("unroll") for (int n = 0; n < 2; ++n) _Pragma("unroll") for (int k = 0; k < 2; ++k) \
        acc[ai][bj][m][n] = __builtin_amdgcn_mfma_f32_16x16x32_bf16(Bt[n][k], At[m][k], acc[ai][bj][m][n], 0, 0, 0); __builtin_amdgcn_s_setprio(0); } while (0)
#define PG8_WAIT_V(n) asm volatile("s_waitcnt vmcnt(" #n ")" ::: "memory")
#define PG8_WAIT_L(n) asm volatile("s_waitcnt lgkmcnt(" #n ")" ::: "memory")
#define PG8_BAR __builtin_amdgcn_s_barrier()
#define PG8_SCHED __builtin_amdgcn_sched_barrier(0)
    Unit cur, nxt; int ui = 0;
    if (!S.next(0, cur)) return;
    f32x4 acc[2][2][4][2];
#pragma unroll
    for (int a = 0; a < 2; ++a)
#pragma unroll
        for (int b = 0; b < 2; ++b)
#pragma unroll
            for (int m = 0; m < 4; ++m)
#pragma unroll
                for (int n = 0; n < 2; ++n) acc[a][b][m][n] = (f32x4){0.f, 0.f, 0.f, 0.f};
    bf16x8 At[4][2], B0[2][2], B1[2][2];
    const char* cA = (const char*)g.A + (size_t)cur.pm * tstep; const char* cB = (const char*)g.Bt + (size_t)cur.pn * tstep;
    S.a_ready(cur);
    PG8_STAGE(PG8_SB(0, 0), cB, voffB); PG8_STAGE(PG8_SA(0, 0), cA, voffA); PG8_STAGE(PG8_SB(0, 1), cB + hstep, voffB); PG8_STAGE(PG8_SA(0, 1), cA + hstep, voffA);
    if (wr == 1) PG8_BAR;
    PG8_WAIT_V(4); PG8_BAR;
    PG8_STAGE(PG8_SB(1, 0), cB + kstep, voffB); PG8_STAGE(PG8_SA(1, 0), cA + kstep, voffA); PG8_STAGE(PG8_SB(1, 1), cB + hstep + kstep, voffB);
    PG8_WAIT_V(6); PG8_BAR;
    PG8_STAMP();
    for (;;) {
        const bool has_next = S.next(ui + 1, nxt);
        const char* nA = has_next ? (const char*)g.A + (size_t)nxt.pm * tstep : cA; const char* nB = has_next ? (const char*)g.Bt + (size_t)nxt.pn * tstep : cB;
        for (int t = 0; t < nt; t += 2) {
            const bool last = (t == nt - 2);
            const char* a1 = cA + (size_t)(t + 1) * kstep;
            const char* a2 = last ? nA : cA + (size_t)(t + 2) * kstep; const char* b2 = last ? nB : cB + (size_t)(t + 2) * kstep;
            const char* a3 = a2 + kstep; const char* b3 = b2 + kstep;
            if (last && has_next) S.a_ready(nxt);
            PG8_LDB(B0, 0, 0); PG8_SCHED; PG8_LDA(At, 0, 0); PG8_STAGE(PG8_SA(1, 1), a1 + hstep, voffA);
            PG8_WAIT_L(8); PG8_BAR; PG8_WAIT_L(0); PG8_MMA(0, 0, At, B0); PG8_BAR; PG8_SCHED;
            PG8_LDB(B1, 0, 1); PG8_STAGE(PG8_SB(0, 0), b2, voffB);
            PG8_BAR; PG8_WAIT_L(0); PG8_MMA(0, 1, At, B1); PG8_BAR;
            PG8_LDA(At, 0, 1); PG8_STAGE(PG8_SA(0, 0), a2, voffA);
            PG8_BAR; PG8_WAIT_L(0); PG8_MMA(1, 0, At, B0); PG8_BAR; PG8_SCHED;
            PG8_STAGE(PG8_SB(0, 1), b2 + hstep, voffB);
            PG8_WAIT_V(6); PG8_BAR; PG8_MMA(1, 1, At, B1); PG8_BAR;
            PG8_LDB(B0, 1, 0); PG8_SCHED; PG8_LDA(At, 1, 0); PG8_STAGE(PG8_SA(0, 1), a2 + hstep, voffA);
            PG8_WAIT_L(8); PG8_BAR; PG8_WAIT_L(0); PG8_MMA(0, 0, At, B0); PG8_BAR; PG8_SCHED;
            PG8_LDB(B1, 1, 1); PG8_STAGE(PG8_SB(1, 0), b3, voffB);
            PG8_BAR; PG8_WAIT_L(0); PG8_MMA(0, 1, At, B1); PG8_BAR;
            PG8_LDA(At, 1, 1); PG8_STAGE(PG8_SA(1, 0), a3, voffA);
            PG8_BAR; PG8_WAIT_L(0); PG8_MMA(1, 0, At, B0); PG8_BAR; PG8_SCHED;
            PG8_STAGE(PG8_SB(1, 1), b3 + hstep, voffB);
            PG8_WAIT_V(6); PG8_BAR; PG8_MMA(1, 1, At, B1); PG8_BAR;
        }
        PG8_STAMP();
        if constexpr (!Epi::AFTER_DRAIN) { E(acc, cur, wr, wc, fr, fq); S.done(cur); }
        PG8_STAMP();
        if (!has_next) break;
#pragma unroll
        for (int a = 0; a < 2; ++a)
#pragma unroll
            for (int b = 0; b < 2; ++b)
#pragma unroll
                for (int m = 0; m < 4; ++m)
#pragma unroll
                    for (int n = 0; n < 2; ++n) acc[a][b][m][n] = (f32x4){0.f, 0.f, 0.f, 0.f};
        cur = nxt; cA = nA; cB = nB; ++ui;
    }
    PG8_WAIT_V(0);
    if (wr == 0) PG8_BAR;
    PG8_BAR;
    if constexpr (Epi::AFTER_DRAIN) { E.fused(acc, cur, wr, wc, fr, fq, lds, wid, lane); S.done(cur); }
    PG8_STAMP();
    if (STAMP && wid == 0) { stamps[lane] = lane < nts ? (((unsigned long long)(unsigned)ts_hi << 32) | (unsigned)ts_lo) : 0ull;
        if (lane == 62) stamps[62] = rt_entry; if (lane == 63) stamps[63] = (unsigned long long)wall_clock64(); }
#undef PG8_STAMP
#undef PG8_SA
#undef PG8_SB
#undef PG8_STAGE
#undef PG8_LDA
#undef PG8_LDB
#undef PG8_MMA
#undef PG8_WAIT_V
#undef PG8_WAIT_L
#undef PG8_BAR
#undef PG8_SCHED
}
}

namespace att {
using bf16 = unsigned short;
constexpr int   D = 128, NW = 8, QBLK = 32, KVBLK = 64;
constexpr float SCALE = 0.088388347648318440f;
constexpr float THR = 8.f;
constexpr int SDEPTH = 2;
constexpr int LDQ = 6144, LDK = 6144, LDO = 2048;
constexpr size_t SHM_V = KVBLK * D * 2, SHM_K = KVBLK * D * 2, SHM_ATTN = 2 * SHM_V + 2 * SHM_K + NW * 64 * 4;
using bf16x8 = __attribute__((ext_vector_type(8))) short;
using s16x4  = __attribute__((ext_vector_type(4))) short;
using f32x16 = __attribute__((ext_vector_type(16))) float;
using f32x8  = __attribute__((ext_vector_type(8))) float;
using u32x4  = __attribute__((ext_vector_type(4))) unsigned;
#define KSWZ(row, colB) ((row) * 256 + ((colB) ^ (((row) & 7) << 4)))
#define SBAR() __builtin_amdgcn_sched_barrier(0)
__device__ __forceinline__ int crow(int r, int hi) { return (r & 3) + 8 * (r >> 2) + 4 * hi; }
__device__ __forceinline__ unsigned cvtpk(float lo, float hi) {
  unsigned r; asm volatile("v_cvt_pk_bf16_f32 %0, %1, %2" : "=v"(r) : "v"(lo), "v"(hi)); return r;
}
template <typename TIn> struct Stage;
template <> struct Stage<bf16>  { using T = bf16x8;
  __device__ static __forceinline__ T ld8(const bf16* p) { return *reinterpret_cast<const bf16x8*>(p); }
  __device__ static __forceinline__ bf16x8 tobf(T x) { return x; } };
template <> struct Stage<float> { using T = f32x8;
  __device__ static __forceinline__ T ld8(const float* p) { return *reinterpret_cast<const f32x8*>(p); }
  __device__ static __forceinline__ bf16x8 tobf(T x) {
    u32x4 w = {cvtpk(x[0], x[1]), cvtpk(x[2], x[3]), cvtpk(x[4], x[5]), cvtpk(x[6], x[7])}; return *reinterpret_cast<bf16x8*>(&w); } };

__device__ __forceinline__ void partialSM(f32x16& p0, f32x16& p1, float& m_reg, float& mn, float& alpha) {
  constexpr float C = SCALE * 1.4426950408889634f;
  float pmax = p0[0]; for (int r = 1; r < 16; ++r) pmax = fmaxf(pmax, p0[r]); for (int r = 0; r < 16; ++r) pmax = fmaxf(pmax, p1[r]);
  { auto rr = __builtin_amdgcn_permlane32_swap(__float_as_uint(pmax), __float_as_uint(pmax), false, false);
    pmax = fmaxf(__uint_as_float(rr[0]), __uint_as_float(rr[1])); }
  if (__builtin_expect(__all(pmax - m_reg <= THR / SCALE), 1)) { mn = m_reg; alpha = 1.f; }
  else { mn = fmaxf(m_reg, pmax); alpha = __builtin_amdgcn_exp2f((m_reg - mn) * C); m_reg = mn; }
  float mnC = -mn * C;
  for (int r = 0; r < 16; ++r) p0[r] = fmaf(p0[r], C, mnC); for (int r = 0; r < 16; ++r) p1[r] = fmaf(p1[r], C, mnC);
  for (int r = 0; r < 16; ++r) p0[r] = __builtin_amdgcn_exp2f(p0[r]);
}
__device__ __forceinline__ void finishSM(f32x16& p0, f32x16& p1, float alpha, float& l_reg, bf16x8& pa0, bf16x8& pa1, bf16x8& pa2, bf16x8& pa3) {
  for (int r = 0; r < 16; ++r) p1[r] = __builtin_amdgcn_exp2f(p1[r]);
  float ps = 0; for (int r = 0; r < 16; ++r) ps += p0[r]; for (int r = 0; r < 16; ++r) ps += p1[r];
  { auto rr = __builtin_amdgcn_permlane32_swap(__float_as_uint(ps), __float_as_uint(ps), false, false);
    ps = __uint_as_float(rr[0]) + __uint_as_float(rr[1]); }
  l_reg = l_reg * alpha + ps;
#define PK4(P, BASE, OUT) do { unsigned a0 = cvtpk(P[BASE + 0], P[BASE + 1]), a1 = cvtpk(P[BASE + 2], P[BASE + 3]);   \
    unsigned b0 = cvtpk(P[BASE + 4], P[BASE + 5]), b1 = cvtpk(P[BASE + 6], P[BASE + 7]);                              \
    auto r0 = __builtin_amdgcn_permlane32_swap(a0, b0, false, false); auto r1 = __builtin_amdgcn_permlane32_swap(a1, b1, false, false); \
    u32x4 w = {r0[0], r1[0], r0[1], r1[1]}; OUT = *reinterpret_cast<bf16x8*>(&w); } while (0)
  PK4(p0, 0, pa0); PK4(p0, 8, pa1); PK4(p1, 0, pa2); PK4(p1, 8, pa3);
#undef PK4
}
__device__ __forceinline__ void qkt(f32x16& p0, f32x16& p1, const bf16* Ks, const bf16x8* qr, int r32, int hi) {
  p0 = f32x16{}; p1 = f32x16{};
  for (int d0 = 0; d0 < 8; ++d0) { int cb = (d0 * 16 + hi * 8) * 2;
    bf16x8 b0 = *reinterpret_cast<const bf16x8*>((const char*)Ks + KSWZ(r32, cb));
    bf16x8 b1 = *reinterpret_cast<const bf16x8*>((const char*)Ks + KSWZ(32 + r32, cb));
    p0 = __builtin_amdgcn_mfma_f32_32x32x16_bf16(b0, qr[d0], p0, 0, 0, 0);
    p1 = __builtin_amdgcn_mfma_f32_32x32x16_bf16(b1, qr[d0], p1, 0, 0, 0); }
}
__device__ __forceinline__ int v_st(int k, int c) { const int kk = (k & ~0xC) | ((k & 4) << 1) | ((k & 8) >> 1); return ((kk >> 3) * 4 + (c >> 5)) * 512 + ((kk & 7) * 32 + (c & 31)) * 2; }
__device__ __forceinline__ int v_rd_base(int lane) { return ((lane & 3) << 3) | (((lane >> 2) & 3) << 6) | (((lane >> 4) & 1) << 5) | (((lane >> 5) & 1) << 8); }
constexpr int v_rd_off(int d0, int ks, int half) { return d0 * 512 + ks * 4096 + half * 2048; }
template <int OFF> __device__ __forceinline__ s16x4 tr_read(int vb) {
  s16x4 r; asm volatile("ds_read_b64_tr_b16 %0, %1 offset:%2" : "=&v"(r) : "v"(vb), "i"(OFF) : "memory"); return r;
}
template <int D0> __device__ __forceinline__ void pv_one(f32x16& od, int vb, bf16x8 pa0, bf16x8 pa1, bf16x8 pa2, bf16x8 pa3) {
  const s16x4 l0 = tr_read<v_rd_off(D0, 0, 0)>(vb), h0 = tr_read<v_rd_off(D0, 0, 1)>(vb), l1 = tr_read<v_rd_off(D0, 1, 0)>(vb), h1 = tr_read<v_rd_off(D0, 1, 1)>(vb);
  const s16x4 l2 = tr_read<v_rd_off(D0, 2, 0)>(vb), h2 = tr_read<v_rd_off(D0, 2, 1)>(vb), l3 = tr_read<v_rd_off(D0, 3, 0)>(vb), h3 = tr_read<v_rd_off(D0, 3, 1)>(vb);
  asm volatile("s_waitcnt lgkmcnt(0)" ::: "memory"); SBAR();
#define PK(L, H) (bf16x8){L[0], L[1], L[2], L[3], H[0], H[1], H[2], H[3]}
  od = __builtin_amdgcn_mfma_f32_32x32x16_bf16(pa0, PK(l0, h0), od, 0, 0, 0);
  od = __builtin_amdgcn_mfma_f32_32x32x16_bf16(pa1, PK(l1, h1), od, 0, 0, 0);
  od = __builtin_amdgcn_mfma_f32_32x32x16_bf16(pa2, PK(l2, h2), od, 0, 0, 0);
  od = __builtin_amdgcn_mfma_f32_32x32x16_bf16(pa3, PK(l3, h3), od, 0, 0, 0);
#undef PK
}
__device__ __forceinline__ void pv_d0(f32x16* o, int vb, bf16x8 pa0, bf16x8 pa1, bf16x8 pa2, bf16x8 pa3) {
  pv_one<0>(o[0], vb, pa0, pa1, pa2, pa3); pv_one<1>(o[1], vb, pa0, pa1, pa2, pa3); pv_one<2>(o[2], vb, pa0, pa1, pa2, pa3); pv_one<3>(o[3], vb, pa0, pa1, pa2, pa3);
}

template <typename TQ>
__device__ __forceinline__ void attn_dense_body(const TQ* __restrict__ Qb, const bf16* __restrict__ Kh, const bf16* __restrict__ Vh,
                                                float* __restrict__ Ob, int seq, char* lds, int mode, float lam, unsigned short* o1buf) {
  using St = Stage<bf16>; using SQ = Stage<TQ>;
  const int tid = tidx(), wid = tid >> 6, lane = tid & 63, r32 = lane & 31, hi = lane >> 5;
  bf16* V_lds = (bf16*)lds; bf16* K_lds = (bf16*)(lds + 2 * SHM_V);
  float* ws = (float*)(lds + 2 * SHM_V + 2 * SHM_K) + wid * 64; float* li_l = ws; float* al_l = ws + 32;
  float m_reg = -1e30f, l_reg = 0; f32x16 o[4] = {}; bf16x8 qr[8];
  const TQ* Qw = Qb + (long)(wid * QBLK + r32) * LDQ + hi * 8;
#pragma unroll
  for (int d0 = 0; d0 < 8; ++d0) qr[d0] = SQ::tobf(SQ::ld8(Qw + d0 * 16));
  const int sr = tid >> 4, sc = (tid & 15) * 8, vst0 = v_st(sr, sc), vst1 = v_st(32 + sr, sc);
  const int vb0 = (int)(uintptr_t)V_lds + v_rd_base(lane);
  struct { typename St::T vs0, vs1, ks0, ks1; } sr_[SDEPTH];
#define SLOAD(i, k0) do { sr_[i].vs0 = St::ld8(&Vh[(long)((k0) + sr) * LDK + sc]); sr_[i].vs1 = St::ld8(&Vh[(long)((k0) + 32 + sr) * LDK + sc]); \
    sr_[i].ks0 = St::ld8(&Kh[(long)((k0) + sr) * LDK + sc]); sr_[i].ks1 = St::ld8(&Kh[(long)((k0) + 32 + sr) * LDK + sc]); } while (0)
#define SWRITE(b, i) do { *(bf16x8*)((char*)V_lds + (b) * SHM_V + vst0) = St::tobf(sr_[i].vs0);          \
    *(bf16x8*)((char*)V_lds + (b) * SHM_V + vst1) = St::tobf(sr_[i].vs1); int kc = sc * 2;               \
    *(bf16x8*)((char*)K_lds + (b) * SHM_K + KSWZ(sr, kc)) = St::tobf(sr_[i].ks0);                       \
    *(bf16x8*)((char*)K_lds + (b) * SHM_K + KSWZ(32 + sr, kc)) = St::tobf(sr_[i].ks1); } while (0)
#define SWAIT() do { if constexpr (SDEPTH == 2) asm volatile("s_waitcnt vmcnt(4)" ::: "memory"); else asm volatile("s_waitcnt vmcnt(0)" ::: "memory"); } while (0)
#define RESC(a) do { if (__any((a) < 1.f)) { if (hi == 0) al_l[r32] = (a); asm volatile("s_waitcnt lgkmcnt(0)" ::: "memory"); \
    for (int d = 0; d < 4; ++d) for (int r = 0; r < 16; ++r) o[d][r] *= al_l[crow(r, hi)]; } } while (0)
  f32x16 pA0, pA1, pB0, pB1; float mnA, mnB, alA, alB; bf16x8 pa0, pa1, pa2, pa3; const int NT = seq / KVBLK;
  constexpr int SE = 0, SO = SDEPTH - 1;
  SLOAD(SE, 0); asm volatile("s_waitcnt vmcnt(0)" ::: "memory"); SWRITE(0, SE); __syncthreads();
  qkt(pA0, pA1, K_lds, qr, r32, hi); partialSM(pA0, pA1, m_reg, mnA, alA);
  SLOAD(SO, KVBLK); if constexpr (SDEPTH == 2) { if (2 < NT) SLOAD(SE, 2 * KVBLK); }
  SWAIT(); SWRITE(1, SO); __syncthreads();
  for (int j = 1; j + 1 < NT; j += 2) {
    SBAR(); qkt(pB0, pB1, (bf16*)((char*)K_lds + SHM_K), qr, r32, hi);
    finishSM(pA0, pA1, alA, l_reg, pa0, pa1, pa2, pa3); SBAR();
    SLOAD(SO, (j + SDEPTH) * KVBLK); SBAR();
    pv_d0(o, vb0, pa0, pa1, pa2, pa3); partialSM(pB0, pB1, m_reg, mnB, alB);
    __syncthreads(); SWAIT(); SWRITE(0, SE);
    RESC(alB); __syncthreads();
    SBAR(); qkt(pA0, pA1, K_lds, qr, r32, hi);
    finishSM(pB0, pB1, alB, l_reg, pa0, pa1, pa2, pa3); SBAR();
    if (SDEPTH == 1 || j + 3 < NT) SLOAD(SE, (j + 1 + SDEPTH) * KVBLK); SBAR();
    pv_d0(o, vb0 + (int)SHM_V, pa0, pa1, pa2, pa3); partialSM(pA0, pA1, m_reg, mnA, alA);
    __syncthreads(); SWAIT(); SWRITE(1, SO);
    RESC(alA); __syncthreads();
  }
  SBAR(); qkt(pB0, pB1, (bf16*)((char*)K_lds + SHM_K), qr, r32, hi);
  finishSM(pA0, pA1, alA, l_reg, pa0, pa1, pa2, pa3); SBAR();
  pv_d0(o, vb0, pa0, pa1, pa2, pa3); partialSM(pB0, pB1, m_reg, mnB, alB);
  __syncthreads(); RESC(alB);
  finishSM(pB0, pB1, alB, l_reg, pa0, pa1, pa2, pa3); SBAR();
  pv_d0(o, vb0 + (int)SHM_V, pa0, pa1, pa2, pa3);
  if (hi == 0) li_l[r32] = l_reg; asm volatile("s_waitcnt lgkmcnt(0)" ::: "memory");
  float rli[16];
#pragma unroll
  for (int r = 0; r < 16; ++r) rli[r] = __builtin_amdgcn_rcpf(li_l[crow(r, hi)]);
  float* Ow = Ob + (long)(wid * QBLK) * LDO;
#pragma unroll
  for (int r = 0; r < 16; ++r) { int orow = crow(r, hi);
    for (int d0 = 0; d0 < 4; ++d0) { const float val = o[d0][r] * rli[r]; unsigned short* lp = o1buf + (wid * QBLK + orow) * 128 + d0 * 32 + r32;
      if (mode == 0) { *lp = (unsigned short)(cvtpk(val, val) & 0xffffu); } else { Ow[(long)orow * LDO + d0 * 32 + r32] = __uint_as_float(((unsigned)*lp) << 16) - lam * val; } } }
#undef SLOAD
#undef SWRITE
#undef SWAIT
#undef RESC
}

#undef KSWZ
#undef SBAR
}
#ifndef MK_NO_HELPER
#define MK_NO_HELPER 0
#endif
namespace mk {
using pg8::bf16_t; using pg8::f32x4; using pg8::u32x4; using pg8::cvt_pk_bf16; using pg8::Unit;
typedef unsigned u32x2 __attribute__((ext_vector_type(2)));
typedef float f32x2 __attribute__((ext_vector_type(2)));
constexpr int T = 16384, DM = 2048, FF = 5632, SEQ = 4096;
constexpr int NIN_REAL = 6176, NIN = 6400, NQKV = 6144;
constexpr int LDS_BYTES = 155648;
constexpr float EPS = 1e-6f;
constexpr float LAMBDA_INIT = 0.35550906759096924f;
#ifdef MK_DUP_PH
constexpr int NPHASE = 20;
#else
constexpr int NPHASE = 19;
#endif

constexpr size_t SZ_SMALL = (size_t)T * 32 * 4;
constexpr size_t SZ_GU = (size_t)2 * FF * DM * 2, SZ_D = (size_t)DM * FF * 2;
constexpr size_t WS_ROPE = 0, WS_BA = WS_ROPE + SZ_SMALL, WS_BG = WS_BA + SZ_SMALL;
constexpr size_t WS_SS = WS_BG + SZ_SMALL;
constexpr size_t WS_WGU = WS_SS + (size_t)1024 * 1024, WS_WD = WS_WGU + 4 * SZ_GU;
typedef unsigned long long u64;
constexpr size_t WS_BAR = WS_SS + (size_t)960 * 1024;
constexpr float SSQ = 1048576.f, SSQ_INV = 1.f / 1048576.f;
constexpr size_t WS_WIN = WS_WD + 4 * SZ_D, WS_WOUT = WS_WIN + (size_t)NIN * DM * 2;
constexpr size_t WS_WQKV = WS_WOUT + (size_t)DM * DM * 2, WS_WO = WS_WQKV + (size_t)NQKV * DM * 2;
constexpr size_t WS_XN = WS_WO + (size_t)DM * DM * 2;
constexpr size_t WS_H = WS_XN + (size_t)T * DM * 2;
constexpr size_t WS_S = WS_H + (size_t)T * NIN * 2;
constexpr size_t SZ_T1K = (size_t)T * 1024 * 2;
constexpr size_t WS_END = WS_S + 5 * SZ_T1K;

struct Args { const float* in[29]; float* out; unsigned char* ws; int ph_lo, ph_hi; };
typedef const __attribute__((address_space(4))) Args* AP;

__device__ __forceinline__ float bflo(unsigned w) { return __uint_as_float(w << 16); }
__device__ __forceinline__ float bfhi(unsigned w) { return __uint_as_float(w & 0xffff0000u); }
__device__ __forceinline__ float sigm(float x) { return __builtin_amdgcn_rcpf(1.f + __expf(-x)); }
__device__ __forceinline__ float silu(float x) { return x * sigm(x); }
__device__ __forceinline__ float wave_sum(float v) {
#pragma unroll
  for (int m = 32; m >= 1; m >>= 1) v += __shfl_xor(v, m, 64);
  return v;
}

template <int CTRL> __device__ __forceinline__ float dpp_mov(float v) { return __int_as_float(__builtin_amdgcn_update_dpp(0, __float_as_int(v), CTRL, 0xF, 0xF, true)); }
__device__ __forceinline__ float row_sum8(float v) { v += dpp_mov<0xB1>(v); v += dpp_mov<0x4E>(v); v += dpp_mov<0x141>(v); return v; }
__device__ __forceinline__ float row_sum16(float v) { v += dpp_mov<0xB1>(v); v += dpp_mov<0x4E>(v); v += dpp_mov<0x141>(v); v += dpp_mov<0x140>(v); return v; }
__device__ __forceinline__ float dpp_row_bcast_sum4(float v) { float t = v + __shfl_xor(v, 16, 64); return t + __shfl_xor(t, 32, 64) - v; }
#define EPI_PIN() __builtin_amdgcn_sched_barrier(0)
struct EpiSwiglu { static constexpr bool PERM = true, AFTER_DRAIN = false; bf16_t* H; const u64* ss; int dup;
  __device__ __forceinline__ void operator()(const f32x4 (&acc)[2][2][4][2], const Unit& u, int wr, int wc, int fr, int fq) const {
    const int row0 = u.pm * 256 + wr * 64 + fr, col0 = u.pn * 128 + wc * 32 + 8 * fq;
    float rsv[2][4];
#pragma unroll
    for (int ai = 0; ai < 2; ++ai)
#pragma unroll
      for (int m = 0; m < 4; ++m) rsv[ai][m] = (float)ss[row0 + ai * 128 + m * 16] * SSQ_INV;
    EPI_PIN();
#pragma unroll
    for (int ai = 0; ai < 2; ++ai)
#pragma unroll
      for (int m = 0; m < 4; ++m) {
        const float rs = rsqrtf(rsv[ai][m] * (1.f / DM) + EPS);
        const f32x4 g0 = acc[ai][0][m][0] * rs, g1 = acc[ai][0][m][1] * rs, u0 = acc[ai][1][m][0] * rs, u1 = acc[ai][1][m][1] * rs;
        float h[8];
#pragma unroll
        for (int j = 0; j < 4; ++j) { h[j] = silu(g0[j]) * u0[j]; h[4 + j] = silu(g1[j]) * u1[j]; }
        u32x4 w; w[0] = cvt_pk_bf16(h[0], h[1]); w[1] = cvt_pk_bf16(h[2], h[3]); w[2] = cvt_pk_bf16(h[4], h[5]); w[3] = cvt_pk_bf16(h[6], h[7]);
#if MK_PROBE_NOSTORE
        if (!dup || w[0] == 0x12345678u)
#endif
        __builtin_nontemporal_store(w, (u32x4*)(H + (size_t)(row0 + ai * 128 + m * 16) * FF + col0));
      }
  }
};
struct EpiResid { static constexpr bool PERM = false, AFTER_DRAIN = false; AP a; int ph; int dup;
  __device__ __forceinline__ void operator()(const f32x4 (&acc)[2][2][4][2], const Unit& u, int wr, int wc, int fr, int fq) const {
    bf16_t* xb = (bf16_t*)(a->ws + WS_XN); const float* xin = a->in[0];
    const float scale = (ph == 7 || ph == 15) ? 1.f : 0.5f;
    const int nss = (ph == 2) ? 0 : (ph == 7) ? 1 : (ph == 9) ? 2 : (ph == 11) ? 3 : (ph == 15) ? 4 : 6;
    u64* ss = (u64*)(a->ws + WS_SS) + (size_t)nss * T;
    const int row0 = u.pm * 256 + wr * 64 + fr, col0 = u.pn * 256 + wc * 32 + 4 * fq;
#pragma unroll
    for (int ai = 0; ai < 2; ++ai) {
    u32x2 rb[4][2][2];
    if (ph != 2) {
#pragma unroll
      for (int m = 0; m < 4; ++m)
#pragma unroll
        for (int bj = 0; bj < 2; ++bj)
#pragma unroll
          for (int n = 0; n < 2; ++n) rb[m][bj][n] = *(const u32x2*)(xb + (size_t)(row0 + ai * 128 + m * 16) * DM + col0 + bj * 128 + n * 16);
    }
    EPI_PIN();
#pragma unroll
    for (int mh = 0; mh < 2; ++mh) {
      f32x4 r[2][2][2];
      if (ph == 2) {
#pragma unroll
        for (int m2 = 0; m2 < 2; ++m2)
#pragma unroll
          for (int bj = 0; bj < 2; ++bj)
#pragma unroll
            for (int n = 0; n < 2; ++n) r[m2][bj][n] = *(const f32x4*)(xin + (size_t)(row0 + ai * 128 + (mh * 2 + m2) * 16) * DM + col0 + bj * 128 + n * 16);
      } else {
#pragma unroll
        for (int m2 = 0; m2 < 2; ++m2)
#pragma unroll
          for (int bj = 0; bj < 2; ++bj)
#pragma unroll
            for (int n = 0; n < 2; ++n) { const u32x2 q = rb[mh * 2 + m2][bj][n]; r[m2][bj][n] = (f32x4){bflo(q[0]), bfhi(q[0]), bflo(q[1]), bfhi(q[1])}; }
      }
      EPI_PIN();
#pragma unroll
      for (int m2 = 0; m2 < 2; ++m2) {
        const int m = mh * 2 + m2;
        const size_t off = (size_t)(row0 + ai * 128 + m * 16) * DM + col0; float sq = 0.f;
#pragma unroll
        for (int bj = 0; bj < 2; ++bj)
#pragma unroll
          for (int n = 0; n < 2; ++n) { const f32x4 rr = r[m2][bj][n] + acc[ai][bj][m][n] * scale;
            u32x2 w; w[0] = cvt_pk_bf16(rr[0], rr[1]); w[1] = cvt_pk_bf16(rr[2], rr[3]); *(u32x2*)(xb + off + bj * 128 + n * 16) = w;
            const float y0 = bflo(w[0]), y1 = bfhi(w[0]), y2 = bflo(w[1]), y3 = bfhi(w[1]); sq += y0 * y0 + y1 * y1 + y2 * y2 + y3 * y3; }
        sq += dpp_row_bcast_sum4(sq); if (fq == 0) atomicAdd(ss + row0 + ai * 128 + m * 16, (u64)(sq * SSQ + 0.5f));
      }
      EPI_PIN();
    }
    }
  }
};
struct EpiP { static constexpr bool PERM = true, AFTER_DRAIN = false; bf16_t* P; float* BA; const u64* ss;
  __device__ __forceinline__ void operator()(const f32x4 (&acc)[2][2][4][2], const Unit& u, int wr, int wc, int fr, int fq) const {
    const int row0 = u.pm * 256 + wr * 64 + fr, col0 = u.pn * 256 + wc * 32 + 8 * fq;
    float rsv[2][4];
#pragma unroll
    for (int ai = 0; ai < 2; ++ai)
#pragma unroll
      for (int m = 0; m < 4; ++m) rsv[ai][m] = (float)ss[row0 + ai * 128 + m * 16] * SSQ_INV;
    EPI_PIN();
#pragma unroll
    for (int ai = 0; ai < 2; ++ai)
#pragma unroll
      for (int m = 0; m < 4; ++m) {
        const int row = row0 + ai * 128 + m * 16;
        const float rs = rsqrtf(rsv[ai][m] * (1.f / DM) + EPS);
#pragma unroll
        for (int bj = 0; bj < 2; ++bj) {
          const f32x4 a0 = acc[ai][bj][m][0] * rs, a1 = acc[ai][bj][m][1] * rs;
          u32x4 w; w[0] = cvt_pk_bf16(a0[0], a0[1]); w[1] = cvt_pk_bf16(a0[2], a0[3]); w[2] = cvt_pk_bf16(a1[0], a1[1]); w[3] = cvt_pk_bf16(a1[2], a1[3]);
          *(u32x4*)(P + (size_t)row * NIN + col0 + bj * 128) = w;
        }
        if (u.pn == 24 && wc == 0) { *(f32x4*)(BA + (size_t)row * 32 + 8 * fq) = acc[ai][0][m][0] * rs; *(f32x4*)(BA + (size_t)row * 32 + 8 * fq + 4) = acc[ai][0][m][1] * rs; }
      }
  }
};
struct EpiQKV { static constexpr bool PERM = false, AFTER_DRAIN = false; bf16_t* O; const float* rope; const u64* ss;
  __device__ __forceinline__ void operator()(const f32x4 (&acc)[2][2][4][2], const Unit& u, int wr, int wc, int fr, int fq) const {
    const int row0 = u.pm * 256 + wr * 64 + fr, col0 = u.pn * 256 + wc * 32 + 4 * fq;
    const bool rot = (wc == 0) && (u.pn < 16);
    float rsv[2][4];
#pragma unroll
    for (int ai = 0; ai < 2; ++ai)
#pragma unroll
      for (int m = 0; m < 4; ++m) rsv[ai][m] = (float)ss[row0 + ai * 128 + m * 16] * SSQ_INV;
#pragma unroll
    for (int ai = 0; ai < 2; ++ai) {
      f32x4 cv[4], sv[4];
#pragma unroll
      for (int m = 0; m < 4; ++m) { const size_t ro = (size_t)(row0 + ai * 128 + m * 16) * 32 + 4 * fq;
        cv[m] = rot ? *(const f32x4*)(rope + ro) : (f32x4){1.f, 1.f, 1.f, 1.f}; sv[m] = rot ? *(const f32x4*)(rope + ro + 16) : (f32x4){0.f, 0.f, 0.f, 0.f}; }
      EPI_PIN();
#pragma unroll
      for (int m = 0; m < 4; ++m) {
        const int row = row0 + ai * 128 + m * 16;
        const float rs = rsqrtf(rsv[ai][m] * (1.f / DM) + EPS);
#pragma unroll
        for (int bj = 0; bj < 2; ++bj) {
          f32x4 v0 = acc[ai][bj][m][0] * rs, v1 = acc[ai][bj][m][1] * rs;
          const f32x4 n0 = v0 * cv[m] - v1 * sv[m], n1 = v1 * cv[m] + v0 * sv[m];
          u32x2 w0, w1; w0[0] = cvt_pk_bf16(n0[0], n0[1]); w0[1] = cvt_pk_bf16(n0[2], n0[3]); w1[0] = cvt_pk_bf16(n1[0], n1[1]); w1[1] = cvt_pk_bf16(n1[2], n1[3]);
          bf16_t* p = O + (size_t)row * NQKV + col0 + bj * 128;
          *(u32x2*)p = w0; *(u32x2*)(p + 16) = w1;
        }
      }
      EPI_PIN();
    }
  }
};

__device__ __forceinline__ void xpose_mat(const float* __restrict__ W, int K, int N, bf16_t* __restrict__ Wt, int mode, float* tile, const float* __restrict__ gk = nullptr) {
  (void)tile;
  const int lane = tidx() & 63, wid = tidx() >> 6;
  const int nkt = K / 64, ntiles = nkt * (N / 32);
  for (int t = blockIdx.x * 8 + wid; t < ntiles; t += gridDim.x * 8) {
    const int nt = t / nkt, kt = t - nt * nkt, n = nt * 32 + (lane & 31), kb = kt * 64 + (lane >> 5) * 32;
    const float* src = W + (size_t)kb * N + n;
    float v[32];
#pragma unroll
    for (int i = 0; i < 32; ++i) v[i] = src[(size_t)i * N];
    int nd = n; if (mode == 1) nd = (n >> 7) * 256 + (n & 127); else if (mode == 2) nd = (n >> 7) * 256 + 128 + (n & 127);
#pragma unroll
    for (int q = 0; q < 4; ++q) {
      f32x4 g0 = {1.f, 1.f, 1.f, 1.f}, g1 = g0;
      if (gk) { g0 = *(const f32x4*)(gk + kb + 8 * q); g1 = *(const f32x4*)(gk + kb + 8 * q + 4); }
      u32x4 w; w[0] = cvt_pk_bf16(v[8 * q] * g0[0], v[8 * q + 1] * g0[1]); w[1] = cvt_pk_bf16(v[8 * q + 2] * g0[2], v[8 * q + 3] * g0[3]);
      w[2] = cvt_pk_bf16(v[8 * q + 4] * g1[0], v[8 * q + 5] * g1[1]); w[3] = cvt_pk_bf16(v[8 * q + 6] * g1[2], v[8 * q + 7] * g1[3]);
      *(u32x4*)(Wt + (size_t)nd * K + kb + 8 * q) = w;
    }
  }
}

constexpr int HT_FFN = (DM / 64) * (FF / 32);
constexpr int HT_SQ = (DM / 64) * (DM / 32), HT_QKV = (DM / 64) * (NQKV / 32);
#if MK_NO_HELPER
constexpr int HT_TOTAL = 0;
#else
constexpr int HT_TOTAL = 9 * HT_FFN + 2 * HT_SQ + HT_QKV;
#endif
struct HTile { const float* W; bf16_t* Wt; int gi; int K, N, mode, k0, n0; };
__device__ __forceinline__ HTile helper_decode(AP a, int id) {
  HTile t; t.mode = 0; t.gi = -1; int lt; unsigned char* ws = a->ws;
  if (id < 9 * HT_FFN) {
    const int mi = id / HT_FFN; lt = id - mi * HT_FFN; const int f = 1 + mi / 3, which = mi - (mi / 3) * 3, layer = f >> 1, second = f & 1;
    if (which == 2) { t.W = a->in[second ? 10 : 5] + (size_t)layer * DM * FF; t.K = FF; t.N = DM; t.Wt = (bf16_t*)(ws + WS_WD + (size_t)f * SZ_D); }
    else { t.W = a->in[which ? (second ? 9 : 4) : (second ? 8 : 3)] + (size_t)layer * DM * FF; t.K = DM; t.N = FF; t.Wt = (bf16_t*)(ws + WS_WGU + (size_t)f * SZ_GU); t.mode = 1 + which; t.gi = f - 1; }
  } else if (id < 9 * HT_FFN + HT_SQ) { lt = id - 9 * HT_FFN; t.W = a->in[20]; t.K = DM; t.N = DM; t.Wt = (bf16_t*)(ws + WS_WOUT); }
  else if (id < 9 * HT_FFN + HT_SQ + HT_QKV) { lt = id - 9 * HT_FFN - HT_SQ; t.W = a->in[21]; t.K = DM; t.N = NQKV; t.Wt = (bf16_t*)(ws + WS_WQKV); t.gi = 3; }
  else { lt = id - 9 * HT_FFN - HT_SQ - HT_QKV; t.W = a->in[27]; t.K = DM; t.N = DM; t.Wt = (bf16_t*)(ws + WS_WO); }
  const int nkt = t.K / 64, nt = lt / nkt, kt = lt - nt * nkt; t.k0 = kt * 64; t.n0 = nt * 32;
  return t;
}
__device__ __forceinline__ void helper_issue(AP a, int id, float (&v)[32], int lane) {
  const HTile t = helper_decode(a, id);
  const float* src = t.W + (size_t)(t.k0 + (lane >> 5) * 32) * t.N + t.n0 + (lane & 31);
#pragma unroll
  for (int i = 0; i < 32; ++i) v[i] = src[(size_t)i * t.N];
}
__device__ __forceinline__ void helper_finish(AP a, int id, const float (&v)[32], float* wtile, const float* gains, int lane) {
  const HTile t = helper_decode(a, id); (void)wtile;
  const int n = t.n0 + (lane & 31), kb = t.k0 + (lane >> 5) * 32;
  int nd = n; if (t.mode == 1) nd = (n >> 7) * 256 + (n & 127); else if (t.mode == 2) nd = (n >> 7) * 256 + 128 + (n & 127);
#pragma unroll
  for (int q = 0; q < 4; ++q) {
    f32x4 g0 = {1.f, 1.f, 1.f, 1.f}, g1 = g0;
    if (t.gi >= 0) { const float* gp = gains + t.gi * DM + kb + 8 * q; g0 = *(const f32x4*)gp; g1 = *(const f32x4*)(gp + 4); }
    u32x4 w; w[0] = cvt_pk_bf16(v[8 * q] * g0[0], v[8 * q + 1] * g0[1]); w[1] = cvt_pk_bf16(v[8 * q + 2] * g0[2], v[8 * q + 3] * g0[3]);
    w[2] = cvt_pk_bf16(v[8 * q + 4] * g1[0], v[8 * q + 5] * g1[1]); w[3] = cvt_pk_bf16(v[8 * q + 6] * g1[2], v[8 * q + 7] * g1[3]);
    *(u32x4*)(t.Wt + (size_t)nd * t.K + kb + 8 * q) = w;
  }
}

__device__ __forceinline__ void cast_phase(const float* __restrict__ X, bf16_t* __restrict__ XB, u64* __restrict__ ss) {
  const int lane = tidx() & 63, wid = tidx() >> 6;
  for (int row = blockIdx.x * 8 + wid; row < T; row += gridDim.x * 8) {
    const float* xr = X + (size_t)row * DM;
    f32x4 v[8]; float sq = 0.f;
#pragma unroll
    for (int i = 0; i < 8; ++i) v[i] = *(const f32x4*)(xr + (i * 64 + lane) * 4);
#pragma unroll
    for (int i = 0; i < 8; ++i) { u32x2 w; w[0] = cvt_pk_bf16(v[i][0], v[i][1]); w[1] = cvt_pk_bf16(v[i][2], v[i][3]); *(u32x2*)(XB + (size_t)row * DM + (i * 64 + lane) * 4) = w;
      const float y0 = bflo(w[0]), y1 = bfhi(w[0]), y2 = bflo(w[1]), y3 = bfhi(w[1]); sq += y0 * y0 + y1 * y1 + y2 * y2 + y3 * y3; }
    sq = wave_sum(sq);
    if (lane == 0) ss[row] = (u64)(sq * SSQ + 0.5f);
  }
}
__device__ __forceinline__ void final_phase(const bf16_t* __restrict__ XB, const u64* __restrict__ ss, const float* __restrict__ g, float* __restrict__ out) {
  const int lane = tidx() & 63, wid = tidx() >> 6;
  for (int row = blockIdx.x * 8 + wid; row < T; row += gridDim.x * 8) {
    const float rstd = rsqrtf((float)ss[row] * SSQ_INV * (1.f / DM) + EPS);
    u32x4 xv[4];
#pragma unroll
    for (int i = 0; i < 4; ++i) xv[i] = *(const u32x4*)(XB + (size_t)row * DM + (i * 64 + lane) * 8);
#pragma unroll
    for (int i = 0; i < 4; ++i) { const int c = (i * 64 + lane) * 8; const f32x4 g0 = *(const f32x4*)(g + c), g1 = *(const f32x4*)(g + c + 4);
      const f32x4 y0 = (f32x4){bflo(xv[i][0]), bfhi(xv[i][0]), bflo(xv[i][1]), bfhi(xv[i][1])} * rstd * g0, y1 = (f32x4){bflo(xv[i][2]), bfhi(xv[i][2]), bflo(xv[i][3]), bfhi(xv[i][3])} * rstd * g1;
      *(f32x4*)(out + (size_t)row * DM + c) = y0; *(f32x4*)(out + (size_t)row * DM + c + 4) = y1; }
  }
}

__device__ __forceinline__ void prologue(AP a, unsigned char* lds) {
  unsigned char* ws = a->ws;
  float* tile = (float*)lds;
  for (int f = 0; f < (MK_NO_HELPER ? 4 : 1); ++f) {
    const int layer = f >> 1, which = f & 1;
    const float* wg = a->in[which ? 8 : 3] + (size_t)layer * DM * FF; const float* wu = a->in[which ? 9 : 4] + (size_t)layer * DM * FF; const float* wd = a->in[which ? 10 : 5] + (size_t)layer * DM * FF;
    const float* gn = a->in[which ? 7 : 2] + (size_t)layer * DM;
    xpose_mat(wg, DM, FF, (bf16_t*)(ws + WS_WGU + f * SZ_GU), 1, tile, gn);
    xpose_mat(wu, DM, FF, (bf16_t*)(ws + WS_WGU + f * SZ_GU), 2, tile, gn);
    xpose_mat(wd, FF, DM, (bf16_t*)(ws + WS_WD + f * SZ_D), 0, tile);
  }
  xpose_mat(a->in[11], DM, NIN_REAL, (bf16_t*)(ws + WS_WIN), 0, tile, a->in[6]);
#if MK_NO_HELPER
  xpose_mat(a->in[20], DM, DM, (bf16_t*)(ws + WS_WOUT), 0, tile);
  xpose_mat(a->in[21], DM, NQKV, (bf16_t*)(ws + WS_WQKV), 0, tile, a->in[6] + DM);
  xpose_mat(a->in[27], DM, DM, (bf16_t*)(ws + WS_WO), 0, tile);
#endif
  const size_t gtid = (size_t)blockIdx.x * 512 + tidx(), gn = (size_t)gridDim.x * 512;
  { u32x4* p = (u32x4*)(ws + WS_WIN + (size_t)NIN_REAL * DM * 2); const size_t n16 = (size_t)(NIN - NIN_REAL) * DM * 2 / 16; unsigned zz = 0u; asm volatile("" : "+v"(zz)); const u32x4 z = {zz, zz, zz, zz};
    for (size_t i = gtid; i < n16; i += gn) p[i] = z; }
  { u64* ssz = (u64*)(ws + WS_SS); for (size_t i = gtid; i < (size_t)6 * T; i += gn) ssz[i < (size_t)5 * T ? i : i + T] = 0ull; }
  { float* rope = (float*)(ws + WS_ROPE); const int* pos = (const int*)a->in[1];
    for (size_t i = gtid; i < (size_t)T * 16; i += gn) {
      const int tok = (int)(i >> 4), j = (int)(i & 15);
      const float inv = exp2f(-(float)j * (18.931568569324174f / 16.f));
      double rev = (double)pos[tok] * (double)inv * 0.15915494309189535; rev -= floor(rev);
      const float fr = (float)rev;
      rope[(size_t)tok * 32 + j] = __builtin_amdgcn_cosf(fr); rope[(size_t)tok * 32 + 16 + j] = __builtin_amdgcn_sinf(fr);
    } }
  cast_phase(a->in[0], (bf16_t*)(ws + WS_XN), (u64*)(ws + WS_SS) + (size_t)5 * T);
}

__device__ __forceinline__ void conv_module(AP a, unsigned char* lds) {
  const bf16_t* P = (const bf16_t*)(a->ws + WS_H); bf16_t* CAT = (bf16_t*)(a->ws + WS_S);
  unsigned* glu = (unsigned*)lds; float* part = (float*)(lds + 62 * 512 * 4); float* stats = part + 512;
  const int tid = tidx(), lane = tid & 63, wid = tid >> 6, c0 = 2 * tid;
  const float* cw = a->in[12];
  float w0[31], w1[31];
#pragma unroll
  for (int j = 0; j < 31; ++j) { const f32x2 t = *(const f32x2*)(cw + j * 1024 + c0); w0[j] = t[0]; w1[j] = t[1]; }
  const f32x2 cb = *(const f32x2*)(a->in[13] + c0), lg = *(const f32x2*)(a->in[14] + c0), lb = *(const f32x2*)(a->in[15] + c0);
  for (int tile = blockIdx.x; tile < T / 32; tile += gridDim.x) {
    const int tok0 = tile * 32, s0 = tok0 & (SEQ - 1);
    for (int r0 = 0; r0 < 64; r0 += 8) {
      unsigned pv[8], pg[8];
#pragma unroll
      for (int i = 0; i < 8; ++i) { const int r = r0 + i, s = s0 - 15 + r; const bool ok = (r < 62) && s >= 0 && s < SEQ;
        const bf16_t* pr = P + (size_t)(ok ? tok0 - 15 + r : tok0) * NIN + c0; pv[i] = *(const unsigned*)pr; pg[i] = *(const unsigned*)(pr + 1024); }
#pragma unroll
      for (int i = 0; i < 8; ++i) { const int r = r0 + i, s = s0 - 15 + r; const bool ok = s >= 0 && s < SEQ;
        const unsigned val = ok ? cvt_pk_bf16(bflo(pv[i]) * sigm(bflo(pg[i])), bfhi(pv[i]) * sigm(bfhi(pg[i]))) : 0u;
        if (r < 62) glu[r * 512 + tid] = val; }
    }
#pragma unroll 1
    for (int tt = 0; tt < 32; ++tt) {
      float o0 = cb[0], o1 = cb[1];
#pragma unroll
      for (int j = 0; j < 31; ++j) { const unsigned u = glu[(tt + j) * 512 + tid]; o0 += w0[j] * bflo(u); o1 += w1[j] * bfhi(u); }
      const float s = wave_sum(o0 + o1), q = wave_sum(o0 * o0 + o1 * o1);
      if (lane == 0) { part[(wid * 32 + tt) * 2] = s; part[(wid * 32 + tt) * 2 + 1] = q; }
    }
    __syncthreads();
    if (tid < 32) { float s = 0.f, q = 0.f;
      for (int w = 0; w < 8; ++w) { s += part[(w * 32 + tid) * 2]; q += part[(w * 32 + tid) * 2 + 1]; }
      const float mean = s * (1.f / 1024.f), var = fmaxf(q * (1.f / 1024.f) - mean * mean, 0.f);
      stats[tid * 2] = mean; stats[tid * 2 + 1] = rsqrtf(var + EPS); }
    __syncthreads();
#pragma unroll 1
    for (int tt = 0; tt < 32; ++tt) {
      float o0 = cb[0], o1 = cb[1];
#pragma unroll
      for (int j = 0; j < 31; ++j) { const unsigned u = glu[(tt + j) * 512 + tid]; o0 += w0[j] * bflo(u); o1 += w1[j] * bfhi(u); }
      const float mean = stats[tt * 2], rstd = stats[tt * 2 + 1];
      const float y0 = (o0 - mean) * rstd * lg[0] + lb[0], y1 = (o1 - mean) * rstd * lg[1] + lb[1];
      *(unsigned*)(CAT + (size_t)(tok0 + tt) * DM + c0) = cvt_pk_bf16(silu(y0), silu(y1));
    }
    __syncthreads();
  }
}

__device__ __forceinline__ void dn_prep(AP a) {
  const bf16_t* P = (const bf16_t*)(a->ws + WS_H);
  bf16_t* QN = (bf16_t*)(a->ws + WS_S); bf16_t* KN = (bf16_t*)(a->ws + WS_S + SZ_T1K); bf16_t* VS = (bf16_t*)(a->ws + WS_S + 2 * SZ_T1K);
  const float* sw = a->in[16];
  const int lane = tidx() & 63, wid = tidx() >> 6;
  for (int tok = blockIdx.x * 8 + wid; tok < T; tok += gridDim.x * 8) {
    const int s = tok & (SEQ - 1);
#pragma unroll 1
    for (int sb = 0; sb < 24; sb += 4) {
      unsigned x0[4], xm[4], xp[4]; f32x2 wa[4], wb[4], wc[4];
#pragma unroll
      for (int i = 0; i < 4; ++i) { const int c = (sb + i) * 128 + 2 * lane; const bf16_t* pr = P + (size_t)tok * NIN + 2048 + c;
        x0[i] = *(const unsigned*)pr; xm[i] = *(const unsigned*)(pr - (s > 0 ? NIN : 0)); xp[i] = *(const unsigned*)(pr + (s < SEQ - 1 ? NIN : 0));
        wa[i] = *(const f32x2*)(sw + c); wb[i] = *(const f32x2*)(sw + 3072 + c); wc[i] = *(const f32x2*)(sw + 6144 + c); }
#pragma unroll
      for (int i = 0; i < 4; ++i) { const int slot = sb + i;
        const unsigned um = (s > 0) ? xm[i] : 0u, up = (s < SEQ - 1) ? xp[i] : 0u;
        float y0 = wa[i][0] * bflo(um) + wb[i][0] * bflo(x0[i]) + wc[i][0] * bflo(up), y1 = wa[i][1] * bfhi(um) + wb[i][1] * bfhi(x0[i]) + wc[i][1] * bfhi(up);
        y0 = silu(y0); y1 = silu(y1);
        if (slot < 16) { const float ss = wave_sum(y0 * y0 + y1 * y1); float r = rsqrtf(ss + EPS); if (slot < 8) r *= 0.08838834764831845f; y0 *= r; y1 *= r; }
        bf16_t* dst = (slot < 8 ? QN : (slot < 16 ? KN : VS)) + (size_t)tok * 1024 + (slot & 7) * 128 + 2 * lane;
        *(unsigned*)dst = cvt_pk_bf16(y0, y1); }
    }
  }
  const float* BA = (const float*)(a->ws + WS_BA); float* BG = (float*)(a->ws + WS_BG);
  for (size_t i = (size_t)blockIdx.x * 512 + tidx(); i < (size_t)T * 16; i += (size_t)gridDim.x * 512) {
    const int tok = (int)(i >> 4), j = (int)(i & 15);
    const float braw = BA[(size_t)tok * 32 + j], araw = BA[(size_t)tok * 32 + 16 + j];
    const float xx = araw + a->in[18][j]; const float sp = xx > 20.f ? xx : log1pf(expf(xx));
    const float g = -expf(a->in[17][j]) * sp;
    BG[(size_t)tok * 32 + j] = sigm(braw); BG[(size_t)tok * 32 + 16 + j] = expf(g);
  }
}

__device__ __forceinline__ void scan_phase(AP a, unsigned char* lds) {
  const bf16_t* QN = (const bf16_t*)(a->ws + WS_S); const bf16_t* KN = (const bf16_t*)(a->ws + WS_S + SZ_T1K); const bf16_t* VS = (const bf16_t*)(a->ws + WS_S + 2 * SZ_T1K);
  const float* BG = (const float*)(a->ws + WS_BG);
  constexpr int BUF_F = 32 * 128 * 2 + 32 * 32 + 64;
  float* sb = (float*)lds; float* ob = sb + 2 * BUF_F;
  float* dump = ob + 2048 + (tidx() & 255);
  float* wtile = (float*)(lds + 86016) + ((tidx() >> 6) & 3) * (64 * 33);
  int hid = (int)blockIdx.x * 4 + ((tidx() >> 6) & 3); const int hstep = (int)gridDim.x * 4;
  float* gains = (float*)(lds + 119808);
  for (int i = tidx(); i < 4 * DM; i += 512) { const int v = i >> 11, k = i & (DM - 1); gains[i] = (v == 0) ? a->in[7][k] : (v == 1) ? a->in[2][DM + k] : (v == 2) ? a->in[7][DM + k] : a->in[6][DM + k]; }
  __syncthreads();
  int hprev = -1; float hv[32];
#pragma unroll
  for (int i = 0; i < 32; ++i) hv[i] = 0.f;
  const int tid = tidx(), lane = tid & 63, wid = tid >> 6, j = lane & 7, col = (wid & 3) * 8 + (lane >> 3);
  const int tl = tid >> 4, c8 = (tid & 15) * 8, tlv = (tid >> 2) & 31, cv = (tid & 3) * 8;
  for (int item = blockIdx.x; item < 256; item += gridDim.x) {
    const int cb = item & 3, dir = (item >> 2) & 1, h = (item >> 3) & 7, b = item >> 6;
    bf16_t* OD = (bf16_t*)(a->ws + WS_S + (3 + dir) * SZ_T1K);
    f32x2 S2[8];
#pragma unroll
    for (int i = 0; i < 8; ++i) S2[i] = (f32x2){0.f, 0.f};
    u32x4 kr, qr, vr; float ar = 0.f, br = 0.f;
#define SC_TOK(c, t) (b * SEQ + (dir ? (SEQ - 1 - ((c) * 32 + (t))) : ((c) * 32 + (t))))
#define SC_LOAD(c) do { const size_t tk = (size_t)SC_TOK(c, tl); kr = *(const u32x4*)(KN + tk * 1024 + h * 128 + c8); qr = *(const u32x4*)(QN + tk * 1024 + h * 128 + c8); \
      if (tid < 128) vr = *(const u32x4*)(VS + (size_t)SC_TOK(c, tlv) * 1024 + h * 128 + cb * 32 + cv); \
      else if (tid < 160) { const size_t t2 = (size_t)SC_TOK(c, tid - 128); br = BG[t2 * 32 + dir * 8 + h]; ar = BG[t2 * 32 + 16 + dir * 8 + h]; } } while (0)
#define SC_WRITE(bi) do { float* kb = sb + (bi) * BUF_F; float* qb = kb + 4096; float* vb = qb + 4096; float* abp = vb + 1024; \
      *(f32x4*)(kb + tl * 128 + c8) = (f32x4){bflo(kr[0]), bfhi(kr[0]), bflo(kr[1]), bfhi(kr[1])}; *(f32x4*)(kb + tl * 128 + c8 + 4) = (f32x4){bflo(kr[2]), bfhi(kr[2]), bflo(kr[3]), bfhi(kr[3])}; \
      *(f32x4*)(qb + tl * 128 + c8) = (f32x4){bflo(qr[0]), bfhi(qr[0]), bflo(qr[1]), bfhi(qr[1])}; *(f32x4*)(qb + tl * 128 + c8 + 4) = (f32x4){bflo(qr[2]), bfhi(qr[2]), bflo(qr[3]), bfhi(qr[3])}; \
      if (tid < 128) { *(f32x4*)(vb + tlv * 32 + cv) = (f32x4){bflo(vr[0]), bfhi(vr[0]), bflo(vr[1]), bfhi(vr[1])}; *(f32x4*)(vb + tlv * 32 + cv + 4) = (f32x4){bflo(vr[2]), bfhi(vr[2]), bflo(vr[3]), bfhi(vr[3])}; } \
      else if (tid < 160) { abp[(tid - 128) * 2] = ar; abp[(tid - 128) * 2 + 1] = br; } } while (0)
#define SC_FLUSH(c) do { if (tid < 128) { const float* op = ob + ((c) & 1) * 1024 + tlv * 32 + cv; const f32x4 x0 = *(const f32x4*)op, x1 = *(const f32x4*)(op + 4); \
      u32x4 w; w[0] = cvt_pk_bf16(x0[0], x0[1]); w[1] = cvt_pk_bf16(x0[2], x0[3]); w[2] = cvt_pk_bf16(x1[0], x1[1]); w[3] = cvt_pk_bf16(x1[2], x1[3]); \
      *(u32x4*)(OD + (size_t)SC_TOK(c, tlv) * 1024 + h * 128 + cb * 32 + cv) = w; } } while (0)
    __syncthreads();
    SC_LOAD(0); SC_WRITE(0); __syncthreads();
    for (int c = 0; c < SEQ / 32; ++c) {
      if (c + 1 < SEQ / 32) SC_LOAD(c + 1);
      if (c > 0) SC_FLUSH(c - 1);
      const float* kb = sb + (c & 1) * BUF_F; const float* qb = kb + 4096; const float* vb = qb + 4096; const float* abp = vb + 1024; float* obc = ob + (c & 1) * 1024;
      if (wid < 4) {
        f32x4 kv[4], qv[4]; f32x2 ab2; float vv;
#define SC_LD(t) do { _Pragma("unroll") for (int i = 0; i < 4; ++i) { kv[i] = *(const f32x4*)(kb + (t) * 128 + 16 * j + 4 * i); qv[i] = *(const f32x4*)(qb + (t) * 128 + 16 * j + 4 * i); } \
          ab2 = *(const f32x2*)(abp + (t) * 2); vv = vb[(t) * 32 + col]; } while (0)
        SC_LD(0);
#pragma unroll 8
        for (int t = 0; t < 32; ++t) {
          f32x2 kk[8], qq[8];
#pragma unroll
          for (int i = 0; i < 4; ++i) { kk[2 * i] = (f32x2){kv[i][0], kv[i][1]}; kk[2 * i + 1] = (f32x2){kv[i][2], kv[i][3]}; qq[2 * i] = (f32x2){qv[i][0], qv[i][1]}; qq[2 * i + 1] = (f32x2){qv[i][2], qv[i][3]}; }
          const float al = ab2[0], bt = ab2[1], vc = vv;
          SC_LD((t + 1) & 31);
          f32x2 d0 = S2[0] * kk[0], d1 = S2[1] * kk[1];
#pragma unroll
          for (int i = 1; i < 4; ++i) { d0 = S2[2 * i] * kk[2 * i] + d0; d1 = S2[2 * i + 1] * kk[2 * i + 1] + d1; }
          d0 = d0 + d1;
          const float d = row_sum8(d0[0] + d0[1]);
          const float dl = bt * (vc - al * d);
          const f32x2 dl2 = {dl, dl}, al2 = {al, al};
#pragma unroll
          for (int i = 0; i < 8; ++i) S2[i] = kk[i] * dl2 + S2[i] * al2;
          f32x2 o0 = S2[0] * qq[0], o1 = S2[1] * qq[1];
#pragma unroll
          for (int i = 1; i < 4; ++i) { o0 = S2[2 * i] * qq[2 * i] + o0; o1 = S2[2 * i + 1] * qq[2 * i + 1] + o1; }
          o0 = o0 + o1;
          const float od = row_sum8(o0[0] + o0[1]);
          *((j == 0) ? (obc + t * 32 + col) : dump) = od;
        }
#undef SC_LD
      } else {
        if (hprev >= 0) helper_finish(a, hprev, hv, wtile, gains, lane);
        if (hid < HT_TOTAL) { helper_issue(a, hid, hv, lane); hprev = hid; hid += hstep; } else hprev = -1;
      }
      if (c + 1 < SEQ / 32) SC_WRITE((c + 1) & 1);
      asm volatile("s_waitcnt lgkmcnt(0)" ::: "memory"); __builtin_amdgcn_s_barrier(); asm volatile("" ::: "memory");
    }
    SC_FLUSH(SEQ / 32 - 1);
    __syncthreads();
#undef SC_TOK
#undef SC_LOAD
#undef SC_WRITE
#undef SC_FLUSH
  }
  if (wid >= 4) { if (hprev >= 0) helper_finish(a, hprev, hv, wtile, gains, lane); for (; hid < HT_TOTAL; hid += hstep) { helper_issue(a, hid, hv, lane); helper_finish(a, hid, hv, wtile, gains, lane); } }
}

__device__ __forceinline__ void gnorm_phase(AP a) {
  const bf16_t* P = (const bf16_t*)(a->ws + WS_H); bf16_t* CAT = (bf16_t*)(a->ws + WS_S);
  const bf16_t* OF = (const bf16_t*)(a->ws + WS_S + 3 * SZ_T1K); const bf16_t* OB = (const bf16_t*)(a->ws + WS_S + 4 * SZ_T1K);
  const int lane = tidx() & 63, wid = tidx() >> 6;
  const f32x2 g = *(const f32x2*)(a->in[19] + 2 * lane);
  for (int tok = blockIdx.x * 8 + wid; tok < T; tok += gridDim.x * 8) {
    unsigned uf[8], ub[8], uz[8];
#pragma unroll
    for (int h = 0; h < 8; ++h) { const size_t o = (size_t)tok * 1024 + h * 128 + 2 * lane;
      uf[h] = *(const unsigned*)(OF + o); ub[h] = *(const unsigned*)(OB + o); uz[h] = *(const unsigned*)(P + (size_t)tok * NIN + 5120 + h * 128 + 2 * lane); }
#pragma unroll
    for (int h = 0; h < 8; ++h) {
      const float o0 = bflo(uf[h]) + bflo(ub[h]), o1 = bfhi(uf[h]) + bfhi(ub[h]);
      const float ss = wave_sum(o0 * o0 + o1 * o1), rstd = rsqrtf(ss * (1.f / 128.f) + EPS);
      const float y0 = o0 * rstd * g[0] * silu(bflo(uz[h])), y1 = o1 * rstd * g[1] * silu(bfhi(uz[h]));
      *(unsigned*)(CAT + (size_t)tok * DM + 1024 + h * 128 + 2 * lane) = cvt_pk_bf16(y0, y1);
    }
  }
}

__device__ __forceinline__ void attn_phase(AP a, unsigned char* lds) {
  const bf16_t* QKV = (const bf16_t*)(a->ws + WS_H); float* OA = (float*)(a->ws + WS_S);
  const int lane = tidx() & 63;
  const float s1 = wave_sum(a->in[22][lane] * a->in[23][lane] + a->in[22][lane + 64] * a->in[23][lane + 64]);
  const float s2 = wave_sum(a->in[24][lane] * a->in[25][lane] + a->in[24][lane + 64] * a->in[25][lane + 64]);
  const float lam = __int_as_float(__builtin_amdgcn_readfirstlane(__float_as_int(expf(s1) - expf(s2) + LAMBDA_INIT)));
  int seq = SEQ; asm volatile("" : "+s"(seq));
  const int nk = (512 - (int)blockIdx.x + (int)gridDim.x - 1) / (int)gridDim.x;
#pragma unroll 1
  for (int it = 0; it < 4 * nk; ++it) {
    const int item = blockIdx.x + gridDim.x * (it >> 2), m = it & 1, vh = (it >> 1) & 1;
    const int h = item & 7, qb = (item >> 3) & 15, b = item >> 7;
    const size_t tok0 = (size_t)b * SEQ + qb * 256, kv0 = (size_t)b * SEQ;
    att::attn_dense_body<att::bf16>(QKV + tok0 * NQKV + h * 256 + m * 128, QKV + kv0 * NQKV + 2048 + h * 256 + m * 128, QKV + kv0 * NQKV + 4096 + h * 256 + vh * 128,
                                    OA + tok0 * DM + h * 256 + vh * 128, seq, (char*)lds, m, lam, (unsigned short*)(lds + 69632));
    __syncthreads();
    if ((it & 3) == 3) {
      asm volatile("s_waitcnt vmcnt(0)" ::: "memory");
      const int wv = tidx() >> 6, ln = tidx() & 63; bf16_t* CAT = (bf16_t*)a->out;
      const f32x4 sg = *(const f32x4*)(a->in[26] + 4 * ln);
#pragma unroll 4
      for (int r = 0; r < 32; ++r) {
        const size_t o = (tok0 + wv * 32 + r) * DM + h * 256 + 4 * ln;
        const f32x4 v = *(const f32x4*)(OA + o);
        const float ss = wave_sum(v[0] * v[0] + v[1] * v[1] + v[2] * v[2] + v[3] * v[3]), rr = rsqrtf(ss * (1.f / 256.f) + EPS) * (1.f - LAMBDA_INIT);
        u32x2 w; w[0] = cvt_pk_bf16(v[0] * rr * sg[0], v[1] * rr * sg[1]); w[1] = cvt_pk_bf16(v[2] * rr * sg[2], v[3] * rr * sg[3]);
        *(u32x2*)(CAT + o) = w;
      }
    }
  }
}
__device__ __forceinline__ void subln_phase(AP a) {
  const float* OA = (const float*)(a->ws + WS_S); bf16_t* CAT = (bf16_t*)(a->ws + WS_H);
  const int lane = tidx() & 63, wid = tidx() >> 6;
  const f32x4 g = *(const f32x4*)(a->in[26] + 4 * lane);
  for (int task = blockIdx.x * 8 + wid; task < T * 8; task += gridDim.x * 8) {
    const size_t o = (size_t)(task >> 3) * DM + (task & 7) * 256 + 4 * lane;
    const f32x4 v = *(const f32x4*)(OA + o);
    const float ss = wave_sum(v[0] * v[0] + v[1] * v[1] + v[2] * v[2] + v[3] * v[3]), r = rsqrtf(ss * (1.f / 256.f) + EPS) * (1.f - LAMBDA_INIT);
    u32x2 w; w[0] = cvt_pk_bf16(v[0] * r * g[0], v[1] * r * g[1]); w[1] = cvt_pk_bf16(v[2] * r * g[2], v[3] * r * g[3]);
    *(u32x2*)(CAT + o) = w;
  }
}

__device__ __forceinline__ void bar_spin(const unsigned* w, unsigned old) {
  for (unsigned n = 0; n < (1u << 22); ++n) {
    if (__hip_atomic_load(w, __ATOMIC_RELAXED, __HIP_MEMORY_SCOPE_AGENT) != old) break;
    __builtin_amdgcn_s_sleep(1);
  }
}
__device__ __forceinline__ void fast_grid_barrier(unsigned* bar, unsigned nblocks) {
  __syncthreads();
  if (threadIdx.x == 0) {
    const unsigned grp = blockIdx.x & 7u, gsize = (nblocks - grp + 7u) >> 3, ngroups = nblocks < 8u ? nblocks : 8u;
    unsigned* gcount = bar + 64 * grp; unsigned* ggen = bar + 64 * (8 + grp); unsigned* tcount = bar + 64 * 16; unsigned* tgen = bar + 64 * 17;
    __builtin_amdgcn_fence(__ATOMIC_RELEASE, "agent");
    const unsigned myg = __hip_atomic_load(ggen, __ATOMIC_RELAXED, __HIP_MEMORY_SCOPE_AGENT);
    const unsigned prev = __hip_atomic_fetch_add(gcount, 1u, __ATOMIC_ACQ_REL, __HIP_MEMORY_SCOPE_AGENT);
    if (prev == gsize - 1u) {
      __hip_atomic_store(gcount, 0u, __ATOMIC_RELAXED, __HIP_MEMORY_SCOPE_AGENT);
      const unsigned tg = __hip_atomic_load(tgen, __ATOMIC_RELAXED, __HIP_MEMORY_SCOPE_AGENT);
      const unsigned p2 = __hip_atomic_fetch_add(tcount, 1u, __ATOMIC_ACQ_REL, __HIP_MEMORY_SCOPE_AGENT);
      if (p2 == ngroups - 1u) { __hip_atomic_store(tcount, 0u, __ATOMIC_RELAXED, __HIP_MEMORY_SCOPE_AGENT); __hip_atomic_fetch_add(tgen, 1u, __ATOMIC_RELEASE, __HIP_MEMORY_SCOPE_AGENT); }
      else bar_spin(tgen, tg);
      __hip_atomic_fetch_add(ggen, 1u, __ATOMIC_RELEASE, __HIP_MEMORY_SCOPE_AGENT);
    } else bar_spin(ggen, myg);
    __builtin_amdgcn_fence(__ATOMIC_ACQUIRE, "agent");
  }
  __syncthreads();
}

enum { PT_PRO, PT_GU, PT_RES, PT_NORM, PT_IN, PT_CONV, PT_SCAN, PT_GNORM, PT_QKV, PT_ATTN, PT_SUBLN, PT_FINAL };

__global__ void __launch_bounds__(512, 2) mega(Args a_kernarg) {
  extern __shared__ __attribute__((aligned(16))) unsigned char lds[];
  cg::grid_group grid = cg::this_grid();
  const AP a0 = (AP)__builtin_amdgcn_kernarg_segment_ptr();
  const int ph_lo = a0->ph_lo, ph_hi = a0->ph_hi;
  for (int php = ph_lo; php < ph_hi; ++php) {
    int ph = php;
#ifndef MK_DUP_PH
#define DUP2 0
#else
#define DUP2 (int)dup2
#endif
#ifdef MK_DUP_PH
    bool dup2 = false;
    if (php > MK_DUP_PH) { ph = php - 1; dup2 = (php == MK_DUP_PH + 1); }
#endif
    unsigned long long apv = (unsigned long long)a0; asm volatile("" : "+s"(apv)); const AP a = (AP)apv;
    unsigned char* ws = a->ws;
    int type = PT_PRO, f = 0, nss = -1;
    const bf16_t* gA = (const bf16_t*)(ws + WS_H); const bf16_t* gB = nullptr; int gK = FF;
    switch (ph) {
      case 0: type = PT_PRO; break;
      case 1: type = PT_GU; f = 0; nss = 5; break;
      case 2: type = PT_RES; gB = (const bf16_t*)(ws + WS_WD); nss = 0; break;
      case 3: type = PT_IN; nss = 0; break;
      case 4: type = PT_CONV; break;
      case 5: type = PT_SCAN; break;
      case 6: type = PT_GNORM; break;
      case 7: type = PT_RES; gA = (const bf16_t*)(ws + WS_S); gB = (const bf16_t*)(ws + WS_WOUT); gK = DM; nss = 1; break;
      case 8: type = PT_GU; f = 1; nss = 1; break;
      case 9: type = PT_RES; gB = (const bf16_t*)(ws + WS_WD + 1 * SZ_D); nss = 2; break;
      case 10: type = PT_GU; f = 2; nss = 2; break;
      case 11: type = PT_RES; gB = (const bf16_t*)(ws + WS_WD + 2 * SZ_D); nss = 3; break;
      case 12: type = PT_QKV; nss = 3; break;
      case 13: type = PT_ATTN; break;
      case 14: type = PT_SUBLN; break;
      case 15: type = PT_RES; gA = (const bf16_t*)a->out; gB = (const bf16_t*)(ws + WS_WO); gK = DM; nss = 4; break;
      case 16: type = PT_GU; f = 3; nss = 4; break;
      case 17: type = PT_RES; gB = (const bf16_t*)(ws + WS_WD + 3 * SZ_D); break;
      default: type = PT_FINAL; break;
    }
    const u64* ssp = (const u64*)(ws + WS_SS) + (size_t)(nss >= 0 ? nss : 0) * T;
    pg8::StaticOrder S;
#ifndef MK_ENABLE
#define MK_ENABLE 0xFFFF
#endif
    if (!((MK_ENABLE >> type) & 1)) continue;
    if (type == PT_SUBLN) continue;
    switch (type) {
      case PT_PRO: prologue(a, lds); break;
      case PT_GU: {
#ifdef MK_STAGGER
        if ((blockIdx.x >> 3) & 1) { const unsigned long long t0 = __builtin_amdgcn_s_memrealtime(); while (__builtin_amdgcn_s_memrealtime() - t0 < MK_STAGGER) __builtin_amdgcn_s_sleep(32); }
#endif
        pg8::Gemm g{(const bf16_t*)(ws + WS_XN), (const bf16_t*)(ws + WS_WGU + (size_t)f * SZ_GU), T, 2 * FF, DM}; S.init(T, 2 * FF, gridDim.x, blockIdx.x);
        EpiSwiglu E{(bf16_t*)(ws + WS_H), ssp, DUP2}; pg8::gemm_phase<EpiSwiglu, pg8::StaticOrder>((PG8_LAS unsigned char*)lds, g, S, E, nullptr); } break;
      case PT_RES: { pg8::Gemm g{gA, gB, T, DM, gK}; S.init(T, DM, gridDim.x, blockIdx.x);
        EpiResid E{a, ph, DUP2}; pg8::gemm_phase<EpiResid, pg8::StaticOrder>((PG8_LAS unsigned char*)lds, g, S, E, nullptr); } break;
      case PT_IN: { pg8::Gemm g{(const bf16_t*)(ws + WS_XN), (const bf16_t*)(ws + WS_WIN), T, NIN, DM}; S.init(T, NIN, gridDim.x, blockIdx.x);
        EpiP E{(bf16_t*)(ws + WS_H), (float*)(ws + WS_BA), ssp}; pg8::gemm_phase<EpiP, pg8::StaticOrder>((PG8_LAS unsigned char*)lds, g, S, E, nullptr); } break;
      case PT_CONV: dn_prep(a); break;
      case PT_SCAN: scan_phase(a, lds); break;
      case PT_GNORM: gnorm_phase(a); conv_module(a, lds); break;
      case PT_QKV: { pg8::Gemm g{(const bf16_t*)(ws + WS_XN), (const bf16_t*)(ws + WS_WQKV), T, NQKV, DM}; S.init(T, NQKV, gridDim.x, blockIdx.x);
        EpiQKV E{(bf16_t*)(ws + WS_H), (const float*)(ws + WS_ROPE), ssp}; pg8::gemm_phase<EpiQKV, pg8::StaticOrder>((PG8_LAS unsigned char*)lds, g, S, E, nullptr); } break;
      case PT_ATTN: attn_phase(a, lds); break;
      case PT_SUBLN: break;
      default: final_phase((const bf16_t*)(ws + WS_XN), (const u64*)(ws + WS_SS) + (size_t)6 * T, a->in[28], a->out); break;
    }
    if (php + 1 < ph_hi) { if (php == ph_lo) grid.sync(); else fast_grid_barrier((unsigned*)(a0->ws + WS_BAR), gridDim.x); }
  }
}
}

#ifndef MK_MULTI
#define MK_MULTI 0
#endif
extern "C" void kernel_launch(void* const* d_in, const int* in_sizes, int n_in, void* d_out, int out_size, void* d_ws, size_t ws_size, hipStream_t stream) {
  static int grid = 0;
  if (grid == 0) {
    if (n_in != 29 || out_size != mk::T * mk::DM || ws_size < mk::WS_END) { fprintf(stderr, "kernel_launch: unexpected shapes n_in %d out %d ws %zu (need %zu)\n", n_in, out_size, ws_size, (size_t)mk::WS_END); grid = -1; return; }
    int dev = 0, cus = 0, per_cu = 0;
    hipGetDevice(&dev); hipDeviceGetAttribute(&cus, hipDeviceAttributeMultiprocessorCount, dev);
    if (hipFuncSetAttribute((const void*)mk::mega, hipFuncAttributeMaxDynamicSharedMemorySize, mk::LDS_BYTES) != hipSuccess) { fprintf(stderr, "kernel_launch: hipFuncSetAttribute failed\n"); grid = -1; return; }
    hipOccupancyMaxActiveBlocksPerMultiprocessor(&per_cu, (const void*)mk::mega, 512, mk::LDS_BYTES);
    if (per_cu < 1) per_cu = 1;
    grid = cus * per_cu;
    (void)hipGetLastError();
  }
  if (grid < 0) return;
  mk::Args a{};
  for (int i = 0; i < 29; ++i) a.in[i] = (const float*)d_in[i];
  a.out = (float*)d_out; a.ws = (unsigned char*)d_ws;
#if MK_MULTI
  for (int ph = 0; ph < mk::NPHASE; ++ph) { a.ph_lo = ph; a.ph_hi = ph + 1; hipLaunchKernelGGL(mk::mega, dim3(grid), dim3(512), mk::LDS_BYTES, stream, a); }
#else
  a.ph_lo = 0; a.ph_hi = mk::NPHASE;
  (void)hipMemsetAsync((char*)d_ws + mk::WS_BAR, 0, 8192, stream);
  void* args[] = {&a};
  hipError_t e = hipLaunchCooperativeKernel((const void*)mk::mega, dim3(grid), dim3(512), args, mk::LDS_BYTES, stream);
  if (e != hipSuccess) fprintf(stderr, "cooperative launch failed: %s (grid %d)\n", hipGetErrorString(e), grid);
#endif
}
```

```cpp
#include <hip/hip_runtime.h>
#include <hip/hip_cooperative_groups.h>
#include <cstdio>
#include <cstdint>
namespace cg = cooperative_groups;
__device__ __forceinline__ int tidx() { int t = threadIdx.x; asm volatile("" : "+v"(t)); return t; }
namespace pg8 {
#define PG8_LAS __attribute__((address_space(3)))
typedef unsigned short bf16_t;
typedef short bf16x8 __attribute__((ext_vector_type(8)));
typedef float f32x4 __attribute__((ext_vector_type(4)));
typedef unsigned u32x4 __attribute__((ext_vector_type(4)));
constexpr int BM = 256, BK = 64, HALF = 128, HTB = HALF * BK * 2  , STAGE_BYTES = 8 * HTB, NXCD = 8, WGM = 4;

__host__ __device__ __forceinline__ int lds_byte(int r, int c) { const int st = (r >> 4) * 2 + (c >> 5), rr = r & 15, cc = c & 31, ob = rr * 64 + cc * 2; return st * 1024 + (ob ^ (((ob >> 9) & 1) << 5)); }
__host__ __device__ __forceinline__ void stage_rc(int b, int& R, int& C) { const int st = b / 1024, sb = b % 1024, swz = sb ^ (((sb >> 9) & 1) << 5); R = (st >> 1) * 16 + swz / 64; C = (st & 1) * 32 + (swz % 64) / 2; }
__host__ __device__ __forceinline__ int perm32(int rho) { const int n = rho >> 4, i = rho & 15; return 8 * (i >> 2) + 4 * n + (i & 3); }
struct Unit { int pm, pn; };
struct Gemm { const bf16_t* A; const bf16_t* Bt; int M, N, K; };

struct StaticOrder {
    int nM, nN, nwg, G, c;
    __host__ __device__ void init(int M, int N, int G_, int c_) { nM = M / BM; nN = N / BM; nwg = nM * nN; G = G_; c = c_; }
    __host__ __device__ bool next(int i, Unit& u) const {
        const long L = (long)i * G + c; if (L >= nwg) return false;
        int wgid = (int)L; { const int q = nwg / NXCD, r = nwg % NXCD, xcd = wgid % NXCD, off = wgid / NXCD; wgid = (xcd < r ? xcd * (q + 1) : r * (q + 1) + (xcd - r) * q) + off; }
        const int nig = WGM * nN, gid = wgid / nig, fm = gid * WGM, gsz = (nM - fm) < WGM ? (nM - fm) : WGM;
        u.pm = fm + ((wgid % nig) % gsz); u.pn = (wgid % nig) / gsz; return true;
    }
    __device__ __forceinline__ void a_ready(const Unit&) const {}
    __device__ __forceinline__ void done(const Unit&) const {}
};
__device__ __forceinline__ unsigned cvt_pk_bf16(float lo, float hi) { unsigned r; asm volatile("v_cvt_pk_bf16_f32 %0, %1, %2" : "=v"(r) : "v"(lo), "v"(hi)); return r; }
template <class Epi, class Sched, bool STAMP = false>
__device__ __forceinline__ void gemm_phase(PG8_LAS unsigned char* lds, const Gemm g, const Sched& S, const Epi& E, unsigned long long* stamps) {
    const int tid = tidx(), wid = __builtin_amdgcn_readfirstlane(tid >> 6), lane = tid & 63, wr = wid >> 2, wc = wid & 3, fr = lane & 15, fq = lane >> 4;
    const int K = g.K, nt = K / BK;
    int ts_lo = 0, ts_hi = 0, nts = 0; const unsigned long long rt_entry = STAMP ? (unsigned long long)wall_clock64() : 0ull;
#define PG8_STAMP() do { if (STAMP && wid == 0 && nts < 64) { const unsigned long long _c = (unsigned long long)clock64(); \
        ts_lo = (lane == nts) ? (int)(unsigned)_c : ts_lo; ts_hi = (lane == nts) ? (int)(unsigned)(_c >> 32) : ts_hi; ++nts; } } while (0)
    PG8_STAMP();
    unsigned voffA[2], voffB[2];
#pragma unroll
    for (int i = 0; i < 2; ++i) { int R, C; stage_rc(tid * 16 + i * 8192, R, C); const int Rb = Epi::PERM ? ((R & ~31) + perm32(R & 31)) : R;
        voffA[i] = (unsigned)(R * K + C) * 2u; voffB[i] = (unsigned)(Rb * K + C) * 2u; }
    const size_t kstep = (size_t)(BK * 2);
    const size_t hstep = (size_t)HALF * K * 2;
    const size_t tstep = 2 * hstep;
    const unsigned ldsw = (unsigned)wid * 1024u;
    const int aoff = lds_byte(wr * 64 + fr, fq * 8), boff = lds_byte(wc * 32 + fr, fq * 8);
#define PG8_SA(b, h) (((b) * 2 + (h)) * HTB)
#define PG8_SB(b, h) ((4 + (b) * 2 + (h)) * HTB)
#define PG8_STAGE(bufoff, gbase, voff) do { _Pragma("unroll") for (int _i = 0; _i < 2; ++_i) \
        __builtin_amdgcn_global_load_lds((const unsigned*)((const char*)(gbase) + (voff)[_i]), (PG8_LAS unsigned*)(lds + (bufoff) + ldsw + _i * 8192), 16, 0, 0); } while (0)
#define PG8_LDA(dst, b, h) do { _Pragma("unroll") for (int m = 0; m < 4; ++m) _Pragma("unroll") for (int k = 0; k < 2; ++k) dst[m][k] = *(const PG8_LAS bf16x8*)(lds + PG8_SA(b, h) + aoff + m * 2048 + k * 1024); } while (0)
#define PG8_LDB(dst, b, h) do { _Pragma("unroll") for (int n = 0; n < 2; ++n) _Pragma("unroll") for (int k = 0; k < 2; ++k) dst[n][k] = *(const PG8_LAS bf16x8*)(lds + PG8_SB(b, h) + boff + n * 2048 + k * 1024); } while (0)
#define PG8_MMA(ai, bj, At, Bt) do { __builtin_amdgcn_s_setprio(1); _Pragma("unroll") for (int m = 0; m < 4; ++m) _Pragma("unroll") for (int n = 0; n < 2; ++n) _Pragma("unroll") for (int k = 0; k < 2; ++k) \
        acc[ai][bj][m][n] = __builtin_amdgcn_mfma_f32_16x16x32_bf16(Bt[n][k], At[m][k], acc[ai][bj][m][n], 0, 0, 0); __builtin_amdgcn_s_setprio(0); } while (0)
#define PG8_WAIT_V(n) asm volatile("s_waitcnt vmcnt(" #n ")" ::: "memory")
#define PG8_WAIT_L(n) asm volatile("s_waitcnt lgkmcnt(" #n ")" ::: "memory")
#define PG8_BAR __builtin_amdgcn_s_barrier()
#define PG8_SCHED __builtin_amdgcn_sched_barrier(0)
    Unit cur, nxt; int ui = 0;
    if (!S.next(0, cur)) return;
    f32x4 acc[2][2][4][2];
#pragma unroll
    for (int a = 0; a < 2; ++a)
#pragma unroll
        for (int b = 0; b < 2; ++b)
#pragma unroll
            for (int m = 0; m < 4; ++m)
#pragma unroll
                for (int n = 0; n < 2; ++n) acc[a][b][m][n] = (f32x4){0.f, 0.f, 0.f, 0.f};
    bf16x8 At[4][2], B0[2][2], B1[2][2];
    const char* cA = (const char*)g.A + (size_t)cur.pm * tstep; const char* cB = (const char*)g.Bt + (size_t)cur.pn * tstep;
    S.a_ready(cur);
    PG8_STAGE(PG8_SB(0, 0), cB, voffB); PG8_STAGE(PG8_SA(0, 0), cA, voffA); PG8_STAGE(PG8_SB(0, 1), cB + hstep, voffB); PG8_STAGE(PG8_SA(0, 1), cA + hstep, voffA);
    if (wr == 1) PG8_BAR;
    PG8_WAIT_V(4); PG8_BAR;
    PG8_STAGE(PG8_SB(1, 0), cB + kstep, voffB); PG8_STAGE(PG8_SA(1, 0), cA + kstep, voffA); PG8_STAGE(PG8_SB(1, 1), cB + hstep + kstep, voffB);
    PG8_WAIT_V(6); PG8_BAR;
    PG8_STAMP();
    for (;;) {
        const bool has_next = S.next(ui + 1, nxt);
        const char* nA = has_next ? (const char*)g.A + (size_t)nxt.pm * tstep : cA; const char* nB = has_next ? (const char*)g.Bt + (size_t)nxt.pn * tstep : cB;
        for (int t = 0; t < nt; t += 2) {
            const bool last = (t == nt - 2);
            const char* a1 = cA + (size_t)(t + 1) * kstep;
            const char* a2 = last ? nA : cA + (size_t)(t + 2) * kstep; const char* b2 = last ? nB : cB + (size_t)(t + 2) * kstep;
            const char* a3 = a2 + kstep; const char* b3 = b2 + kstep;
            if (last && has_next) S.a_ready(nxt);
            PG8_LDB(B0, 0, 0); PG8_SCHED; PG8_LDA(At, 0, 0); PG8_STAGE(PG8_SA(1, 1), a1 + hstep, voffA);
            PG8_WAIT_L(8); PG8_BAR; PG8_WAIT_L(0); PG8_MMA(0, 0, At, B0); PG8_BAR; PG8_SCHED;
            PG8_LDB(B1, 0, 1); PG8_STAGE(PG8_SB(0, 0), b2, voffB);
            PG8_BAR; PG8_WAIT_L(0); PG8_MMA(0, 1, At, B1); PG8_BAR;
            PG8_LDA(At, 0, 1); PG8_STAGE(PG8_SA(0, 0), a2, voffA);
            PG8_BAR; PG8_WAIT_L(0); PG8_MMA(1, 0, At, B0); PG8_BAR; PG8_SCHED;
            PG8_STAGE(PG8_SB(0, 1), b2 + hstep, voffB);
            PG8_WAIT_V(6); PG8_BAR; PG8_MMA(1, 1, At, B1); PG8_BAR;
            PG8_LDB(B0, 1, 0); PG8_SCHED; PG8_LDA(At, 1, 0); PG8_STAGE(PG8_SA(0, 1), a2 + hstep, voffA);
            PG8_WAIT_L(8); PG8_BAR; PG8_WAIT_L(0); PG8_MMA(0, 0, At, B0); PG8_BAR; PG8_SCHED;
            PG8_LDB(B1, 1, 1); PG8_STAGE(PG8_SB(1, 0), b3, voffB);
            PG8_BAR; PG8_WAIT_L(0); PG8_MMA(0, 1, At, B1); PG8_BAR;
            PG8_LDA(At, 1, 1); PG8_STAGE(PG8_SA(1, 0), a3, voffA);
            PG8_BAR; PG8_WAIT_L(0); PG8_MMA(1, 0, At, B0); PG8_BAR; PG8_SCHED;
            PG8_STAGE(PG8_SB(1, 1), b3 + hstep, voffB);
            PG8_WAIT_V(6); PG8_BAR; PG8_MMA(1, 1, At, B1); PG8_BAR;
        }
        PG8_STAMP();
        if constexpr (!Epi::AFTER_DRAIN) { E(acc, cur, wr, wc, fr, fq); S.done(cur); }
        PG8_STAMP();
        if (!has_next) break;
#pragma unroll
        for (int a = 0; a < 2; ++a)
#pragma unroll
            for (int b = 0; b < 2; ++b)
#pragma unroll
                for (int m = 0; m < 4; ++m)
#pragma unroll
                    for (int n = 0; n < 2; ++n) acc[a][b][m][n] = (f32x4){0.f, 0.f, 0.f, 0.f};
        cur = nxt; cA = nA; cB = nB; ++ui;
    }
    PG8_WAIT_V(0);
    if (wr == 0) PG8_BAR;
    PG8_BAR;
    if constexpr (Epi::AFTER_DRAIN) { E.fused(acc, cur, wr, wc, fr, fq, lds, wid, lane); S.done(cur); }
    PG8_STAMP();
    if (STAMP && wid == 0) { stamps[lane] = lane < nts ? (((unsigned long long)(unsigned)ts_hi << 32) | (unsigned)ts_lo) : 0ull;
        if (lane == 62) stamps[62] = rt_entry; if (lane == 63) stamps[63] = (unsigned long long)wall_clock64(); }
#undef PG8_STAMP
#undef PG8_SA
#undef PG8_SB
#undef PG8_STAGE
#undef PG8_LDA
#undef PG8_LDB
#undef PG8_MMA
#undef PG8_WAIT_V
#undef PG8_WAIT_L
#undef PG8_BAR
#undef PG8_SCHED
}
}

namespace att {
using bf16 = unsigned short;
constexpr int   D = 128, NW = 8, QBLK = 32, KVBLK = 64;
constexpr float SCALE = 0.088388347648318440f;
constexpr float THR = 8.f;
constexpr int SDEPTH = 2;
constexpr int LDQ = 6144, LDK = 6144, LDO = 2048;
constexpr size_t SHM_V = KVBLK * D * 2, SHM_K = KVBLK * D * 2, SHM_ATTN = 2 * SHM_V + 2 * SHM_K + NW * 64 * 4;
using bf16x8 = __attribute__((ext_vector_type(8))) short;
using s16x4  = __attribute__((ext_vector_type(4))) short;
using f32x16 = __attribute__((ext_vector_type(16))) float;
using f32x8  = __attribute__((ext_vector_type(8))) float;
using u32x4  = __attribute__((ext_vector_type(4))) unsigned;
#define KSWZ(row, colB) ((row) * 256 + ((colB) ^ (((row) & 7) << 4)))
#define SBAR() __builtin_amdgcn_sched_barrier(0)
__device__ __forceinline__ int crow(int r, int hi) { return (r & 3) + 8 * (r >> 2) + 4 * hi; }
__device__ __forceinline__ unsigned cvtpk(float lo, float hi) {
  unsigned r; asm volatile("v_cvt_pk_bf16_f32 %0, %1, %2" : "=v"(r) : "v"(lo), "v"(hi)); return r;
}
template <typename TIn> struct Stage;
template <> struct Stage<bf16>  { using T = bf16x8;
  __device__ static __forceinline__ T ld8(const bf16* p) { return *reinterpret_cast<const bf16x8*>(p); }
  __device__ static __forceinline__ bf16x8 tobf(T x) { return x; } };
template <> struct Stage<float> { using T = f32x8;
  __device__ static __forceinline__ T ld8(const float* p) { return *reinterpret_cast<const f32x8*>(p); }
  __device__ static __forceinline__ bf16x8 tobf(T x) {
    u32x4 w = {cvtpk(x[0], x[1]), cvtpk(x[2], x[3]), cvtpk(x[4], x[5]), cvtpk(x[6], x[7])}; return *reinterpret_cast<bf16x8*>(&w); } };

__device__ __forceinline__ void partialSM(f32x16& p0, f32x16& p1, float& m_reg, float& mn, float& alpha) {
  constexpr float C = SCALE * 1.4426950408889634f;
  float pmax = p0[0]; for (int r = 1; r < 16; ++r) pmax = fmaxf(pmax, p0[r]); for (int r = 0; r < 16; ++r) pmax = fmaxf(pmax, p1[r]);
  { auto rr = __builtin_amdgcn_permlane32_swap(__float_as_uint(pmax), __float_as_uint(pmax), false, false);
    pmax = fmaxf(__uint_as_float(rr[0]), __uint_as_float(rr[1])); }
  if (__builtin_expect(__all(pmax - m_reg <= THR / SCALE), 1)) { mn = m_reg; alpha = 1.f; }
  else { mn = fmaxf(m_reg, pmax); alpha = __builtin_amdgcn_exp2f((m_reg - mn) * C); m_reg = mn; }
  float mnC = -mn * C;
  for (int r = 0; r < 16; ++r) p0[r] = fmaf(p0[r], C, mnC); for (int r = 0; r < 16; ++r) p1[r] = fmaf(p1[r], C, mnC);
  for (int r = 0; r < 16; ++r) p0[r] = __builtin_amdgcn_exp2f(p0[r]);
}
__device__ __forceinline__ void finishSM(f32x16& p0, f32x16& p1, float alpha, float& l_reg, bf16x8& pa0, bf16x8& pa1, bf16x8& pa2, bf16x8& pa3) {
  for (int r = 0; r < 16; ++r) p1[r] = __builtin_amdgcn_exp2f(p1[r]);
  float ps = 0; for (int r = 0; r < 16; ++r) ps += p0[r]; for (int r = 0; r < 16; ++r) ps += p1[r];
  { auto rr = __builtin_amdgcn_permlane32_swap(__float_as_uint(ps), __float_as_uint(ps), false, false);
    ps = __uint_as_float(rr[0]) + __uint_as_float(rr[1]); }
  l_reg = l_reg * alpha + ps;
#define PK4(P, BASE, OUT) do { unsigned a0 = cvtpk(P[BASE + 0], P[BASE + 1]), a1 = cvtpk(P[BASE + 2], P[BASE + 3]);   \
    unsigned b0 = cvtpk(P[BASE + 4], P[BASE + 5]), b1 = cvtpk(P[BASE + 6], P[BASE + 7]);                              \
    auto r0 = __builtin_amdgcn_permlane32_swap(a0, b0, false, false); auto r1 = __builtin_amdgcn_permlane32_swap(a1, b1, false, false); \
    u32x4 w = {r0[0], r1[0], r0[1], r1[1]}; OUT = *reinterpret_cast<bf16x8*>(&w); } while (0)
  PK4(p0, 0, pa0); PK4(p0, 8, pa1); PK4(p1, 0, pa2); PK4(p1, 8, pa3);
#undef PK4
}
__device__ __forceinline__ void qkt(f32x16& p0, f32x16& p1, const bf16* Ks, const bf16x8* qr, int r32, int hi) {
  p0 = f32x16{}; p1 = f32x16{};
  for (int d0 = 0; d0 < 8; ++d0) { int cb = (d0 * 16 + hi * 8) * 2;
    bf16x8 b0 = *reinterpret_cast<const bf16x8*>((const char*)Ks + KSWZ(r32, cb));
    bf16x8 b1 = *reinterpret_cast<const bf16x8*>((const char*)Ks + KSWZ(32 + r32, cb));
    p0 = __builtin_amdgcn_mfma_f32_32x32x16_bf16(b0, qr[d0], p0, 0, 0, 0);
    p1 = __builtin_amdgcn_mfma_f32_32x32x16_bf16(b1, qr[d0], p1, 0, 0, 0); }
}
__device__ __forceinline__ int v_st(int k, int c) { const int kk = (k & ~0xC) | ((k & 4) << 1) | ((k & 8) >> 1); return ((kk >> 3) * 4 + (c >> 5)) * 512 + ((kk & 7) * 32 + (c & 31)) * 2; }
__device__ __forceinline__ int v_rd_base(int lane) { return ((lane & 3) << 3) | (((lane >> 2) & 3) << 6) | (((lane >> 4) & 1) << 5) | (((lane >> 5) & 1) << 8); }
constexpr int v_rd_off(int d0, int ks, int half) { return d0 * 512 + ks * 4096 + half * 2048; }
template <int OFF> __device__ __forceinline__ s16x4 tr_read(int vb) {
  s16x4 r; asm volatile("ds_read_b64_tr_b16 %0, %1 offset:%2" : "=&v"(r) : "v"(vb), "i"(OFF) : "memory"); return r;
}
template <int D0> __device__ __forceinline__ void pv_one(f32x16& od, int vb, bf16x8 pa0, bf16x8 pa1, bf16x8 pa2, bf16x8 pa3) {
  const s16x4 l0 = tr_read<v_rd_off(D0, 0, 0)>(vb), h0 = tr_read<v_rd_off(D0, 0, 1)>(vb), l1 = tr_read<v_rd_off(D0, 1, 0)>(vb), h1 = tr_read<v_rd_off(D0, 1, 1)>(vb);
  const s16x4 l2 = tr_read<v_rd_off(D0, 2, 0)>(vb), h2 = tr_read<v_rd_off(D0, 2, 1)>(vb), l3 = tr_read<v_rd_off(D0, 3, 0)>(vb), h3 = tr_read<v_rd_off(D0, 3, 1)>(vb);
  asm volatile("s_waitcnt lgkmcnt(0)" ::: "memory"); SBAR();
#define PK(L, H) (bf16x8){L[0], L[1], L[2], L[3], H[0], H[1], H[2], H[3]}
  od = __builtin_amdgcn_mfma_f32_32x32x16_bf16(pa0, PK(l0, h0), od, 0, 0, 0);
  od = __builtin_amdgcn_mfma_f32_32x32x16_bf16(pa1, PK(l1, h1), od, 0, 0, 0);
  od = __builtin_amdgcn_mfma_f32_32x32x16_bf16(pa2, PK(l2, h2), od, 0, 0, 0);
  od = __builtin_amdgcn_mfma_f32_32x32x16_bf16(pa3, PK(l3, h3), od, 0, 0, 0);
#undef PK
}
__device__ __forceinline__ void pv_d0(f32x16* o, int vb, bf16x8 pa0, bf16x8 pa1, bf16x8 pa2, bf16x8 pa3) {
  pv_one<0>(o[0], vb, pa0, pa1, pa2, pa3); pv_one<1>(o[1], vb, pa0, pa1, pa2, pa3); pv_one<2>(o[2], vb, pa0, pa1, pa2, pa3); pv_one<3>(o[3], vb, pa0, pa1, pa2, pa3);
}

template <typename TQ>
__device__ __forceinline__ void attn_dense_body(const TQ* __restrict__ Qb, const bf16* __restrict__ Kh, const bf16* __restrict__ Vh,
                                                float* __restrict__ Ob, int seq, char* lds, int mode, float lam, unsigned short* o1buf) {
  using St = Stage<bf16>; using SQ = Stage<TQ>;
  const int tid = tidx(), wid = tid >> 6, lane = tid & 63, r32 = lane & 31, hi = lane >> 5;
  bf16* V_lds = (bf16*)lds; bf16* K_lds = (bf16*)(lds + 2 * SHM_V);
  float* ws = (float*)(lds + 2 * SHM_V + 2 * SHM_K) + wid * 64; float* li_l = ws; float* al_l = ws + 32;
  float m_reg = -1e30f, l_reg = 0; f32x16 o[4] = {}; bf16x8 qr[8];
  const TQ* Qw = Qb + (long)(wid * QBLK + r32) * LDQ + hi * 8;
#pragma unroll
  for (int d0 = 0; d0 < 8; ++d0) qr[d0] = SQ::tobf(SQ::ld8(Qw + d0 * 16));
  const int sr = tid >> 4, sc = (tid & 15) * 8, vst0 = v_st(sr, sc), vst1 = v_st(32 + sr, sc);
  const int vb0 = (int)(uintptr_t)V_lds + v_rd_base(lane);
  struct { typename St::T vs0, vs1, ks0, ks1; } sr_[SDEPTH];
#define SLOAD(i, k0) do { sr_[i].vs0 = St::ld8(&Vh[(long)((k0) + sr) * LDK + sc]); sr_[i].vs1 = St::ld8(&Vh[(long)((k0) + 32 + sr) * LDK + sc]); \
    sr_[i].ks0 = St::ld8(&Kh[(long)((k0) + sr) * LDK + sc]); sr_[i].ks1 = St::ld8(&Kh[(long)((k0) + 32 + sr) * LDK + sc]); } while (0)
#define SWRITE(b, i) do { *(bf16x8*)((char*)V_lds + (b) * SHM_V + vst0) = St::tobf(sr_[i].vs0);          \
    *(bf16x8*)((char*)V_lds + (b) * SHM_V + vst1) = St::tobf(sr_[i].vs1); int kc = sc * 2;               \
    *(bf16x8*)((char*)K_lds + (b) * SHM_K + KSWZ(sr, kc)) = St::tobf(sr_[i].ks0);                       \
    *(bf16x8*)((char*)K_lds + (b) * SHM_K + KSWZ(32 + sr, kc)) = St::tobf(sr_[i].ks1); } while (0)
#define SWAIT() do { if constexpr (SDEPTH == 2) asm volatile("s_waitcnt vmcnt(4)" ::: "memory"); else asm volatile("s_waitcnt vmcnt(0)" ::: "memory"); } while (0)
#define RESC(a) do { if (__any((a) < 1.f)) { if (hi == 0) al_l[r32] = (a); asm volatile("s_waitcnt lgkmcnt(0)" ::: "memory"); \
    for (int d = 0; d < 4; ++d) for (int r = 0; r < 16; ++r) o[d][r] *= al_l[crow(r, hi)]; } } while (0)
  f32x16 pA0, pA1, pB0, pB1; float mnA, mnB, alA, alB; bf16x8 pa0, pa1, pa2, pa3; const int NT = seq / KVBLK;
  constexpr int SE = 0, SO = SDEPTH - 1;
  SLOAD(SE, 0); asm volatile("s_waitcnt vmcnt(0)" ::: "memory"); SWRITE(0, SE); __syncthreads();
  qkt(pA0, pA1, K_lds, qr, r32, hi); partialSM(pA0, pA1, m_reg, mnA, alA);
  SLOAD(SO, KVBLK); if constexpr (SDEPTH == 2) { if (2 < NT) SLOAD(SE, 2 * KVBLK); }
  SWAIT(); SWRITE(1, SO); __syncthreads();
  for (int j = 1; j + 1 < NT; j += 2) {
    SBAR(); qkt(pB0, pB1, (bf16*)((char*)K_lds + SHM_K), qr, r32, hi);
    finishSM(pA0, pA1, alA, l_reg, pa0, pa1, pa2, pa3); SBAR();
    SLOAD(SO, (j + SDEPTH) * KVBLK); SBAR();
    pv_d0(o, vb0, pa0, pa1, pa2, pa3); partialSM(pB0, pB1, m_reg, mnB, alB);
    __syncthreads(); SWAIT(); SWRITE(0, SE);
    RESC(alB); __syncthreads();
    SBAR(); qkt(pA0, pA1, K_lds, qr, r32, hi);
    finishSM(pB0, pB1, alB, l_reg, pa0, pa1, pa2, pa3); SBAR();
    if (SDEPTH == 1 || j + 3 < NT) SLOAD(SE, (j + 1 + SDEPTH) * KVBLK); SBAR();
    pv_d0(o, vb0 + (int)SHM_V, pa0, pa1, pa2, pa3); partialSM(pA0, pA1, m_reg, mnA, alA);
    __syncthreads(); SWAIT(); SWRITE(1, SO);
    RESC(alA); __syncthreads();
  }
  SBAR(); qkt(pB0, pB1, (bf16*)((char*)K_lds + SHM_K), qr, r32, hi);
  finishSM(pA0, pA1, alA, l_reg, pa0, pa1, pa2, pa3); SBAR();
  pv_d0(o, vb0, pa0, pa1, pa2, pa3); partialSM(pB0, pB1, m_reg, mnB, alB);
  __syncthreads(); RESC(alB);
  finishSM(pB0, pB1, alB, l_reg, pa0, pa1, pa2, pa3); SBAR();
  pv_d0(o, vb0 + (int)SHM_V, pa0, pa1, pa2, pa3);
  if (hi == 0) li_l[r32] = l_reg; asm volatile("s_waitcnt lgkmcnt(0)" ::: "memory");
  float rli[16];
#pragma unroll
  for (int r = 0; r < 16; ++r) rli[r] = __builtin_amdgcn_rcpf(li_l[crow(r, hi)]);
  float* Ow = Ob + (long)(wid * QBLK) * LDO;
#pragma unroll
  for (int r = 0; r < 16; ++r) { int orow = crow(r, hi);
    for (int d0 = 0; d0 < 4; ++d0) { const float val = o[d0][r] * rli[r]; unsigned short* lp = o1buf + (wid * QBLK + orow) * 128 + d0 * 32 + r32;
      if (mode == 0) { *lp = (unsigned short)(cvtpk(val, val) & 0xffffu); } else { Ow[(long)orow * LDO + d0 * 32 + r32] = __uint_as_float(((unsigned)*lp) << 16) - lam * val; } } }
#undef SLOAD
#undef SWRITE
#undef SWAIT
#undef RESC
}

#undef KSWZ
#undef SBAR
}
#ifndef MK_NO_HELPER
#define MK_NO_HELPER 0
#endif
namespace mk {
using pg8::bf16_t; using pg8::f32x4; using pg8::u32x4; using pg8::cvt_pk_bf16; using pg8::Unit;
typedef unsigned u32x2 __attribute__((ext_vector_type(2)));
typedef float f32x2 __attribute__((ext_vector_type(2)));
constexpr int T = 16384, DM = 2048, FF = 5632, SEQ = 4096;
constexpr int NIN_REAL = 6176, NIN = 6400, NQKV = 6144;
constexpr int LDS_BYTES = 155648;
constexpr float EPS = 1e-6f;
constexpr float LAMBDA_INIT = 0.35550906759096924f;
#ifdef MK_DUP_PH
constexpr int NPHASE = 20;
#else
constexpr int NPHASE = 19;
#endif

constexpr size_t SZ_SMALL = (size_t)T * 32 * 4;
constexpr size_t SZ_GU = (size_t)2 * FF * DM * 2, SZ_D = (size_t)DM * FF * 2;
constexpr size_t WS_ROPE = 0, WS_BA = WS_ROPE + SZ_SMALL, WS_BG = WS_BA + SZ_SMALL;
constexpr size_t WS_SS = WS_BG + SZ_SMALL;
constexpr size_t WS_WGU = WS_SS + (size_t)1024 * 1024, WS_WD = WS_WGU + 4 * SZ_GU;
typedef unsigned long long u64;
constexpr size_t WS_BAR = WS_SS + (size_t)960 * 1024;
constexpr float SSQ = 1048576.f, SSQ_INV = 1.f / 1048576.f;
constexpr size_t WS_WIN = WS_WD + 4 * SZ_D, WS_WOUT = WS_WIN + (size_t)NIN * DM * 2;
constexpr size_t WS_WQKV = WS_WOUT + (size_t)DM * DM * 2, WS_WO = WS_WQKV + (size_t)NQKV * DM * 2;
constexpr size_t WS_XN = WS_WO + (size_t)DM * DM * 2;
constexpr size_t WS_H = WS_XN + (size_t)T * DM * 2;
constexpr size_t WS_S = WS_H + (size_t)T * NIN * 2;
constexpr size_t SZ_T1K = (size_t)T * 1024 * 2;
constexpr size_t WS_END = WS_S + 5 * SZ_T1K;

struct Args { const float* in[29]; float* out; unsigned char* ws; int ph_lo, ph_hi; };
typedef const __attribute__((address_space(4))) Args* AP;

__device__ __forceinline__ float bflo(unsigned w) { return __uint_as_float(w << 16); }
__device__ __forceinline__ float bfhi(unsigned w) { return __uint_as_float(w & 0xffff0000u); }
__device__ __forceinline__ float sigm(float x) { return __builtin_amdgcn_rcpf(1.f + __expf(-x)); }
__device__ __forceinline__ float silu(float x) { return x * sigm(x); }
__device__ __forceinline__ float wave_sum(float v) {
#pragma unroll
  for (int m = 32; m >= 1; m >>= 1) v += __shfl_xor(v, m, 64);
  return v;
}

template <int CTRL> __device__ __forceinline__ float dpp_mov(float v) { return __int_as_float(__builtin_amdgcn_update_dpp(0, __float_as_int(v), CTRL, 0xF, 0xF, true)); }
__device__ __forceinline__ float row_sum8(float v) { v += dpp_mov<0xB1>(v); v += dpp_mov<0x4E>(v); v += dpp_mov<0x141>(v); return v; }
__device__ __forceinline__ float row_sum16(float v) { v += dpp_mov<0xB1>(v); v += dpp_mov<0x4E>(v); v += dpp_mov<0x141>(v); v += dpp_mov<0x140>(v); return v; }
__device__ __forceinline__ float dpp_row_bcast_sum4(float v) { float t = v + __shfl_xor(v, 16, 64); return t + __shfl_xor(t, 32, 64) - v; }
#define EPI_PIN() __builtin_amdgcn_sched_barrier(0)
struct EpiSwiglu { static constexpr bool PERM = true, AFTER_DRAIN = false; bf16_t* H; const u64* ss; int dup;
  __device__ __forceinline__ void operator()(const f32x4 (&acc)[2][2][4][2], const Unit& u, int wr, int wc, int fr, int fq) const {
    const int row0 = u.pm * 256 + wr * 64 + fr, col0 = u.pn * 128 + wc * 32 + 8 * fq;
    float rsv[2][4];
#pragma unroll
    for (int ai = 0; ai < 2; ++ai)
#pragma unroll
      for (int m = 0; m < 4; ++m) rsv[ai][m] = (float)ss[row0 + ai * 128 + m * 16] * SSQ_INV;
    EPI_PIN();
#pragma unroll
    for (int ai = 0; ai < 2; ++ai)
#pragma unroll
      for (int m = 0; m < 4; ++m) {
        const float rs = rsqrtf(rsv[ai][m] * (1.f / DM) + EPS);
        const f32x4 g0 = acc[ai][0][m][0] * rs, g1 = acc[ai][0][m][1] * rs, u0 = acc[ai][1][m][0] * rs, u1 = acc[ai][1][m][1] * rs;
        float h[8];
#pragma unroll
        for (int j = 0; j < 4; ++j) { h[j] = silu(g0[j]) * u0[j]; h[4 + j] = silu(g1[j]) * u1[j]; }
        u32x4 w; w[0] = cvt_pk_bf16(h[0], h[1]); w[1] = cvt_pk_bf16(h[2], h[3]); w[2] = cvt_pk_bf16(h[4], h[5]); w[3] = cvt_pk_bf16(h[6], h[7]);
#if MK_PROBE_NOSTORE
        if (!dup || w[0] == 0x12345678u)
#endif
        __builtin_nontemporal_store(w, (u32x4*)(H + (size_t)(row0 + ai * 128 + m * 16) * FF + col0));
      }
  }
};
struct EpiResid { static constexpr bool PERM = false, AFTER_DRAIN = false; AP a; int ph; int dup;
  __device__ __forceinline__ void operator()(const f32x4 (&acc)[2][2][4][2], const Unit& u, int wr, int wc, int fr, int fq) const {
    bf16_t* xb = (bf16_t*)(a->ws + WS_XN); const float* xin = a->in[0];
    const float scale = (ph == 7 || ph == 15) ? 1.f : 0.5f;
    const int nss = (ph == 2) ? 0 : (ph == 7) ? 1 : (ph == 9) ? 2 : (ph == 11) ? 3 : (ph == 15) ? 4 : 6;
    u64* ss = (u64*)(a->ws + WS_SS) + (size_t)nss * T;
    const int row0 = u.pm * 256 + wr * 64 + fr, col0 = u.pn * 256 + wc * 32 + 4 * fq;
#pragma unroll
    for (int ai = 0; ai < 2; ++ai) {
    u32x2 rb[4][2][2];
    if (ph != 2) {
#pragma unroll
      for (int m = 0; m < 4; ++m)
#pragma unroll
        for (int bj = 0; bj < 2; ++bj)
#pragma unroll
          for (int n = 0; n < 2; ++n) rb[m][bj][n] = *(const u32x2*)(xb + (size_t)(row0 + ai * 128 + m * 16) * DM + col0 + bj * 128 + n * 16);
    }
    EPI_PIN();
#pragma unroll
    for (int mh = 0; mh < 2; ++mh) {
      f32x4 r[2][2][2];
      if (ph == 2) {
#pragma unroll
        for (int m2 = 0; m2 < 2; ++m2)
#pragma unroll
          for (int bj = 0; bj < 2; ++bj)
#pragma unroll
            for (int n = 0; n < 2; ++n) r[m2][bj][n] = *(const f32x4*)(xin + (size_t)(row0 + ai * 128 + (mh * 2 + m2) * 16) * DM + col0 + bj * 128 + n * 16);
      } else {
#pragma unroll
        for (int m2 = 0; m2 < 2; ++m2)
#pragma unroll
          for (int bj = 0; bj < 2; ++bj)
#pragma unroll
            for (int n = 0; n < 2; ++n) { const u32x2 q = rb[mh * 2 + m2][bj][n]; r[m2][bj][n] = (f32x4){bflo(q[0]), bfhi(q[0]), bflo(q[1]), bfhi(q[1])}; }
      }
      EPI_PIN();
#pragma unroll
      for (int m2 = 0; m2 < 2; ++m2) {
        const int m = mh * 2 + m2;
        const size_t off = (size_t)(row0 + ai * 128 + m * 16) * DM + col0; float sq = 0.f;
#pragma unroll
        for (int bj = 0; bj < 2; ++bj)
#pragma unroll
          for (int n = 0; n < 2; ++n) { const f32x4 rr = r[m2][bj][n] + acc[ai][bj][m][n] * scale;
            u32x2 w; w[0] = cvt_pk_bf16(rr[0], rr[1]); w[1] = cvt_pk_bf16(rr[2], rr[3]); *(u32x2*)(xb + off + bj * 128 + n * 16) = w;
            const float y0 = bflo(w[0]), y1 = bfhi(w[0]), y2 = bflo(w[1]), y3 = bfhi(w[1]); sq += y0 * y0 + y1 * y1 + y2 * y2 + y3 * y3; }
        sq += dpp_row_bcast_sum4(sq); if (fq == 0) atomicAdd(ss + row0 + ai * 128 + m * 16, (u64)(sq * SSQ + 0.5f));
      }
      EPI_PIN();
    }
    }
  }
};
struct EpiP { static constexpr bool PERM = true, AFTER_DRAIN = false; bf16_t* P; float* BA; const u64* ss;
  __device__ __forceinline__ void operator()(const f32x4 (&acc)[2][2][4][2], const Unit& u, int wr, int wc, int fr, int fq) const {
    const int row0 = u.pm * 256 + wr * 64 + fr, col0 = u.pn * 256 + wc * 32 + 8 * fq;
    float rsv[2][4];
#pragma unroll
    for (int ai = 0; ai < 2; ++ai)
#pragma unroll
      for (int m = 0; m < 4; ++m) rsv[ai][m] = (float)ss[row0 + ai * 128 + m * 16] * SSQ_INV;
    EPI_PIN();
#pragma unroll
    for (int ai = 0; ai < 2; ++ai)
#pragma unroll
      for (int m = 0; m < 4; ++m) {
        const int row = row0 + ai * 128 + m * 16;
        const float rs = rsqrtf(rsv[ai][m] * (1.f / DM) + EPS);
#pragma unroll
        for (int bj = 0; bj < 2; ++bj) {
          const f32x4 a0 = acc[ai][bj][m][0] * rs, a1 = acc[ai][bj][m][1] * rs;
          u32x4 w; w[0] = cvt_pk_bf16(a0[0], a0[1]); w[1] = cvt_pk_bf16(a0[2], a0[3]); w[2] = cvt_pk_bf16(a1[0], a1[1]); w[3] = cvt_pk_bf16(a1[2], a1[3]);
          *(u32x4*)(P + (size_t)row * NIN + col0 + bj * 128) = w;
        }
        if (u.pn == 24 && wc == 0) { *(f32x4*)(BA + (size_t)row * 32 + 8 * fq) = acc[ai][0][m][0] * rs; *(f32x4*)(BA + (size_t)row * 32 + 8 * fq + 4) = acc[ai][0][m][1] * rs; }
      }
  }
};
struct EpiQKV { static constexpr bool PERM = false, AFTER_DRAIN = false; bf16_t* O; const float* rope; const u64* ss;
  __device__ __forceinline__ void operator()(const f32x4 (&acc)[2][2][4][2], const Unit& u, int wr, int wc, int fr, int fq) const {
    const int row0 = u.pm * 256 + wr * 64 + fr, col0 = u.pn * 256 + wc * 32 + 4 * fq;
    const bool rot = (wc == 0) && (u.pn < 16);
    float rsv[2][4];
#pragma unroll
    for (int ai = 0; ai < 2; ++ai)
#pragma unroll
      for (int m = 0; m < 4; ++m) rsv[ai][m] = (float)ss[row0 + ai * 128 + m * 16] * SSQ_INV;
#pragma unroll
    for (int ai = 0; ai < 2; ++ai) {
      f32x4 cv[4], sv[4];
#pragma unroll
      for (int m = 0; m < 4; ++m) { const size_t ro = (size_t)(row0 + ai * 128 + m * 16) * 32 + 4 * fq;
        cv[m] = rot ? *(const f32x4*)(rope + ro) : (f32x4){1.f, 1.f, 1.f, 1.f}; sv[m] = rot ? *(const f32x4*)(rope + ro + 16) : (f32x4){0.f, 0.f, 0.f, 0.f}; }
      EPI_PIN();
#pragma unroll
      for (int m = 0; m < 4; ++m) {
        const int row = row0 + ai * 128 + m * 16;
        const float rs = rsqrtf(rsv[ai][m] * (1.f / DM) + EPS);
#pragma unroll
        for (int bj = 0; bj < 2; ++bj) {
          f32x4 v0 = acc[ai][bj][m][0] * rs, v1 = acc[ai][bj][m][1] * rs;
          const f32x4 n0 = v0 * cv[m] - v1 * sv[m], n1 = v1 * cv[m] + v0 * sv[m];
          u32x2 w0, w1; w0[0] = cvt_pk_bf16(n0[0], n0[1]); w0[1] = cvt_pk_bf16(n0[2], n0[3]); w1[0] = cvt_pk_bf16(n1[0], n1[1]); w1[1] = cvt_pk_bf16(n1[2], n1[3]);
          bf16_t* p = O + (size_t)row * NQKV + col0 + bj * 128;
          *(u32x2*)p = w0; *(u32x2*)(p + 16) = w1;
        }
      }
      EPI_PIN();
    }
  }
};

__device__ __forceinline__ void xpose_mat(const float* __restrict__ W, int K, int N, bf16_t* __restrict__ Wt, int mode, float* tile, const float* __restrict__ gk = nullptr) {
  (void)tile;
  const int lane = tidx() & 63, wid = tidx() >> 6;
  const int nkt = K / 64, ntiles = nkt * (N / 32);
  for (int t = blockIdx.x * 8 + wid; t < ntiles; t += gridDim.x * 8) {
    const int nt = t / nkt, kt = t - nt * nkt, n = nt * 32 + (lane & 31), kb = kt * 64 + (lane >> 5) * 32;
    const float* src = W + (size_t)kb * N + n;
    float v[32];
#pragma unroll
    for (int i = 0; i < 32; ++i) v[i] = src[(size_t)i * N];
    int nd = n; if (mode == 1) nd = (n >> 7) * 256 + (n & 127); else if (mode == 2) nd = (n >> 7) * 256 + 128 + (n & 127);
#pragma unroll
    for (int q = 0; q < 4; ++q) {
      f32x4 g0 = {1.f, 1.f, 1.f, 1.f}, g1 = g0;
      if (gk) { g0 = *(const f32x4*)(gk + kb + 8 * q); g1 = *(const f32x4*)(gk + kb + 8 * q + 4); }
      u32x4 w; w[0] = cvt_pk_bf16(v[8 * q] * g0[0], v[8 * q + 1] * g0[1]); w[1] = cvt_pk_bf16(v[8 * q + 2] * g0[2], v[8 * q + 3] * g0[3]);
      w[2] = cvt_pk_bf16(v[8 * q + 4] * g1[0], v[8 * q + 5] * g1[1]); w[3] = cvt_pk_bf16(v[8 * q + 6] * g1[2], v[8 * q + 7] * g1[3]);
      *(u32x4*)(Wt + (size_t)nd * K + kb + 8 * q) = w;
    }
  }
}

constexpr int HT_FFN = (DM / 64) * (FF / 32);
constexpr int HT_SQ = (DM / 64) * (DM / 32), HT_QKV = (DM / 64) * (NQKV / 32);
#if MK_NO_HELPER
constexpr int HT_TOTAL = 0;
#else
constexpr int HT_TOTAL = 9 * HT_FFN + 2 * HT_SQ + HT_QKV;
#endif
struct HTile { const float* W; bf16_t* Wt; int gi; int K, N, mode, k0, n0; };
__device__ __forceinline__ HTile helper_decode(AP a, int id) {
  HTile t; t.mode = 0; t.gi = -1; int lt; unsigned char* ws = a->ws;
  if (id < 9 * HT_FFN) {
    const int mi = id / HT_FFN; lt = id - mi * HT_FFN; const int f = 1 + mi / 3, which = mi - (mi / 3) * 3, layer = f >> 1, second = f & 1;
    if (which == 2) { t.W = a->in[second ? 10 : 5] + (size_t)layer * DM * FF; t.K = FF; t.N = DM; t.Wt = (bf16_t*)(ws + WS_WD + (size_t)f * SZ_D); }
    else { t.W = a->in[which ? (second ? 9 : 4) : (second ? 8 : 3)] + (size_t)layer * DM * FF; t.K = DM; t.N = FF; t.Wt = (bf16_t*)(ws + WS_WGU + (size_t)f * SZ_GU); t.mode = 1 + which; t.gi = f - 1; }
  } else if (id < 9 * HT_FFN + HT_SQ) { lt = id - 9 * HT_FFN; t.W = a->in[20]; t.K = DM; t.N = DM; t.Wt = (bf16_t*)(ws + WS_WOUT); }
  else if (id < 9 * HT_FFN + HT_SQ + HT_QKV) { lt = id - 9 * HT_FFN - HT_SQ; t.W = a->in[21]; t.K = DM; t.N = NQKV; t.Wt = (bf16_t*)(ws + WS_WQKV); t.gi = 3; }
  else { lt = id - 9 * HT_FFN - HT_SQ - HT_QKV; t.W = a->in[27]; t.K = DM; t.N = DM; t.Wt = (bf16_t*)(ws + WS_WO); }
  const int nkt = t.K / 64, nt = lt / nkt, kt = lt - nt * nkt; t.k0 = kt * 64; t.n0 = nt * 32;
  return t;
}
__device__ __forceinline__ void helper_issue(AP a, int id, float (&v)[32], int lane) {
  const HTile t = helper_decode(a, id);
  const float* src = t.W + (size_t)(t.k0 + (lane >> 5) * 32) * t.N + t.n0 + (lane & 31);
#pragma unroll
  for (int i = 0; i < 32; ++i) v[i] = src[(size_t)i * t.N];
}
__device__ __forceinline__ void helper_finish(AP a, int id, const float (&v)[32], float* wtile, const float* gains, int lane) {
  const HTile t = helper_decode(a, id); (void)wtile;
  const int n = t.n0 + (lane & 31), kb = t.k0 + (lane >> 5) * 32;
  int nd = n; if (t.mode == 1) nd = (n >> 7) * 256 + (n & 127); else if (t.mode == 2) nd = (n >> 7) * 256 + 128 + (n & 127);
#pragma unroll
  for (int q = 0; q < 4; ++q) {
    f32x4 g0 = {1.f, 1.f, 1.f, 1.f}, g1 = g0;
    if (t.gi >= 0) { const float* gp = gains + t.gi * DM + kb + 8 * q; g0 = *(const f32x4*)gp; g1 = *(const f32x4*)(gp + 4); }
    u32x4 w; w[0] = cvt_pk_bf16(v[8 * q] * g0[0], v[8 * q + 1] * g0[1]); w[1] = cvt_pk_bf16(v[8 * q + 2] * g0[2], v[8 * q + 3] * g0[3]);
    w[2] = cvt_pk_bf16(v[8 * q + 4] * g1[0], v[8 * q + 5] * g1[1]); w[3] = cvt_pk_bf16(v[8 * q + 6] * g1[2], v[8 * q + 7] * g1[3]);
    *(u32x4*)(t.Wt + (size_t)nd * t.K + kb + 8 * q) = w;
  }
}

__device__ __forceinline__ void cast_phase(const float* __restrict__ X, bf16_t* __restrict__ XB, u64* __restrict__ ss) {
  const int lane = tidx() & 63, wid = tidx() >> 6;
  for (int row = blockIdx.x * 8 + wid; row < T; row += gridDim.x * 8) {
    const float* xr = X + (size_t)row * DM;
    f32x4 v[8]; float sq = 0.f;
#pragma unroll
    for (int i = 0; i < 8; ++i) v[i] = *(const f32x4*)(xr + (i * 64 + lane) * 4);
#pragma unroll
    for (int i = 0; i < 8; ++i) { u32x2 w; w[0] = cvt_pk_bf16(v[i][0], v[i][1]); w[1] = cvt_pk_bf16(v[i][2], v[i][3]); *(u32x2*)(XB + (size_t)row * DM + (i * 64 + lane) * 4) = w;
      const float y0 = bflo(w[0]), y1 = bfhi(w[0]), y2 = bflo(w[1]), y3 = bfhi(w[1]); sq += y0 * y0 + y1 * y1 + y2 * y2 + y3 * y3; }
    sq = wave_sum(sq);
    if (lane == 0) ss[row] = (u64)(sq * SSQ + 0.5f);
  }
}
__device__ __forceinline__ void final_phase(const bf16_t* __restrict__ XB, const u64* __restrict__ ss, const float* __restrict__ g, float* __restrict__ out) {
  const int lane = tidx() & 63, wid = tidx() >> 6;
  for (int row = blockIdx.x * 8 + wid; row < T; row += gridDim.x * 8) {
    const float rstd = rsqrtf((float)ss[row] * SSQ_INV * (1.f / DM) + EPS);
    u32x4 xv[4];
#pragma unroll
    for (int i = 0; i < 4; ++i) xv[i] = *(const u32x4*)(XB + (size_t)row * DM + (i * 64 + lane) * 8);
#pragma unroll
    for (int i = 0; i < 4; ++i) { const int c = (i * 64 + lane) * 8; const f32x4 g0 = *(const f32x4*)(g + c), g1 = *(const f32x4*)(g + c + 4);
      const f32x4 y0 = (f32x4){bflo(xv[i][0]), bfhi(xv[i][0]), bflo(xv[i][1]), bfhi(xv[i][1])} * rstd * g0, y1 = (f32x4){bflo(xv[i][2]), bfhi(xv[i][2]), bflo(xv[i][3]), bfhi(xv[i][3])} * rstd * g1;
      *(f32x4*)(out + (size_t)row * DM + c) = y0; *(f32x4*)(out + (size_t)row * DM + c + 4) = y1; }
  }
}

__device__ __forceinline__ void prologue(AP a, unsigned char* lds) {
  unsigned char* ws = a->ws;
  float* tile = (float*)lds;
  for (int f = 0; f < (MK_NO_HELPER ? 4 : 1); ++f) {
    const int layer = f >> 1, which = f & 1;
    const float* wg = a->in[which ? 8 : 3] + (size_t)layer * DM * FF; const float* wu = a->in[which ? 9 : 4] + (size_t)layer * DM * FF; const float* wd = a->in[which ? 10 : 5] + (size_t)layer * DM * FF;
    const float* gn = a->in[which ? 7 : 2] + (size_t)layer * DM;
    xpose_mat(wg, DM, FF, (bf16_t*)(ws + WS_WGU + f * SZ_GU), 1, tile, gn);
    xpose_mat(wu, DM, FF, (bf16_t*)(ws + WS_WGU + f * SZ_GU), 2, tile, gn);
    xpose_mat(wd, FF, DM, (bf16_t*)(ws + WS_WD + f * SZ_D), 0, tile);
  }
  xpose_mat(a->in[11], DM, NIN_REAL, (bf16_t*)(ws + WS_WIN), 0, tile, a->in[6]);
#if MK_NO_HELPER
  xpose_mat(a->in[20], DM, DM, (bf16_t*)(ws + WS_WOUT), 0, tile);
  xpose_mat(a->in[21], DM, NQKV, (bf16_t*)(ws + WS_WQKV), 0, tile, a->in[6] + DM);
  xpose_mat(a->in[27], DM, DM, (bf16_t*)(ws + WS_WO), 0, tile);
#endif
  const size_t gtid = (size_t)blockIdx.x * 512 + tidx(), gn = (size_t)gridDim.x * 512;
  { u32x4* p = (u32x4*)(ws + WS_WIN + (size_t)NIN_REAL * DM * 2); const size_t n16 = (size_t)(NIN - NIN_REAL) * DM * 2 / 16; unsigned zz = 0u; asm volatile("" : "+v"(zz)); const u32x4 z = {zz, zz, zz, zz};
    for (size_t i = gtid; i < n16; i += gn) p[i] = z; }
  { u64* ssz = (u64*)(ws + WS_SS); unsigned zq = 0u; asm volatile("" : "+v"(zq)); const u64 z64 = ((u64)zq << 32) | zq;
    for (size_t i = gtid; i < (size_t)6 * T; i += gn) ssz[i < (size_t)5 * T ? i : i + T] = z64; }
  { float* rope = (float*)(ws + WS_ROPE); const int* pos = (const int*)a->in[1];
    for (size_t i = gtid; i < (size_t)T * 16; i += gn) {
      const int tok = (int)(i >> 4), j = (int)(i & 15);
      const float inv = exp2f(-(float)j * (18.931568569324174f / 16.f));
      double rev = (double)pos[tok] * (double)inv * 0.15915494309189535; rev -= floor(rev);
      const float fr = (float)rev;
      rope[(size_t)tok * 32 + j] = __builtin_amdgcn_cosf(fr); rope[(size_t)tok * 32 + 16 + j] = __builtin_amdgcn_sinf(fr);
    } }
  cast_phase(a->in[0], (bf16_t*)(ws + WS_XN), (u64*)(ws + WS_SS) + (size_t)5 * T);
}

__device__ __forceinline__ void conv_module(AP a, unsigned char* lds) {
  const bf16_t* P = (const bf16_t*)(a->ws + WS_H); bf16_t* CAT = (bf16_t*)(a->ws + WS_S);
  unsigned* glu = (unsigned*)lds; float* part = (float*)(lds + 62 * 512 * 4); float* stats = part + 512;
  const int tid = tidx(), lane = tid & 63, wid = tid >> 6, c0 = 2 * tid;
  const float* cw = a->in[12];
  float w0[31], w1[31];
#pragma unroll
  for (int j = 0; j < 31; ++j) { const f32x2 t = *(const f32x2*)(cw + j * 1024 + c0); w0[j] = t[0]; w1[j] = t[1]; }
  const f32x2 cb = *(const f32x2*)(a->in[13] + c0), lg = *(const f32x2*)(a->in[14] + c0), lb = *(const f32x2*)(a->in[15] + c0);
  for (int tile = blockIdx.x; tile < T / 32; tile += gridDim.x) {
    const int tok0 = tile * 32, s0 = tok0 & (SEQ - 1);
    for (int r0 = 0; r0 < 64; r0 += 8) {
      unsigned pv[8], pg[8];
#pragma unroll
      for (int i = 0; i < 8; ++i) { const int r = r0 + i, s = s0 - 15 + r; const bool ok = (r < 62) && s >= 0 && s < SEQ;
        const bf16_t* pr = P + (size_t)(ok ? tok0 - 15 + r : tok0) * NIN + c0; pv[i] = *(const unsigned*)pr; pg[i] = *(const unsigned*)(pr + 1024); }
#pragma unroll
      for (int i = 0; i < 8; ++i) { const int r = r0 + i, s = s0 - 15 + r; const bool ok = s >= 0 && s < SEQ;
        const unsigned val = ok ? cvt_pk_bf16(bflo(pv[i]) * sigm(bflo(pg[i])), bfhi(pv[i]) * sigm(bfhi(pg[i]))) : 0u;
        if (r < 62) glu[r * 512 + tid] = val; }
    }
#pragma unroll 1
    for (int tt = 0; tt < 32; ++tt) {
      float o0 = cb[0], o1 = cb[1];
#pragma unroll
      for (int j = 0; j < 31; ++j) { const unsigned u = glu[(tt + j) * 512 + tid]; o0 += w0[j] * bflo(u); o1 += w1[j] * bfhi(u); }
      const float s = wave_sum(o0 + o1), q = wave_sum(o0 * o0 + o1 * o1);
      if (lane == 0) { part[(wid * 32 + tt) * 2] = s; part[(wid * 32 + tt) * 2 + 1] = q; }
    }
    __syncthreads();
    if (tid < 32) { float s = 0.f, q = 0.f;
      for (int w = 0; w < 8; ++w) { s += part[(w * 32 + tid) * 2]; q += part[(w * 32 + tid) * 2 + 1]; }
      const float mean = s * (1.f / 1024.f), var = fmaxf(q * (1.f / 1024.f) - mean * mean, 0.f);
      stats[tid * 2] = mean; stats[tid * 2 + 1] = rsqrtf(var + EPS); }
    __syncthreads();
#pragma unroll 1
    for (int tt = 0; tt < 32; ++tt) {
      float o0 = cb[0], o1 = cb[1];
#pragma unroll
      for (int j = 0; j < 31; ++j) { const unsigned u = glu[(tt + j) * 512 + tid]; o0 += w0[j] * bflo(u); o1 += w1[j] * bfhi(u); }
      const float mean = stats[tt * 2], rstd = stats[tt * 2 + 1];
      const float y0 = (o0 - mean) * rstd * lg[0] + lb[0], y1 = (o1 - mean) * rstd * lg[1] + lb[1];
      *(unsigned*)(CAT + (size_t)(tok0 + tt) * DM + c0) = cvt_pk_bf16(silu(y0), silu(y1));
    }
    __syncthreads();
  }
}

__device__ __forceinline__ void dn_prep(AP a) {
  const bf16_t* P = (const bf16_t*)(a->ws + WS_H);
  bf16_t* QN = (bf16_t*)(a->ws + WS_S); bf16_t* KN = (bf16_t*)(a->ws + WS_S + SZ_T1K); bf16_t* VS = (bf16_t*)(a->ws + WS_S + 2 * SZ_T1K);
  const float* sw = a->in[16];
  const int lane = tidx() & 63, wid = tidx() >> 6;
  for (int tok = blockIdx.x * 8 + wid; tok < T; tok += gridDim.x * 8) {
    const int s = tok & (SEQ - 1);
#pragma unroll 1
    for (int sb = 0; sb < 24; sb += 4) {
      unsigned x0[4], xm[4], xp[4]; f32x2 wa[4], wb[4], wc[4];
#pragma unroll
      for (int i = 0; i < 4; ++i) { const int c = (sb + i) * 128 + 2 * lane; const bf16_t* pr = P + (size_t)tok * NIN + 2048 + c;
        x0[i] = *(const unsigned*)pr; xm[i] = *(const unsigned*)(pr - (s > 0 ? NIN : 0)); xp[i] = *(const unsigned*)(pr + (s < SEQ - 1 ? NIN : 0));
        wa[i] = *(const f32x2*)(sw + c); wb[i] = *(const f32x2*)(sw + 3072 + c); wc[i] = *(const f32x2*)(sw + 6144 + c); }
#pragma unroll
      for (int i = 0; i < 4; ++i) { const int slot = sb + i;
        const unsigned um = (s > 0) ? xm[i] : 0u, up = (s < SEQ - 1) ? xp[i] : 0u;
        float y0 = wa[i][0] * bflo(um) + wb[i][0] * bflo(x0[i]) + wc[i][0] * bflo(up), y1 = wa[i][1] * bfhi(um) + wb[i][1] * bfhi(x0[i]) + wc[i][1] * bfhi(up);
        y0 = silu(y0); y1 = silu(y1);
        if (slot < 16) { const float ss = wave_sum(y0 * y0 + y1 * y1); float r = rsqrtf(ss + EPS); if (slot < 8) r *= 0.08838834764831845f; y0 *= r; y1 *= r; }
        bf16_t* dst = (slot < 8 ? QN : (slot < 16 ? KN : VS)) + (size_t)tok * 1024 + (slot & 7) * 128 + 2 * lane;
        *(unsigned*)dst = cvt_pk_bf16(y0, y1); }
    }
  }
  const float* BA = (const float*)(a->ws + WS_BA); float* BG = (float*)(a->ws + WS_BG);
  for (size_t i = (size_t)blockIdx.x * 512 + tidx(); i < (size_t)T * 16; i += (size_t)gridDim.x * 512) {
    const int tok = (int)(i >> 4), j = (int)(i & 15);
    const float braw = BA[(size_t)tok * 32 + j], araw = BA[(size_t)tok * 32 + 16 + j];
    const float xx = araw + a->in[18][j]; const float sp = xx > 20.f ? xx : log1pf(expf(xx));
    const float g = -expf(a->in[17][j]) * sp;
    BG[(size_t)tok * 32 + j] = sigm(braw); BG[(size_t)tok * 32 + 16 + j] = expf(g);
  }
}

__device__ __forceinline__ void scan_phase(AP a, unsigned char* lds) {
  const bf16_t* QN = (const bf16_t*)(a->ws + WS_S); const bf16_t* KN = (const bf16_t*)(a->ws + WS_S + SZ_T1K); const bf16_t* VS = (const bf16_t*)(a->ws + WS_S + 2 * SZ_T1K);
  const float* BG = (const float*)(a->ws + WS_BG);
  constexpr int BUF_F = 32 * 128 * 2 + 32 * 32 + 64;
  float* sb = (float*)lds; float* ob = sb + 2 * BUF_F;
  float* dump = ob + 2048 + (tidx() & 255);
  float* wtile = (float*)(lds + 86016) + ((tidx() >> 6) & 3) * (64 * 33);
  int hid = (int)blockIdx.x * 4 + ((tidx() >> 6) & 3); const int hstep = (int)gridDim.x * 4;
  float* gains = (float*)(lds + 119808);
  for (int i = tidx(); i < 4 * DM; i += 512) { const int v = i >> 11, k = i & (DM - 1); gains[i] = (v == 0) ? a->in[7][k] : (v == 1) ? a->in[2][DM + k] : (v == 2) ? a->in[7][DM + k] : a->in[6][DM + k]; }
  __syncthreads();
  int hprev = -1; float hv[32];
#pragma unroll
  for (int i = 0; i < 32; ++i) hv[i] = 0.f;
  const int tid = tidx(), lane = tid & 63, wid = tid >> 6, j = lane & 7, col = (wid & 3) * 8 + (lane >> 3);
  const int tl = tid >> 4, c8 = (tid & 15) * 8, tlv = (tid >> 2) & 31, cv = (tid & 3) * 8;
  for (int item = blockIdx.x; item < 256; item += gridDim.x) {
    const int cb = item & 3, dir = (item >> 2) & 1, h = (item >> 3) & 7, b = item >> 6;
    bf16_t* OD = (bf16_t*)(a->ws + WS_S + (3 + dir) * SZ_T1K);
    f32x2 S2[8];
#pragma unroll
    for (int i = 0; i < 8; ++i) S2[i] = (f32x2){0.f, 0.f};
    u32x4 kr, qr, vr; float ar = 0.f, br = 0.f;
#define SC_TOK(c, t) (b * SEQ + (dir ? (SEQ - 1 - ((c) * 32 + (t))) : ((c) * 32 + (t))))
#define SC_LOAD(c) do { const size_t tk = (size_t)SC_TOK(c, tl); kr = *(const u32x4*)(KN + tk * 1024 + h * 128 + c8); qr = *(const u32x4*)(QN + tk * 1024 + h * 128 + c8); \
      if (tid < 128) vr = *(const u32x4*)(VS + (size_t)SC_TOK(c, tlv) * 1024 + h * 128 + cb * 32 + cv); \
      else if (tid < 160) { const size_t t2 = (size_t)SC_TOK(c, tid - 128); br = BG[t2 * 32 + dir * 8 + h]; ar = BG[t2 * 32 + 16 + dir * 8 + h]; } } while (0)
#define SC_WRITE(bi) do { float* kb = sb + (bi) * BUF_F; float* qb = kb + 4096; float* vb = qb + 4096; float* abp = vb + 1024; \
      *(f32x4*)(kb + tl * 128 + c8) = (f32x4){bflo(kr[0]), bfhi(kr[0]), bflo(kr[1]), bfhi(kr[1])}; *(f32x4*)(kb + tl * 128 + c8 + 4) = (f32x4){bflo(kr[2]), bfhi(kr[2]), bflo(kr[3]), bfhi(kr[3])}; \
      *(f32x4*)(qb + tl * 128 + c8) = (f32x4){bflo(qr[0]), bfhi(qr[0]), bflo(qr[1]), bfhi(qr[1])}; *(f32x4*)(qb + tl * 128 + c8 + 4) = (f32x4){bflo(qr[2]), bfhi(qr[2]), bflo(qr[3]), bfhi(qr[3])}; \
      if (tid < 128) { *(f32x4*)(vb + tlv * 32 + cv) = (f32x4){bflo(vr[0]), bfhi(vr[0]), bflo(vr[1]), bfhi(vr[1])}; *(f32x4*)(vb + tlv * 32 + cv + 4) = (f32x4){bflo(vr[2]), bfhi(vr[2]), bflo(vr[3]), bfhi(vr[3])}; } \
      else if (tid < 160) { abp[(tid - 128) * 2] = ar; abp[(tid - 128) * 2 + 1] = br; } } while (0)
#define SC_FLUSH(c) do { if (tid < 128) { const float* op = ob + ((c) & 1) * 1024 + tlv * 32 + cv; const f32x4 x0 = *(const f32x4*)op, x1 = *(const f32x4*)(op + 4); \
      u32x4 w; w[0] = cvt_pk_bf16(x0[0], x0[1]); w[1] = cvt_pk_bf16(x0[2], x0[3]); w[2] = cvt_pk_bf16(x1[0], x1[1]); w[3] = cvt_pk_bf16(x1[2], x1[3]); \
      *(u32x4*)(OD + (size_t)SC_TOK(c, tlv) * 1024 + h * 128 + cb * 32 + cv) = w; } } while (0)
    __syncthreads();
    SC_LOAD(0); SC_WRITE(0); __syncthreads();
    for (int c = 0; c < SEQ / 32; ++c) {
      if (c + 1 < SEQ / 32) SC_LOAD(c + 1);
      if (c > 0) SC_FLUSH(c - 1);
      const float* kb = sb + (c & 1) * BUF_F; const float* qb = kb + 4096; const float* vb = qb + 4096; const float* abp = vb + 1024; float* obc = ob + (c & 1) * 1024;
      if (wid < 4) {
        f32x4 kv[4], qv[4]; f32x2 ab2; float vv;
#define SC_LD(t) do { _Pragma("unroll") for (int i = 0; i < 4; ++i) { kv[i] = *(const f32x4*)(kb + (t) * 128 + 16 * j + 4 * i); qv[i] = *(const f32x4*)(qb + (t) * 128 + 16 * j + 4 * i); } \
          ab2 = *(const f32x2*)(abp + (t) * 2); vv = vb[(t) * 32 + col]; } while (0)
        SC_LD(0);
#pragma unroll 8
        for (int t = 0; t < 32; ++t) {
          f32x2 kk[8], qq[8];
#pragma unroll
          for (int i = 0; i < 4; ++i) { kk[2 * i] = (f32x2){kv[i][0], kv[i][1]}; kk[2 * i + 1] = (f32x2){kv[i][2], kv[i][3]}; qq[2 * i] = (f32x2){qv[i][0], qv[i][1]}; qq[2 * i + 1] = (f32x2){qv[i][2], qv[i][3]}; }
          const float al = ab2[0], bt = ab2[1], vc = vv;
          SC_LD((t + 1) & 31);
          f32x2 d0 = S2[0] * kk[0], d1 = S2[1] * kk[1];
#pragma unroll
          for (int i = 1; i < 4; ++i) { d0 = S2[2 * i] * kk[2 * i] + d0; d1 = S2[2 * i + 1] * kk[2 * i + 1] + d1; }
          d0 = d0 + d1;
          const float d = row_sum8(d0[0] + d0[1]);
          const float dl = bt * (vc - al * d);
          const f32x2 dl2 = {dl, dl}, al2 = {al, al};
#pragma unroll
          for (int i = 0; i < 8; ++i) S2[i] = kk[i] * dl2 + S2[i] * al2;
          f32x2 o0 = S2[0] * qq[0], o1 = S2[1] * qq[1];
#pragma unroll
          for (int i = 1; i < 4; ++i) { o0 = S2[2 * i] * qq[2 * i] + o0; o1 = S2[2 * i + 1] * qq[2 * i + 1] + o1; }
          o0 = o0 + o1;
          const float od = row_sum8(o0[0] + o0[1]);
          *((j == 0) ? (obc + t * 32 + col) : dump) = od;
        }
#undef SC_LD
      } else {
        if (hprev >= 0) helper_finish(a, hprev, hv, wtile, gains, lane);
        if (hid < HT_TOTAL) { helper_issue(a, hid, hv, lane); hprev = hid; hid += hstep; } else hprev = -1;
      }
      if (c + 1 < SEQ / 32) SC_WRITE((c + 1) & 1);
      asm volatile("s_waitcnt lgkmcnt(0)" ::: "memory"); __builtin_amdgcn_s_barrier(); asm volatile("" ::: "memory");
    }
    SC_FLUSH(SEQ / 32 - 1);
    __syncthreads();
#undef SC_TOK
#undef SC_LOAD
#undef SC_WRITE
#undef SC_FLUSH
  }
  if (wid >= 4) { if (hprev >= 0) helper_finish(a, hprev, hv, wtile, gains, lane); for (; hid < HT_TOTAL; hid += hstep) { helper_issue(a, hid, hv, lane); helper_finish(a, hid, hv, wtile, gains, lane); } }
}

__device__ __forceinline__ void gnorm_phase(AP a) {
  const bf16_t* P = (const bf16_t*)(a->ws + WS_H); bf16_t* CAT = (bf16_t*)(a->ws + WS_S);
  const bf16_t* OF = (const bf16_t*)(a->ws + WS_S + 3 * SZ_T1K); const bf16_t* OB = (const bf16_t*)(a->ws + WS_S + 4 * SZ_T1K);
  const int lane = tidx() & 63, wid = tidx() >> 6;
  const f32x2 g = *(const f32x2*)(a->in[19] + 2 * lane);
  for (int tok = blockIdx.x * 8 + wid; tok < T; tok += gridDim.x * 8) {
    unsigned uf[8], ub[8], uz[8];
#pragma unroll
    for (int h = 0; h < 8; ++h) { const size_t o = (size_t)tok * 1024 + h * 128 + 2 * lane;
      uf[h] = *(const unsigned*)(OF + o); ub[h] = *(const unsigned*)(OB + o); uz[h] = *(const unsigned*)(P + (size_t)tok * NIN + 5120 + h * 128 + 2 * lane); }
#pragma unroll
    for (int h = 0; h < 8; ++h) {
      const float o0 = bflo(uf[h]) + bflo(ub[h]), o1 = bfhi(uf[h]) + bfhi(ub[h]);
      const float ss = wave_sum(o0 * o0 + o1 * o1), rstd = rsqrtf(ss * (1.f / 128.f) + EPS);
      const float y0 = o0 * rstd * g[0] * silu(bflo(uz[h])), y1 = o1 * rstd * g[1] * silu(bfhi(uz[h]));
      *(unsigned*)(CAT + (size_t)tok * DM + 1024 + h * 128 + 2 * lane) = cvt_pk_bf16(y0, y1);
    }
  }
}

__device__ __forceinline__ void attn_phase(AP a, unsigned char* lds) {
  const bf16_t* QKV = (const bf16_t*)(a->ws + WS_H); float* OA = (float*)(a->ws + WS_S);
  const int lane = tidx() & 63;
  const float s1 = wave_sum(a->in[22][lane] * a->in[23][lane] + a->in[22][lane + 64] * a->in[23][lane + 64]);
  const float s2 = wave_sum(a->in[24][lane] * a->in[25][lane] + a->in[24][lane + 64] * a->in[25][lane + 64]);
  const float lam = __int_as_float(__builtin_amdgcn_readfirstlane(__float_as_int(expf(s1) - expf(s2) + LAMBDA_INIT)));
  int seq = SEQ; asm volatile("" : "+s"(seq));
  const int nk = (512 - (int)blockIdx.x + (int)gridDim.x - 1) / (int)gridDim.x;
#pragma unroll 1
  for (int it = 0; it < 4 * nk; ++it) {
    const int item = blockIdx.x + gridDim.x * (it >> 2), m = it & 1, vh = (it >> 1) & 1;
    const int h = item & 7, qb = (item >> 3) & 15, b = item >> 7;
    const size_t tok0 = (size_t)b * SEQ + qb * 256, kv0 = (size_t)b * SEQ;
    att::attn_dense_body<att::bf16>(QKV + tok0 * NQKV + h * 256 + m * 128, QKV + kv0 * NQKV + 2048 + h * 256 + m * 128, QKV + kv0 * NQKV + 4096 + h * 256 + vh * 128,
                                    OA + tok0 * DM + h * 256 + vh * 128, seq, (char*)lds, m, lam, (unsigned short*)(lds + 69632));
    __syncthreads();
    if ((it & 3) == 3) {
      asm volatile("s_waitcnt vmcnt(0)" ::: "memory");
      const int wv = tidx() >> 6, ln = tidx() & 63; bf16_t* CAT = (bf16_t*)a->out;
      const f32x4 sg = *(const f32x4*)(a->in[26] + 4 * ln);
#pragma unroll 4
      for (int r = 0; r < 32; ++r) {
        const size_t o = (tok0 + wv * 32 + r) * DM + h * 256 + 4 * ln;
        const f32x4 v = *(const f32x4*)(OA + o);
        const float ss = wave_sum(v[0] * v[0] + v[1] * v[1] + v[2] * v[2] + v[3] * v[3]), rr = rsqrtf(ss * (1.f / 256.f) + EPS) * (1.f - LAMBDA_INIT);
        u32x2 w; w[0] = cvt_pk_bf16(v[0] * rr * sg[0], v[1] * rr * sg[1]); w[1] = cvt_pk_bf16(v[2] * rr * sg[2], v[3] * rr * sg[3]);
        *(u32x2*)(CAT + o) = w;
      }
    }
  }
}
__device__ __forceinline__ void subln_phase(AP a) {
  const float* OA = (const float*)(a->ws + WS_S); bf16_t* CAT = (bf16_t*)(a->ws + WS_H);
  const int lane = tidx() & 63, wid = tidx() >> 6;
  const f32x4 g = *(const f32x4*)(a->in[26] + 4 * lane);
  for (int task = blockIdx.x * 8 + wid; task < T * 8; task += gridDim.x * 8) {
    const size_t o = (size_t)(task >> 3) * DM + (task & 7) * 256 + 4 * lane;
    const f32x4 v = *(const f32x4*)(OA + o);
    const float ss = wave_sum(v[0] * v[0] + v[1] * v[1] + v[2] * v[2] + v[3] * v[3]), r = rsqrtf(ss * (1.f / 256.f) + EPS) * (1.f - LAMBDA_INIT);
    u32x2 w; w[0] = cvt_pk_bf16(v[0] * r * g[0], v[1] * r * g[1]); w[1] = cvt_pk_bf16(v[2] * r * g[2], v[3] * r * g[3]);
    *(u32x2*)(CAT + o) = w;
  }
}

#define XB_TMO      128
#define XB_XCNT(j)  (256  + 64 * (j))
#define XB_XSUB(j)  (1280 + 64 * (j))
#define XB_XGEN(j)  (2304 + 64 * (j))
#define XB_TOP      3328
#define XB_TOPGEN   3392
#define XCD_BAR_WORDS 3456
#define XB_SPIN_CAP (1u << 18)
__device__ __forceinline__ unsigned xb_ld(unsigned* p)              { return __hip_atomic_load(p, __ATOMIC_RELAXED, __HIP_MEMORY_SCOPE_AGENT); }
__device__ __forceinline__ unsigned xb_add(unsigned* p, unsigned v) { return __hip_atomic_fetch_add(p, v, __ATOMIC_RELAXED, __HIP_MEMORY_SCOPE_AGENT); }
__device__ __forceinline__ unsigned xb_xcc_id() { return (unsigned)__builtin_amdgcn_s_getreg((3 << 11) | 20) & 0xFu; }
#define XB_SPIN(cond, bar) do { unsigned _sp = 0; while (cond) { __builtin_amdgcn_s_sleep(1); \
    if ((++_sp & 255u) == 0u) { if (xb_ld(&(bar)[XB_TMO])) break; if (_sp > XB_SPIN_CAP) { atomicAdd(&(bar)[XB_TMO], 1u); break; } } } } while (0)
__device__ __forceinline__ void xcd_barrier_complete(unsigned* bar, unsigned x, unsigned& nloc, unsigned& nx) {
  const unsigned G = gridDim.x;
  unsigned sum, cnt, mine, sp = 0u;
  for (;;) {
    sum = 0u; cnt = 0u; mine = 0u;
#pragma unroll 1
    for (unsigned j = 0; j < 16; ++j) { const unsigned c = xb_ld(&bar[XB_XCNT(j)]); sum += c; cnt += (c > 0u) ? 1u : 0u; mine = (j == x) ? c : mine; }
    if (sum == G) break;
    __builtin_amdgcn_s_sleep(1);
    if ((++sp & 255u) == 0u) { if (xb_ld(&bar[XB_TMO])) break; if (sp > XB_SPIN_CAP) { atomicAdd(&bar[XB_TMO], 1u); break; } }
  }
  nloc = mine > 0u ? mine : 1u; nx = cnt > 0u ? cnt : 1u;
}
__device__ __forceinline__ void xcd_barrier(unsigned* bar, volatile PG8_LAS unsigned* st) {
  asm volatile("s_waitcnt vmcnt(0)" ::: "memory");
  __syncthreads();
  if (threadIdx.x == 0) {
    const unsigned x = xb_xcc_id();
    __builtin_amdgcn_s_waitcnt(0);
    unsigned nloc = st[0], nx = st[1];
    if (nloc == 0u) { xcd_barrier_complete(bar, x, nloc, nx); st[0] = nloc; st[1] = nx; }
    const unsigned old = xb_add(&bar[XB_XSUB(x)], 1u);
    const unsigned gen = old / nloc;
    if (old + 1u == (gen + 1u) * nloc) {
      __builtin_amdgcn_fence(__ATOMIC_RELEASE, "agent");
      asm volatile("s_waitcnt vmcnt(0)" ::: "memory");
      const unsigned og = xb_add(&bar[XB_TOP], 1u);
      const unsigned tg = og / nx;
      if (og + 1u == (tg + 1u) * nx) xb_add(&bar[XB_TOPGEN], 1u);
      else XB_SPIN(xb_ld(&bar[XB_TOPGEN]) == tg, bar);
      __builtin_amdgcn_fence(__ATOMIC_ACQUIRE, "agent");
      xb_add(&bar[XB_XGEN(x)], 1u);
      asm volatile("s_waitcnt vmcnt(0)" ::: "memory");
    } else {
      XB_SPIN(xb_ld(&bar[XB_XGEN(x)]) == gen, bar);
      __builtin_amdgcn_fence(__ATOMIC_ACQUIRE, "agent");
      asm volatile("s_waitcnt vmcnt(0)" ::: "memory");
    }
  }
  __syncthreads();
}

enum { PT_PRO, PT_GU, PT_RES, PT_NORM, PT_IN, PT_CONV, PT_SCAN, PT_GNORM, PT_QKV, PT_ATTN, PT_SUBLN, PT_FINAL };

__global__ void __launch_bounds__(512, 2) mega(Args a_kernarg) {
  extern __shared__ __attribute__((aligned(16))) unsigned char lds[];
  cg::grid_group grid = cg::this_grid();
  const AP a0 = (AP)__builtin_amdgcn_kernarg_segment_ptr();
  volatile PG8_LAS unsigned* xst = (volatile PG8_LAS unsigned*)((PG8_LAS unsigned char*)lds + (LDS_BYTES - 16));
  if (threadIdx.x == 0) { xst[0] = 0u; xst[1] = 0u; (void)xb_add(&((unsigned*)(a0->ws + WS_BAR))[XB_XCNT(xb_xcc_id())], 1u); }
  __syncthreads();
  const int ph_lo = a0->ph_lo, ph_hi = a0->ph_hi;
  for (int php = ph_lo; php < ph_hi; ++php) {
    int ph = php;
#ifndef MK_DUP_PH
#define DUP2 0
#else
#define DUP2 (int)dup2
#endif
#ifdef MK_DUP_PH
    bool dup2 = false;
    if (php > MK_DUP_PH) { ph = php - 1; dup2 = (php == MK_DUP_PH + 1); }
#endif
    unsigned long long apv = (unsigned long long)a0; asm volatile("" : "+s"(apv)); const AP a = (AP)apv;
    unsigned char* ws = a->ws;
    int type = PT_PRO, f = 0, nss = -1;
    const bf16_t* gA = (const bf16_t*)(ws + WS_H); const bf16_t* gB = nullptr; int gK = FF;
    switch (ph) {
      case 0: type = PT_PRO; break;
      case 1: type = PT_GU; f = 0; nss = 5; break;
      case 2: type = PT_RES; gB = (const bf16_t*)(ws + WS_WD); nss = 0; break;
      case 3: type = PT_IN; nss = 0; break;
      case 4: type = PT_CONV; break;
      case 5: type = PT_SCAN; break;
      case 6: type = PT_GNORM; break;
      case 7: type = PT_RES; gA = (const bf16_t*)(ws + WS_S); gB = (const bf16_t*)(ws + WS_WOUT); gK = DM; nss = 1; break;
      case 8: type = PT_GU; f = 1; nss = 1; break;
      case 9: type = PT_RES; gB = (const bf16_t*)(ws + WS_WD + 1 * SZ_D); nss = 2; break;
      case 10: type = PT_GU; f = 2; nss = 2; break;
      case 11: type = PT_RES; gB = (const bf16_t*)(ws + WS_WD + 2 * SZ_D); nss = 3; break;
      case 12: type = PT_QKV; nss = 3; break;
      case 13: type = PT_ATTN; break;
      case 14: type = PT_SUBLN; break;
      case 15: type = PT_RES; gA = (const bf16_t*)a->out; gB = (const bf16_t*)(ws + WS_WO); gK = DM; nss = 4; break;
      case 16: type = PT_GU; f = 3; nss = 4; break;
      case 17: type = PT_RES; gB = (const bf16_t*)(ws + WS_WD + 3 * SZ_D); break;
      default: type = PT_FINAL; break;
    }
    const u64* ssp = (const u64*)(ws + WS_SS) + (size_t)(nss >= 0 ? nss : 0) * T;
    pg8::StaticOrder S;
#ifndef MK_ENABLE
#define MK_ENABLE 0xFFFF
#endif
    if (!((MK_ENABLE >> type) & 1)) continue;
    if (type == PT_SUBLN) continue;
    switch (type) {
      case PT_PRO: prologue(a, lds); break;
      case PT_GU: {
#ifdef MK_STAGGER
        if ((blockIdx.x >> 3) & 1) { const unsigned long long t0 = __builtin_amdgcn_s_memrealtime(); while (__builtin_amdgcn_s_memrealtime() - t0 < MK_STAGGER) __builtin_amdgcn_s_sleep(32); }
#endif
        pg8::Gemm g{(const bf16_t*)(ws + WS_XN), (const bf16_t*)(ws + WS_WGU + (size_t)f * SZ_GU), T, 2 * FF, DM}; S.init(T, 2 * FF, gridDim.x, blockIdx.x);
        EpiSwiglu E{(bf16_t*)(ws + WS_H), ssp, DUP2}; pg8::gemm_phase<EpiSwiglu, pg8::StaticOrder>((PG8_LAS unsigned char*)lds, g, S, E, nullptr); } break;
      case PT_RES: { pg8::Gemm g{gA, gB, T, DM, gK}; S.init(T, DM, gridDim.x, blockIdx.x);
        EpiResid E{a, ph, DUP2}; pg8::gemm_phase<EpiResid, pg8::StaticOrder>((PG8_LAS unsigned char*)lds, g, S, E, nullptr); } break;
      case PT_IN: { pg8::Gemm g{(const bf16_t*)(ws + WS_XN), (const bf16_t*)(ws + WS_WIN), T, NIN, DM}; S.init(T, NIN, gridDim.x, blockIdx.x);
        EpiP E{(bf16_t*)(ws + WS_H), (float*)(ws + WS_BA), ssp}; pg8::gemm_phase<EpiP, pg8::StaticOrder>((PG8_LAS unsigned char*)lds, g, S, E, nullptr); } break;
      case PT_CONV: dn_prep(a); break;
      case PT_SCAN: scan_phase(a, lds); break;
      case PT_GNORM: gnorm_phase(a); conv_module(a, lds); break;
      case PT_QKV: { pg8::Gemm g{(const bf16_t*)(ws + WS_XN), (const bf16_t*)(ws + WS_WQKV), T, NQKV, DM}; S.init(T, NQKV, gridDim.x, blockIdx.x);
        EpiQKV E{(bf16_t*)(ws + WS_H), (const float*)(ws + WS_ROPE), ssp}; pg8::gemm_phase<EpiQKV, pg8::StaticOrder>((PG8_LAS unsigned char*)lds, g, S, E, nullptr); } break;
      case PT_ATTN: attn_phase(a, lds); break;
      case PT_SUBLN: break;
      default: final_phase((const bf16_t*)(ws + WS_XN), (const u64*)(ws + WS_SS) + (size_t)6 * T, a->in[28], a->out); break;
    }
    if (php + 1 < ph_hi) { if (php == ph_lo) grid.sync(); else xcd_barrier((unsigned*)(a0->ws + WS_BAR), xst); }
  }
}
}

#ifndef MK_MULTI
#define MK_MULTI 0
#endif
extern "C" void kernel_launch(void* const* d_in, const int* in_sizes, int n_in, void* d_out, int out_size, void* d_ws, size_t ws_size, hipStream_t stream) {
  static int grid = 0;
  if (grid == 0) {
    if (n_in != 29 || out_size != mk::T * mk::DM || ws_size < mk::WS_END) { fprintf(stderr, "kernel_launch: unexpected shapes n_in %d out %d ws %zu (need %zu)\n", n_in, out_size, ws_size, (size_t)mk::WS_END); grid = -1; return; }
    int dev = 0, cus = 0, per_cu = 0;
    hipGetDevice(&dev); hipDeviceGetAttribute(&cus, hipDeviceAttributeMultiprocessorCount, dev);
    if (hipFuncSetAttribute((const void*)mk::mega, hipFuncAttributeMaxDynamicSharedMemorySize, mk::LDS_BYTES) != hipSuccess) { fprintf(stderr, "kernel_launch: hipFuncSetAttribute failed\n"); grid = -1; return; }
    hipOccupancyMaxActiveBlocksPerMultiprocessor(&per_cu, (const void*)mk::mega, 512, mk::LDS_BYTES);
    if (per_cu < 1) per_cu = 1;
    grid = cus * per_cu;
    (void)hipGetLastError();
  }
  if (grid < 0) return;
  mk::Args a{};
  for (int i = 0; i < 29; ++i) a.in[i] = (const float*)d_in[i];
  a.out = (float*)d_out; a.ws = (unsigned char*)d_ws;
#if MK_MULTI
  for (int ph = 0; ph < mk::NPHASE; ++ph) { a.ph_lo = ph; a.ph_hi = ph + 1; hipLaunchKernelGGL(mk::mega, dim3(grid), dim3(512), mk::LDS_BYTES, stream, a); }
#else
  a.ph_lo = 0; a.ph_hi = mk::NPHASE;
  (void)hipMemsetAsync((char*)d_ws + mk::WS_BAR, 0, 16384, stream);
  void* args[] = {&a};
  hipError_t e = hipLaunchCooperativeKernel((const void*)mk::mega, dim3(grid), dim3(512), args, mk::LDS_BYTES, stream);
  if (e != hipSuccess) fprintf(stderr, "cooperative launch failed: %s (grid %d)\n", hipGetErrorString(e), grid);
#endif
}
```

```cpp
#include <hip/hip_runtime.h>
#include <hip/hip_cooperative_groups.h>
#include <cstdio>
#include <cstdint>
namespace cg = cooperative_groups;
__device__ __forceinline__ int tidx() { int t = threadIdx.x; asm volatile("" : "+v"(t)); return t; }
namespace pg8 {
#define PG8_LAS __attribute__((address_space(3)))
typedef unsigned short bf16_t;
typedef short bf16x8 __attribute__((ext_vector_type(8)));
typedef float f32x4 __attribute__((ext_vector_type(4)));
typedef unsigned u32x4 __attribute__((ext_vector_type(4)));
constexpr int BM = 256, BK = 64, HALF = 128, HTB = HALF * BK * 2  , STAGE_BYTES = 8 * HTB, NXCD = 8, WGM = 4;

__host__ __device__ __forceinline__ int lds_byte(int r, int c) { const int st = (r >> 4) * 2 + (c >> 5), rr = r & 15, cc = c & 31, ob = rr * 64 + cc * 2; return st * 1024 + (ob ^ (((ob >> 9) & 1) << 5)); }
__host__ __device__ __forceinline__ void stage_rc(int b, int& R, int& C) { const int st = b / 1024, sb = b % 1024, swz = sb ^ (((sb >> 9) & 1) << 5); R = (st >> 1) * 16 + swz / 64; C = (st & 1) * 32 + (swz % 64) / 2; }
__host__ __device__ __forceinline__ int perm32(int rho) { const int n = rho >> 4, i = rho & 15; return 8 * (i >> 2) + 4 * n + (i & 3); }
struct Unit { int pm, pn; };
struct Gemm { const bf16_t* A; const bf16_t* Bt; int M, N, K; };

struct StaticOrder {
    int nM, nN, nwg, G, c;
    __host__ __device__ void init(int M, int N, int G_, int c_) { nM = M / BM; nN = N / BM; nwg = nM * nN; G = G_; c = c_; }
    __host__ __device__ bool next(int i, Unit& u) const {
        const long L = (long)i * G + c; if (L >= nwg) return false;
        int wgid = (int)L; { const int q = nwg / NXCD, r = nwg % NXCD, xcd = wgid % NXCD, off = wgid / NXCD; wgid = (xcd < r ? xcd * (q + 1) : r * (q + 1) + (xcd - r) * q) + off; }
        const int nig = WGM * nN, gid = wgid / nig, fm = gid * WGM, gsz = (nM - fm) < WGM ? (nM - fm) : WGM;
        u.pm = fm + ((wgid % nig) % gsz); u.pn = (wgid % nig) / gsz; return true;
    }
    __device__ __forceinline__ void a_ready(const Unit&) const {}
    __device__ __forceinline__ void done(const Unit&) const {}
};
__device__ __forceinline__ unsigned cvt_pk_bf16(float lo, float hi) { unsigned r; asm volatile("v_cvt_pk_bf16_f32 %0, %1, %2" : "=v"(r) : "v"(lo), "v"(hi)); return r; }
template <class Epi, class Sched, bool STAMP = false>
__device__ __forceinline__ void gemm_phase(PG8_LAS unsigned char* lds, const Gemm g, const Sched& S, const Epi& E, unsigned long long* stamps) {
    const int tid = tidx(), wid = __builtin_amdgcn_readfirstlane(tid >> 6), lane = tid & 63, wr = wid >> 2, wc = wid & 3, fr = lane & 15, fq = lane >> 4;
    const int K = g.K, nt = K / BK;
    int ts_lo = 0, ts_hi = 0, nts = 0; const unsigned long long rt_entry = STAMP ? (unsigned long long)wall_clock64() : 0ull;
#define PG8_STAMP() do { if (STAMP && wid == 0 && nts < 64) { const unsigned long long _c = (unsigned long long)clock64(); \
        ts_lo = (lane == nts) ? (int)(unsigned)_c : ts_lo; ts_hi = (lane == nts) ? (int)(unsigned)(_c >> 32) : ts_hi; ++nts; } } while (0)
    PG8_STAMP();
    unsigned voffA[2], voffB[2];
#pragma unroll
    for (int i = 0; i < 2; ++i) { int R, C; stage_rc(tid * 16 + i * 8192, R, C); const int Rb = Epi::PERM ? ((R & ~31) + perm32(R & 31)) : R;
        voffA[i] = (unsigned)(R * K + C) * 2u; voffB[i] = (unsigned)(Rb * K + C) * 2u; }
    const size_t kstep = (size_t)(BK * 2);
    const size_t hstep = (size_t)HALF * K * 2;
    const size_t tstep = 2 * hstep;
    const unsigned ldsw = (unsigned)wid * 1024u;
    const int aoff = lds_byte(wr * 64 + fr, fq * 8), boff = lds_byte(wc * 32 + fr, fq * 8);
#define PG8_SA(b, h) (((b) * 2 + (h)) * HTB)
#define PG8_SB(b, h) ((4 + (b) * 2 + (h)) * HTB)
#define PG8_STAGE(bufoff, gbase, voff) do { _Pragma("unroll") for (int _i = 0; _i < 2; ++_i) \
        __builtin_amdgcn_global_load_lds((const unsigned*)((const char*)(gbase) + (voff)[_i]), (PG8_LAS unsigned*)(lds + (bufoff) + ldsw + _i * 8192), 16, 0, 0); } while (0)
#define PG8_LDA(dst, b, h) do { _Pragma("unroll") for (int m = 0; m < 4; ++m) _Pragma("unroll") for (int k = 0; k < 2; ++k) dst[m][k] = *(const PG8_LAS bf16x8*)(lds + PG8_SA(b, h) + aoff + m * 2048 + k * 1024); } while (0)
#define PG8_LDB(dst, b, h) do { _Pragma("unroll") for (int n = 0; n < 2; ++n) _Pragma("unroll") for (int k = 0; k < 2; ++k) dst[n][k] = *(const PG8_LAS bf16x8*)(lds + PG8_SB(b, h) + boff + n * 2048 + k * 1024); } while (0)
#define PG8_MMA(ai, bj, At, Bt) do { __builtin_amdgcn_s_setprio(1); _Pragma("unroll") for (int m = 0; m < 4; ++m) _Pragma("unroll") for (int n = 0; n < 2; ++n) _Pragma("unroll") for (int k = 0; k < 2; ++k) \
        acc[ai][bj][m][n] = __builtin_amdgcn_mfma_f32_16x16x32_bf16(Bt[n][k], At[m][k], acc[ai][bj][m][n], 0, 0, 0); __builtin_amdgcn_s_setprio(0); } while (0)
#define PG8_WAIT_V(n) asm volatile("s_waitcnt vmcnt(" #n ")" ::: "memory")
#define PG8_WAIT_L(n) asm volatile("s_waitcnt lgkmcnt(" #n ")" ::: "memory")
#define PG8_BAR __builtin_amdgcn_s_barrier()
#define PG8_SCHED __builtin_amdgcn_sched_barrier(0)
    Unit cur, nxt; int ui = 0;
    if (!S.next(0, cur)) return;
    f32x4 acc[2][2][4][2];
#pragma unroll
    for (int a = 0; a < 2; ++a)
#pragma unroll
        for (int b = 0; b < 2; ++b)
#pragma unroll
            for (int m = 0; m < 4; ++m)
#pragma unroll
                for (int n = 0; n < 2; ++n) acc[a][b][m][n] = (f32x4){0.f, 0.f, 0.f, 0.f};
    bf16x8 At[4][2], B0[2][2], B1[2][2];
    const char* cA = (const char*)g.A + (size_t)cur.pm * tstep; const char* cB = (const char*)g.Bt + (size_t)cur.pn * tstep;
    S.a_ready(cur);
    PG8_STAGE(PG8_SB(0, 0), cB, voffB); PG8_STAGE(PG8_SA(0, 0), cA, voffA); PG8_STAGE(PG8_SB(0, 1), cB + hstep, voffB); PG8_STAGE(PG8_SA(0, 1), cA + hstep, voffA);
    if (wr == 1) PG8_BAR;
    PG8_WAIT_V(4); PG8_BAR;
    PG8_STAGE(PG8_SB(1, 0), cB + kstep, voffB); PG8_STAGE(PG8_SA(1, 0), cA + kstep, voffA); PG8_STAGE(PG8_SB(1, 1), cB + hstep + kstep, voffB);
    PG8_WAIT_V(6); PG8_BAR;
    PG8_STAMP();
    for (;;) {
        const bool has_next = S.next(ui + 1, nxt);
        const char* nA = has_next ? (const char*)g.A + (size_t)nxt.pm * tstep : cA; const char* nB = has_next ? (const char*)g.Bt + (size_t)nxt.pn * tstep : cB;
        for (int t = 0; t < nt; t += 2) {
            const bool last = (t == nt - 2);
            const char* a1 = cA + (size_t)(t + 1) * kstep;
            const char* a2 = last ? nA : cA + (size_t)(t + 2) * kstep; const char* b2 = last ? nB : cB + (size_t)(t + 2) * kstep;
            const char* a3 = a2 + kstep; const char* b3 = b2 + kstep;
            if (last && has_next) S.a_ready(nxt);
            PG8_LDB(B0, 0, 0); PG8_SCHED; PG8_LDA(At, 0, 0); PG8_STAGE(PG8_SA(1, 1), a1 + hstep, voffA);
            PG8_WAIT_L(8); PG8_BAR; PG8_WAIT_L(0); PG8_MMA(0, 0, At, B0); PG8_BAR; PG8_SCHED;
            PG8_LDB(B1, 0, 1); PG8_STAGE(PG8_SB(0, 0), b2, voffB);
            PG8_BAR; PG8_WAIT_L(0); PG8_MMA(0, 1, At, B1); PG8_BAR;
            PG8_LDA(At, 0, 1); PG8_STAGE(PG8_SA(0, 0), a2, voffA);
            PG8_BAR; PG8_WAIT_L(0); PG8_MMA(1, 0, At, B0); PG8_BAR; PG8_SCHED;
            PG8_STAGE(PG8_SB(0, 1), b2 + hstep, voffB);
            PG8_WAIT_V(6); PG8_BAR; PG8_MMA(1, 1, At, B1); PG8_BAR;
            PG8_LDB(B0, 1, 0); PG8_SCHED; PG8_LDA(At, 1, 0); PG8_STAGE(PG8_SA(0, 1), a2 + hstep, voffA);
            PG8_WAIT_L(8); PG8_BAR; PG8_WAIT_L(0); PG8_MMA(0, 0, At, B0); PG8_BAR; PG8_SCHED;
            PG8_LDB(B1, 1, 1); PG8_STAGE(PG8_SB(1, 0), b3, voffB);
            PG8_BAR; PG8_WAIT_L(0); PG8_MMA(0, 1, At, B1); PG8_BAR;
            PG8_LDA(At, 1, 1); PG8_STAGE(PG8_SA(1, 0), a3, voffA);
            PG8_BAR; PG8_WAIT_L(0); PG8_MMA(1, 0, At, B0); PG8_BAR; PG8_SCHED;
            PG8_STAGE(PG8_SB(1, 1), b3 + hstep, voffB);
            PG8_WAIT_V(6); PG8_BAR; PG8_MMA(1, 1, At, B1); PG8_BAR;
        }
        PG8_STAMP();
        if constexpr (!Epi::AFTER_DRAIN) { E(acc, cur, wr, wc, fr, fq); S.done(cur); }
        PG8_STAMP();
        if (!has_next) break;
#pragma unroll
        for (int a = 0; a < 2; ++a)
#pragma unroll
            for (int b = 0; b < 2; ++b)
#pragma unroll
                for (int m = 0; m < 4; ++m)
#pragma unroll
                    for (int n = 0; n < 2; ++n) acc[a][b][m][n] = (f32x4){0.f, 0.f, 0.f, 0.f};
        cur = nxt; cA = nA; cB = nB; ++ui;
    }
    PG8_WAIT_V(0);
    if (wr == 0) PG8_BAR;
    PG8_BAR;
    if constexpr (Epi::AFTER_DRAIN) { E.fused(acc, cur, wr, wc, fr, fq, lds, wid, lane); S.done(cur); }
    PG8_STAMP();
    if (STAMP && wid == 0) { stamps[lane] = lane < nts ? (((unsigned long long)(unsigned)ts_hi << 32) | (unsigned)ts_lo) : 0ull;
        if (lane == 62) stamps[62] = rt_entry; if (lane == 63) stamps[63] = (unsigned long long)wall_clock64(); }
#undef PG8_STAMP
#undef PG8_SA
#undef PG8_SB
#undef PG8_STAGE
#undef PG8_LDA
#undef PG8_LDB
#undef PG8_MMA
#undef PG8_WAIT_V
#undef PG8_WAIT_L
#undef PG8_BAR
#undef PG8_SCHED
}
}

namespace att {
using bf16 = unsigned short;
constexpr int   D = 128, NW = 8, QBLK = 32, KVBLK = 64;
constexpr float SCALE = 0.088388347648318440f;
constexpr float THR = 8.f;
constexpr int SDEPTH = 2;
constexpr int LDQ = 6144, LDK = 6144, LDO = 2048;
constexpr size_t SHM_V = KVBLK * D * 2, SHM_K = KVBLK * D * 2, SHM_ATTN = 2 * SHM_V + 2 * SHM_K + NW * 64 * 4;
using bf16x8 = __attribute__((ext_vector_type(8))) short;
using s16x4  = __attribute__((ext_vector_type(4))) short;
using f32x16 = __attribute__((ext_vector_type(16))) float;
using f32x8  = __attribute__((ext_vector_type(8))) float;
using u32x4  = __attribute__((ext_vector_type(4))) unsigned;
#define KSWZ(row, colB) ((row) * 256 + ((colB) ^ (((row) & 7) << 4)))
#define SBAR() __builtin_amdgcn_sched_barrier(0)
__device__ __forceinline__ int crow(int r, int hi) { return (r & 3) + 8 * (r >> 2) + 4 * hi; }
__device__ __forceinline__ unsigned cvtpk(float lo, float hi) {
  unsigned r; asm volatile("v_cvt_pk_bf16_f32 %0, %1, %2" : "=v"(r) : "v"(lo), "v"(hi)); return r;
}
template <typename TIn> struct Stage;
template <> struct Stage<bf16>  { using T = bf16x8;
  __device__ static __forceinline__ T ld8(const bf16* p) { return *reinterpret_cast<const bf16x8*>(p); }
  __device__ static __forceinline__ bf16x8 tobf(T x) { return x; } };
template <> struct Stage<float> { using T = f32x8;
  __device__ static __forceinline__ T ld8(const float* p) { return *reinterpret_cast<const f32x8*>(p); }
  __device__ static __forceinline__ bf16x8 tobf(T x) {
    u32x4 w = {cvtpk(x[0], x[1]), cvtpk(x[2], x[3]), cvtpk(x[4], x[5]), cvtpk(x[6], x[7])}; return *reinterpret_cast<bf16x8*>(&w); } };

__device__ __forceinline__ void partialSM(f32x16& p0, f32x16& p1, float& m_reg, float& mn, float& alpha) {
  constexpr float C = SCALE * 1.4426950408889634f;
  float pmax = p0[0]; for (int r = 1; r < 16; ++r) pmax = fmaxf(pmax, p0[r]); for (int r = 0; r < 16; ++r) pmax = fmaxf(pmax, p1[r]);
  { auto rr = __builtin_amdgcn_permlane32_swap(__float_as_uint(pmax), __float_as_uint(pmax), false, false);
    pmax = fmaxf(__uint_as_float(rr[0]), __uint_as_float(rr[1])); }
  if (__builtin_expect(__all(pmax - m_reg <= THR / SCALE), 1)) { mn = m_reg; alpha = 1.f; }
  else { mn = fmaxf(m_reg, pmax); alpha = __builtin_amdgcn_exp2f((m_reg - mn) * C); m_reg = mn; }
  float mnC = -mn * C;
  for (int r = 0; r < 16; ++r) p0[r] = fmaf(p0[r], C, mnC); for (int r = 0; r < 16; ++r) p1[r] = fmaf(p1[r], C, mnC);
  for (int r = 0; r < 16; ++r) p0[r] = __builtin_amdgcn_exp2f(p0[r]);
}
__device__ __forceinline__ void finishSM(f32x16& p0, f32x16& p1, float alpha, float& l_reg, bf16x8& pa0, bf16x8& pa1, bf16x8& pa2, bf16x8& pa3) {
  for (int r = 0; r < 16; ++r) p1[r] = __builtin_amdgcn_exp2f(p1[r]);
  float ps = 0; for (int r = 0; r < 16; ++r) ps += p0[r]; for (int r = 0; r < 16; ++r) ps += p1[r];
  { auto rr = __builtin_amdgcn_permlane32_swap(__float_as_uint(ps), __float_as_uint(ps), false, false);
    ps = __uint_as_float(rr[0]) + __uint_as_float(rr[1]); }
  l_reg = l_reg * alpha + ps;
#define PK4(P, BASE, OUT) do { unsigned a0 = cvtpk(P[BASE + 0], P[BASE + 1]), a1 = cvtpk(P[BASE + 2], P[BASE + 3]);   \
    unsigned b0 = cvtpk(P[BASE + 4], P[BASE + 5]), b1 = cvtpk(P[BASE + 6], P[BASE + 7]);                              \
    auto r0 = __builtin_amdgcn_permlane32_swap(a0, b0, false, false); auto r1 = __builtin_amdgcn_permlane32_swap(a1, b1, false, false); \
    u32x4 w = {r0[0], r1[0], r0[1], r1[1]}; OUT = *reinterpret_cast<bf16x8*>(&w); } while (0)
  PK4(p0, 0, pa0); PK4(p0, 8, pa1); PK4(p1, 0, pa2); PK4(p1, 8, pa3);
#undef PK4
}
__device__ __forceinline__ void qkt(f32x16& p0, f32x16& p1, const bf16* Ks, const bf16x8* qr, int r32, int hi) {
  p0 = f32x16{}; p1 = f32x16{};
  for (int d0 = 0; d0 < 8; ++d0) { int cb = (d0 * 16 + hi * 8) * 2;
    bf16x8 b0 = *reinterpret_cast<const bf16x8*>((const char*)Ks + KSWZ(r32, cb));
    bf16x8 b1 = *reinterpret_cast<const bf16x8*>((const char*)Ks + KSWZ(32 + r32, cb));
    p0 = __builtin_amdgcn_mfma_f32_32x32x16_bf16(b0, qr[d0], p0, 0, 0, 0);
    p1 = __builtin_amdgcn_mfma_f32_32x32x16_bf16(b1, qr[d0], p1, 0, 0, 0); }
}
__device__ __forceinline__ int v_st(int k, int c) { const int kk = (k & ~0xC) | ((k & 4) << 1) | ((k & 8) >> 1); return ((kk >> 3) * 4 + (c >> 5)) * 512 + ((kk & 7) * 32 + (c & 31)) * 2; }
__device__ __forceinline__ int v_rd_base(int lane) { return ((lane & 3) << 3) | (((lane >> 2) & 3) << 6) | (((lane >> 4) & 1) << 5) | (((lane >> 5) & 1) << 8); }
constexpr int v_rd_off(int d0, int ks, int half) { return d0 * 512 + ks * 4096 + half * 2048; }
template <int OFF> __device__ __forceinline__ s16x4 tr_read(int vb) {
  s16x4 r; asm volatile("ds_read_b64_tr_b16 %0, %1 offset:%2" : "=&v"(r) : "v"(vb), "i"(OFF) : "memory"); return r;
}
template <int D0> __device__ __forceinline__ void pv_one(f32x16& od, int vb, bf16x8 pa0, bf16x8 pa1, bf16x8 pa2, bf16x8 pa3) {
  const s16x4 l0 = tr_read<v_rd_off(D0, 0, 0)>(vb), h0 = tr_read<v_rd_off(D0, 0, 1)>(vb), l1 = tr_read<v_rd_off(D0, 1, 0)>(vb), h1 = tr_read<v_rd_off(D0, 1, 1)>(vb);
  const s16x4 l2 = tr_read<v_rd_off(D0, 2, 0)>(vb), h2 = tr_read<v_rd_off(D0, 2, 1)>(vb), l3 = tr_read<v_rd_off(D0, 3, 0)>(vb), h3 = tr_read<v_rd_off(D0, 3, 1)>(vb);
  asm volatile("s_waitcnt lgkmcnt(0)" ::: "memory"); SBAR();
#define PK(L, H) (bf16x8){L[0], L[1], L[2], L[3], H[0], H[1], H[2], H[3]}
  od = __builtin_amdgcn_mfma_f32_32x32x16_bf16(pa0, PK(l0, h0), od, 0, 0, 0);
  od = __builtin_amdgcn_mfma_f32_32x32x16_bf16(pa1, PK(l1, h1), od, 0, 0, 0);
  od = __builtin_amdgcn_mfma_f32_32x32x16_bf16(pa2, PK(l2, h2), od, 0, 0, 0);
  od = __builtin_amdgcn_mfma_f32_32x32x16_bf16(pa3, PK(l3, h3), od, 0, 0, 0);
#undef PK
}
__device__ __forceinline__ void pv_d0(f32x16* o, int vb, bf16x8 pa0, bf16x8 pa1, bf16x8 pa2, bf16x8 pa3) {
  pv_one<0>(o[0], vb, pa0, pa1, pa2, pa3); pv_one<1>(o[1], vb, pa0, pa1, pa2, pa3); pv_one<2>(o[2], vb, pa0, pa1, pa2, pa3); pv_one<3>(o[3], vb, pa0, pa1, pa2, pa3);
}

template <typename TQ>
__device__ __forceinline__ void attn_dense_body(const TQ* __restrict__ Qb, const bf16* __restrict__ Kh, const bf16* __restrict__ Vh,
                                                float* __restrict__ Ob, int seq, char* lds, int mode, float lam, unsigned short* o1buf) {
  using St = Stage<bf16>; using SQ = Stage<TQ>;
  const int tid = tidx(), wid = tid >> 6, lane = tid & 63, r32 = lane & 31, hi = lane >> 5;
  bf16* V_lds = (bf16*)lds; bf16* K_lds = (bf16*)(lds + 2 * SHM_V);
  float* ws = (float*)(lds + 2 * SHM_V + 2 * SHM_K) + wid * 64; float* li_l = ws; float* al_l = ws + 32;
  float m_reg = -1e30f, l_reg = 0; f32x16 o[4] = {}; bf16x8 qr[8];
  const TQ* Qw = Qb + (long)(wid * QBLK + r32) * LDQ + hi * 8;
#pragma unroll
  for (int d0 = 0; d0 < 8; ++d0) qr[d0] = SQ::tobf(SQ::ld8(Qw + d0 * 16));
  const int sr = tid >> 4, sc = (tid & 15) * 8, vst0 = v_st(sr, sc), vst1 = v_st(32 + sr, sc);
  const int vb0 = (int)(uintptr_t)V_lds + v_rd_base(lane);
  struct { typename St::T vs0, vs1, ks0, ks1; } sr_[SDEPTH];
#define SLOAD(i, k0) do { sr_[i].vs0 = St::ld8(&Vh[(long)((k0) + sr) * LDK + sc]); sr_[i].vs1 = St::ld8(&Vh[(long)((k0) + 32 + sr) * LDK + sc]); \
    sr_[i].ks0 = St::ld8(&Kh[(long)((k0) + sr) * LDK + sc]); sr_[i].ks1 = St::ld8(&Kh[(long)((k0) + 32 + sr) * LDK + sc]); } while (0)
#define SWRITE(b, i) do { *(bf16x8*)((char*)V_lds + (b) * SHM_V + vst0) = St::tobf(sr_[i].vs0);          \
    *(bf16x8*)((char*)V_lds + (b) * SHM_V + vst1) = St::tobf(sr_[i].vs1); int kc = sc * 2;               \
    *(bf16x8*)((char*)K_lds + (b) * SHM_K + KSWZ(sr, kc)) = St::tobf(sr_[i].ks0);                       \
    *(bf16x8*)((char*)K_lds + (b) * SHM_K + KSWZ(32 + sr, kc)) = St::tobf(sr_[i].ks1); } while (0)
#define SWAIT() do { if constexpr (SDEPTH == 2) asm volatile("s_waitcnt vmcnt(4)" ::: "memory"); else asm volatile("s_waitcnt vmcnt(0)" ::: "memory"); } while (0)
#define RESC(a) do { if (__any((a) < 1.f)) { if (hi == 0) al_l[r32] = (a); asm volatile("s_waitcnt lgkmcnt(0)" ::: "memory"); \
    for (int d = 0; d < 4; ++d) for (int r = 0; r < 16; ++r) o[d][r] *= al_l[crow(r, hi)]; } } while (0)
  f32x16 pA0, pA1, pB0, pB1; float mnA, mnB, alA, alB; bf16x8 pa0, pa1, pa2, pa3; const int NT = seq / KVBLK;
  constexpr int SE = 0, SO = SDEPTH - 1;
  SLOAD(SE, 0); asm volatile("s_waitcnt vmcnt(0)" ::: "memory"); SWRITE(0, SE); __syncthreads();
  qkt(pA0, pA1, K_lds, qr, r32, hi); partialSM(pA0, pA1, m_reg, mnA, alA);
  SLOAD(SO, KVBLK); if constexpr (SDEPTH == 2) { if (2 < NT) SLOAD(SE, 2 * KVBLK); }
  SWAIT(); SWRITE(1, SO); __syncthreads();
  for (int j = 1; j + 1 < NT; j += 2) {
    SBAR(); qkt(pB0, pB1, (bf16*)((char*)K_lds + SHM_K), qr, r32, hi);
    finishSM(pA0, pA1, alA, l_reg, pa0, pa1, pa2, pa3); SBAR();
    SLOAD(SO, (j + SDEPTH) * KVBLK); SBAR();
    pv_d0(o, vb0, pa0, pa1, pa2, pa3); partialSM(pB0, pB1, m_reg, mnB, alB);
    __syncthreads(); SWAIT(); SWRITE(0, SE);
    RESC(alB); __syncthreads();
    SBAR(); qkt(pA0, pA1, K_lds, qr, r32, hi);
    finishSM(pB0, pB1, alB, l_reg, pa0, pa1, pa2, pa3); SBAR();
    if (SDEPTH == 1 || j + 3 < NT) SLOAD(SE, (j + 1 + SDEPTH) * KVBLK); SBAR();
    pv_d0(o, vb0 + (int)SHM_V, pa0, pa1, pa2, pa3); partialSM(pA0, pA1, m_reg, mnA, alA);
    __syncthreads(); SWAIT(); SWRITE(1, SO);
    RESC(alA); __syncthreads();
  }
  SBAR(); qkt(pB0, pB1, (bf16*)((char*)K_lds + SHM_K), qr, r32, hi);
  finishSM(pA0, pA1, alA, l_reg, pa0, pa1, pa2, pa3); SBAR();
  pv_d0(o, vb0, pa0, pa1, pa2, pa3); partialSM(pB0, pB1, m_reg, mnB, alB);
  __syncthreads(); RESC(alB);
  finishSM(pB0, pB1, alB, l_reg, pa0, pa1, pa2, pa3); SBAR();
  pv_d0(o, vb0 + (int)SHM_V, pa0, pa1, pa2, pa3);
  if (hi == 0) li_l[r32] = l_reg; asm volatile("s_waitcnt lgkmcnt(0)" ::: "memory");
  float rli[16];
#pragma unroll
  for (int r = 0; r < 16; ++r) rli[r] = __builtin_amdgcn_rcpf(li_l[crow(r, hi)]);
  float* Ow = Ob + (long)(wid * QBLK) * LDO;
#pragma unroll
  for (int r = 0; r < 16; ++r) { int orow = crow(r, hi);
    for (int d0 = 0; d0 < 4; ++d0) { const float val = o[d0][r] * rli[r]; unsigned short* lp = o1buf + (wid * QBLK + orow) * 128 + d0 * 32 + r32;
      if (mode == 0) { *lp = (unsigned short)(cvtpk(val, val) & 0xffffu); } else { Ow[(long)orow * LDO + d0 * 32 + r32] = __uint_as_float(((unsigned)*lp) << 16) - lam * val; } } }
#undef SLOAD
#undef SWRITE
#undef SWAIT
#undef RESC
}

#undef KSWZ
#undef SBAR
}
#ifndef MK_NO_HELPER
#define MK_NO_HELPER 0
#endif
namespace mk {
using pg8::bf16_t; using pg8::f32x4; using pg8::u32x4; using pg8::cvt_pk_bf16; using pg8::Unit;
typedef unsigned u32x2 __attribute__((ext_vector_type(2)));
typedef float f32x2 __attribute__((ext_vector_type(2)));
constexpr int T = 16384, DM = 2048, FF = 5632, SEQ = 4096;
constexpr int NIN_REAL = 6176, NIN = 6400, NQKV = 6144;
constexpr int LDS_BYTES = 155648;
constexpr float EPS = 1e-6f;
constexpr float LAMBDA_INIT = 0.35550906759096924f;
#ifdef MK_DUP_PH
constexpr int NPHASE = 20;
#else
constexpr int NPHASE = 19;
#endif

constexpr size_t SZ_SMALL = (size_t)T * 32 * 4;
constexpr size_t SZ_GU = (size_t)2 * FF * DM * 2, SZ_D = (size_t)DM * FF * 2;
constexpr size_t WS_ROPE = 0, WS_BA = WS_ROPE + SZ_SMALL, WS_BG = WS_BA + SZ_SMALL;
constexpr size_t WS_SS = WS_BG + SZ_SMALL;
constexpr size_t WS_WGU = WS_SS + (size_t)1024 * 1024, WS_WD = WS_WGU + 4 * SZ_GU;
typedef unsigned long long u64;
constexpr size_t WS_BAR = WS_SS + (size_t)960 * 1024;
constexpr float SSQ = 1048576.f, SSQ_INV = 1.f / 1048576.f;
constexpr size_t WS_WIN = WS_WD + 4 * SZ_D, WS_WOUT = WS_WIN + (size_t)NIN * DM * 2;
constexpr size_t WS_WQKV = WS_WOUT + (size_t)DM * DM * 2, WS_WO = WS_WQKV + (size_t)NQKV * DM * 2;
constexpr size_t WS_XN = WS_WO + (size_t)DM * DM * 2;
constexpr size_t WS_H = WS_XN + (size_t)T * DM * 2;
constexpr size_t WS_S = WS_H + (size_t)T * NIN * 2;
constexpr size_t SZ_T1K = (size_t)T * 1024 * 2;
constexpr size_t WS_END = WS_S + 5 * SZ_T1K;

struct Args { const float* in[29]; float* out; unsigned char* ws; int ph_lo, ph_hi; };
typedef const __attribute__((address_space(4))) Args* AP;

__device__ __forceinline__ float bflo(unsigned w) { return __uint_as_float(w << 16); }
__device__ __forceinline__ float bfhi(unsigned w) { return __uint_as_float(w & 0xffff0000u); }
__device__ __forceinline__ float sigm(float x) { return __builtin_amdgcn_rcpf(1.f + __expf(-x)); }
__device__ __forceinline__ float silu(float x) { return x * sigm(x); }
__device__ __forceinline__ float wave_sum(float v) {
#pragma unroll
  for (int m = 32; m >= 1; m >>= 1) v += __shfl_xor(v, m, 64);
  return v;
}

template <int CTRL> __device__ __forceinline__ float dpp_mov(float v) { return __int_as_float(__builtin_amdgcn_update_dpp(0, __float_as_int(v), CTRL, 0xF, 0xF, true)); }
__device__ __forceinline__ float row_sum8(float v) { v += dpp_mov<0xB1>(v); v += dpp_mov<0x4E>(v); v += dpp_mov<0x141>(v); return v; }
__device__ __forceinline__ float row_sum16(float v) { v += dpp_mov<0xB1>(v); v += dpp_mov<0x4E>(v); v += dpp_mov<0x141>(v); v += dpp_mov<0x140>(v); return v; }
__device__ __forceinline__ float dpp_row_bcast_sum4(float v) { float t = v + __shfl_xor(v, 16, 64); return t + __shfl_xor(t, 32, 64) - v; }
#define EPI_PIN() __builtin_amdgcn_sched_barrier(0)
struct EpiSwiglu { static constexpr bool PERM = true, AFTER_DRAIN = false; bf16_t* H; const u64* ss; int dup;
  __device__ __forceinline__ void operator()(const f32x4 (&acc)[2][2][4][2], const Unit& u, int wr, int wc, int fr, int fq) const {
    const int row0 = u.pm * 256 + wr * 64 + fr, col0 = u.pn * 128 + wc * 32 + 8 * fq;
    float rsv[2][4];
#pragma unroll
    for (int ai = 0; ai < 2; ++ai)
#pragma unroll
      for (int m = 0; m < 4; ++m) rsv[ai][m] = (float)ss[row0 + ai * 128 + m * 16] * SSQ_INV;
    EPI_PIN();
#pragma unroll
    for (int ai = 0; ai < 2; ++ai)
#pragma unroll
      for (int m = 0; m < 4; ++m) {
        const float rs = rsqrtf(rsv[ai][m] * (1.f / DM) + EPS);
        const f32x4 g0 = acc[ai][0][m][0] * rs, g1 = acc[ai][0][m][1] * rs, u0 = acc[ai][1][m][0] * rs, u1 = acc[ai][1][m][1] * rs;
        float h[8];
#pragma unroll
        for (int j = 0; j < 4; ++j) { h[j] = silu(g0[j]) * u0[j]; h[4 + j] = silu(g1[j]) * u1[j]; }
        u32x4 w; w[0] = cvt_pk_bf16(h[0], h[1]); w[1] = cvt_pk_bf16(h[2], h[3]); w[2] = cvt_pk_bf16(h[4], h[5]); w[3] = cvt_pk_bf16(h[6], h[7]);
#if MK_PROBE_NOSTORE
        if (!dup || w[0] == 0x12345678u)
#endif
        __builtin_nontemporal_store(w, (u32x4*)(H + (size_t)(row0 + ai * 128 + m * 16) * FF + col0));
      }
  }
};
struct EpiResid { static constexpr bool PERM = false, AFTER_DRAIN = false; AP a; int ph; int dup;
  __device__ __forceinline__ void operator()(const f32x4 (&acc)[2][2][4][2], const Unit& u, int wr, int wc, int fr, int fq) const {
    bf16_t* xb = (bf16_t*)(a->ws + WS_XN); const float* xin = a->in[0];
    const float scale = (ph == 7 || ph == 15) ? 1.f : 0.5f;
    const int nss = (ph == 2) ? 0 : (ph == 7) ? 1 : (ph == 9) ? 2 : (ph == 11) ? 3 : (ph == 15) ? 4 : 6;
    u64* ss = (u64*)(a->ws + WS_SS) + (size_t)nss * T;
    const int row0 = u.pm * 256 + wr * 64 + fr, col0 = u.pn * 256 + wc * 32 + 4 * fq;
#pragma unroll
    for (int ai = 0; ai < 2; ++ai) {
    u32x2 rb[4][2][2];
    if (ph != 2) {
#pragma unroll
      for (int m = 0; m < 4; ++m)
#pragma unroll
        for (int bj = 0; bj < 2; ++bj)
#pragma unroll
          for (int n = 0; n < 2; ++n) rb[m][bj][n] = *(const u32x2*)(xb + (size_t)(row0 + ai * 128 + m * 16) * DM + col0 + bj * 128 + n * 16);
    }
    EPI_PIN();
#pragma unroll
    for (int mh = 0; mh < 2; ++mh) {
      f32x4 r[2][2][2];
      if (ph == 2) {
#pragma unroll
        for (int m2 = 0; m2 < 2; ++m2)
#pragma unroll
          for (int bj = 0; bj < 2; ++bj)
#pragma unroll
            for (int n = 0; n < 2; ++n) r[m2][bj][n] = *(const f32x4*)(xin + (size_t)(row0 + ai * 128 + (mh * 2 + m2) * 16) * DM + col0 + bj * 128 + n * 16);
      } else {
#pragma unroll
        for (int m2 = 0; m2 < 2; ++m2)
#pragma unroll
          for (int bj = 0; bj < 2; ++bj)
#pragma unroll
            for (int n = 0; n < 2; ++n) { const u32x2 q = rb[mh * 2 + m2][bj][n]; r[m2][bj][n] = (f32x4){bflo(q[0]), bfhi(q[0]), bflo(q[1]), bfhi(q[1])}; }
      }
      EPI_PIN();
#pragma unroll
      for (int m2 = 0; m2 < 2; ++m2) {
        const int m = mh * 2 + m2;
        const size_t off = (size_t)(row0 + ai * 128 + m * 16) * DM + col0; float sq = 0.f;
#pragma unroll
        for (int bj = 0; bj < 2; ++bj)
#pragma unroll
          for (int n = 0; n < 2; ++n) { const f32x4 rr = r[m2][bj][n] + acc[ai][bj][m][n] * scale;
            u32x2 w; w[0] = cvt_pk_bf16(rr[0], rr[1]); w[1] = cvt_pk_bf16(rr[2], rr[3]); *(u32x2*)(xb + off + bj * 128 + n * 16) = w;
            const float y0 = bflo(w[0]), y1 = bfhi(w[0]), y2 = bflo(w[1]), y3 = bfhi(w[1]); sq += y0 * y0 + y1 * y1 + y2 * y2 + y3 * y3; }
        sq += dpp_row_bcast_sum4(sq); if (fq == 0) atomicAdd(ss + row0 + ai * 128 + m * 16, (u64)(sq * SSQ + 0.5f));
      }
      EPI_PIN();
    }
    }
  }
};
struct EpiP { static constexpr bool PERM = true, AFTER_DRAIN = false; bf16_t* P; float* BA; const u64* ss;
  __device__ __forceinline__ void operator()(const f32x4 (&acc)[2][2][4][2], const Unit& u, int wr, int wc, int fr, int fq) const {
    const int row0 = u.pm * 256 + wr * 64 + fr, col0 = u.pn * 256 + wc * 32 + 8 * fq;
    float rsv[2][4];
#pragma unroll
    for (int ai = 0; ai < 2; ++ai)
#pragma unroll
      for (int m = 0; m < 4; ++m) rsv[ai][m] = (float)ss[row0 + ai * 128 + m * 16] * SSQ_INV;
    EPI_PIN();
#pragma unroll
    for (int ai = 0; ai < 2; ++ai)
#pragma unroll
      for (int m = 0; m < 4; ++m) {
        const int row = row0 + ai * 128 + m * 16;
        const float rs = rsqrtf(rsv[ai][m] * (1.f / DM) + EPS);
#pragma unroll
        for (int bj = 0; bj < 2; ++bj) {
          const f32x4 a0 = acc[ai][bj][m][0] * rs, a1 = acc[ai][bj][m][1] * rs;
          u32x4 w; w[0] = cvt_pk_bf16(a0[0], a0[1]); w[1] = cvt_pk_bf16(a0[2], a0[3]); w[2] = cvt_pk_bf16(a1[0], a1[1]); w[3] = cvt_pk_bf16(a1[2], a1[3]);
          *(u32x4*)(P + (size_t)row * NIN + col0 + bj * 128) = w;
        }
        if (u.pn == 24 && wc == 0) { *(f32x4*)(BA + (size_t)row * 32 + 8 * fq) = acc[ai][0][m][0] * rs; *(f32x4*)(BA + (size_t)row * 32 + 8 * fq + 4) = acc[ai][0][m][1] * rs; }
      }
  }
};
struct EpiQKV { static constexpr bool PERM = false, AFTER_DRAIN = false; bf16_t* O; const float* rope; const u64* ss;
  __device__ __forceinline__ void operator()(const f32x4 (&acc)[2][2][4][2], const Unit& u, int wr, int wc, int fr, int fq) const {
    const int row0 = u.pm * 256 + wr * 64 + fr, col0 = u.pn * 256 + wc * 32 + 4 * fq;
    const bool rot = (wc == 0) && (u.pn < 16);
    float rsv[2][4];
#pragma unroll
    for (int ai = 0; ai < 2; ++ai)
#pragma unroll
      for (int m = 0; m < 4; ++m) rsv[ai][m] = (float)ss[row0 + ai * 128 + m * 16] * SSQ_INV;
#pragma unroll
    for (int ai = 0; ai < 2; ++ai) {
      f32x4 cv[4], sv[4];
#pragma unroll
      for (int m = 0; m < 4; ++m) { const size_t ro = (size_t)(row0 + ai * 128 + m * 16) * 32 + 4 * fq;
        cv[m] = rot ? *(const f32x4*)(rope + ro) : (f32x4){1.f, 1.f, 1.f, 1.f}; sv[m] = rot ? *(const f32x4*)(rope + ro + 16) : (f32x4){0.f, 0.f, 0.f, 0.f}; }
      EPI_PIN();
#pragma unroll
      for (int m = 0; m < 4; ++m) {
        const int row = row0 + ai * 128 + m * 16;
        const float rs = rsqrtf(rsv[ai][m] * (1.f / DM) + EPS);
#pragma unroll
        for (int bj = 0; bj < 2; ++bj) {
          f32x4 v0 = acc[ai][bj][m][0] * rs, v1 = acc[ai][bj][m][1] * rs;
          const f32x4 n0 = v0 * cv[m] - v1 * sv[m], n1 = v1 * cv[m] + v0 * sv[m];
          u32x2 w0, w1; w0[0] = cvt_pk_bf16(n0[0], n0[1]); w0[1] = cvt_pk_bf16(n0[2], n0[3]); w1[0] = cvt_pk_bf16(n1[0], n1[1]); w1[1] = cvt_pk_bf16(n1[2], n1[3]);
          bf16_t* p = O + (size_t)row * NQKV + col0 + bj * 128;
          *(u32x2*)p = w0; *(u32x2*)(p + 16) = w1;
        }
      }
      EPI_PIN();
    }
  }
};

__device__ __forceinline__ void xpose_mat(const float* __restrict__ W, int K, int N, bf16_t* __restrict__ Wt, int mode, float* tile, const float* __restrict__ gk = nullptr) {
  (void)tile;
  const int lane = tidx() & 63, wid = tidx() >> 6;
  const int nkt = K / 64, ntiles = nkt * (N / 32);
  for (int t = blockIdx.x * 8 + wid; t < ntiles; t += gridDim.x * 8) {
    const int nt = t / nkt, kt = t - nt * nkt, n = nt * 32 + (lane & 31), kb = kt * 64 + (lane >> 5) * 32;
    const float* src = W + (size_t)kb * N + n;
    float v[32];
#pragma unroll
    for (int i = 0; i < 32; ++i) v[i] = src[(size_t)i * N];
    int nd = n; if (mode == 1) nd = (n >> 7) * 256 + (n & 127); else if (mode == 2) nd = (n >> 7) * 256 + 128 + (n & 127);
#pragma unroll
    for (int q = 0; q < 4; ++q) {
      f32x4 g0 = {1.f, 1.f, 1.f, 1.f}, g1 = g0;
      if (gk) { g0 = *(const f32x4*)(gk + kb + 8 * q); g1 = *(const f32x4*)(gk + kb + 8 * q + 4); }
      u32x4 w; w[0] = cvt_pk_bf16(v[8 * q] * g0[0], v[8 * q + 1] * g0[1]); w[1] = cvt_pk_bf16(v[8 * q + 2] * g0[2], v[8 * q + 3] * g0[3]);
      w[2] = cvt_pk_bf16(v[8 * q + 4] * g1[0], v[8 * q + 5] * g1[1]); w[3] = cvt_pk_bf16(v[8 * q + 6] * g1[2], v[8 * q + 7] * g1[3]);
      *(u32x4*)(Wt + (size_t)nd * K + kb + 8 * q) = w;
    }
  }
}

constexpr int HT_FFN = (DM / 64) * (FF / 32);
constexpr int HT_SQ = (DM / 64) * (DM / 32), HT_QKV = (DM / 64) * (NQKV / 32);
#if MK_NO_HELPER
constexpr int HT_TOTAL = 0;
#else
constexpr int HT_TOTAL = 9 * HT_FFN + 2 * HT_SQ + HT_QKV;
#endif
struct HTile { const float* W; bf16_t* Wt; int gi; int K, N, mode, k0, n0; };
__device__ __forceinline__ HTile helper_decode(AP a, int id) {
  HTile t; t.mode = 0; t.gi = -1; int lt; unsigned char* ws = a->ws;
  if (id < 9 * HT_FFN) {
    const int mi = id / HT_FFN; lt = id - mi * HT_FFN; const int f = 1 + mi / 3, which = mi - (mi / 3) * 3, layer = f >> 1, second = f & 1;
    if (which == 2) { t.W = a->in[second ? 10 : 5] + (size_t)layer * DM * FF; t.K = FF; t.N = DM; t.Wt = (bf16_t*)(ws + WS_WD + (size_t)f * SZ_D); }
    else { t.W = a->in[which ? (second ? 9 : 4) : (second ? 8 : 3)] + (size_t)layer * DM * FF; t.K = DM; t.N = FF; t.Wt = (bf16_t*)(ws + WS_WGU + (size_t)f * SZ_GU); t.mode = 1 + which; t.gi = f - 1; }
  } else if (id < 9 * HT_FFN + HT_SQ) { lt = id - 9 * HT_FFN; t.W = a->in[20]; t.K = DM; t.N = DM; t.Wt = (bf16_t*)(ws + WS_WOUT); }
  else if (id < 9 * HT_FFN + HT_SQ + HT_QKV) { lt = id - 9 * HT_FFN - HT_SQ; t.W = a->in[21]; t.K = DM; t.N = NQKV; t.Wt = (bf16_t*)(ws + WS_WQKV); t.gi = 3; }
  else { lt = id - 9 * HT_FFN - HT_SQ - HT_QKV; t.W = a->in[27]; t.K = DM; t.N = DM; t.Wt = (bf16_t*)(ws + WS_WO); }
  const int nkt = t.K / 64, nt = lt / nkt, kt = lt - nt * nkt; t.k0 = kt * 64; t.n0 = nt * 32;
  return t;
}
__device__ __forceinline__ void helper_issue(AP a, int id, float (&v)[32], int lane) {
  const HTile t = helper_decode(a, id);
  const float* src = t.W + (size_t)(t.k0 + (lane >> 5) * 32) * t.N + t.n0 + (lane & 31);
#pragma unroll
  for (int i = 0; i < 32; ++i) v[i] = src[(size_t)i * t.N];
}
__device__ __forceinline__ void helper_finish(AP a, int id, const float (&v)[32], float* wtile, const float* gains, int lane) {
  const HTile t = helper_decode(a, id); (void)wtile;
  const int n = t.n0 + (lane & 31), kb = t.k0 + (lane >> 5) * 32;
  int nd = n; if (t.mode == 1) nd = (n >> 7) * 256 + (n & 127); else if (t.mode == 2) nd = (n >> 7) * 256 + 128 + (n & 127);
#pragma unroll
  for (int q = 0; q < 4; ++q) {
    f32x4 g0 = {1.f, 1.f, 1.f, 1.f}, g1 = g0;
    if (t.gi >= 0) { const float* gp = gains + t.gi * DM + kb + 8 * q; g0 = *(const f32x4*)gp; g1 = *(const f32x4*)(gp + 4); }
    u32x4 w; w[0] = cvt_pk_bf16(v[8 * q] * g0[0], v[8 * q + 1] * g0[1]); w[1] = cvt_pk_bf16(v[8 * q + 2] * g0[2], v[8 * q + 3] * g0[3]);
    w[2] = cvt_pk_bf16(v[8 * q + 4] * g1[0], v[8 * q + 5] * g1[1]); w[3] = cvt_pk_bf16(v[8 * q + 6] * g1[2], v[8 * q + 7] * g1[3]);
    *(u32x4*)(t.Wt + (size_t)nd * t.K + kb + 8 * q) = w;
  }
}

__device__ __forceinline__ void cast_phase(const float* __restrict__ X, bf16_t* __restrict__ XB, u64* __restrict__ ss) {
  const int lane = tidx() & 63, wid = tidx() >> 6;
  for (int row = blockIdx.x * 8 + wid; row < T; row += gridDim.x * 8) {
    const float* xr = X + (size_t)row * DM;
    f32x4 v[8]; float sq = 0.f;
#pragma unroll
    for (int i = 0; i < 8; ++i) v[i] = *(const f32x4*)(xr + (i * 64 + lane) * 4);
#pragma unroll
    for (int i = 0; i < 8; ++i) { u32x2 w; w[0] = cvt_pk_bf16(v[i][0], v[i][1]); w[1] = cvt_pk_bf16(v[i][2], v[i][3]); *(u32x2*)(XB + (size_t)row * DM + (i * 64 + lane) * 4) = w;
      const float y0 = bflo(w[0]), y1 = bfhi(w[0]), y2 = bflo(w[1]), y3 = bfhi(w[1]); sq += y0 * y0 + y1 * y1 + y2 * y2 + y3 * y3; }
    sq = wave_sum(sq);
    if (lane == 0) ss[row] = (u64)(sq * SSQ + 0.5f);
  }
}
__device__ __forceinline__ void final_phase(const bf16_t* __restrict__ XB, const u64* __restrict__ ss, const float* __restrict__ g, float* __restrict__ out) {
  const int lane = tidx() & 63, wid = tidx() >> 6;
  for (int row = blockIdx.x * 8 + wid; row < T; row += gridDim.x * 8) {
    const float rstd = rsqrtf((float)ss[row] * SSQ_INV * (1.f / DM) + EPS);
    u32x4 xv[4];
#pragma unroll
    for (int i = 0; i < 4; ++i) xv[i] = *(const u32x4*)(XB + (size_t)row * DM + (i * 64 + lane) * 8);
#pragma unroll
    for (int i = 0; i < 4; ++i) { const int c = (i * 64 + lane) * 8; const f32x4 g0 = *(const f32x4*)(g + c), g1 = *(const f32x4*)(g + c + 4);
      const f32x4 y0 = (f32x4){bflo(xv[i][0]), bfhi(xv[i][0]), bflo(xv[i][1]), bfhi(xv[i][1])} * rstd * g0, y1 = (f32x4){bflo(xv[i][2]), bfhi(xv[i][2]), bflo(xv[i][3]), bfhi(xv[i][3])} * rstd * g1;
      *(f32x4*)(out + (size_t)row * DM + c) = y0; *(f32x4*)(out + (size_t)row * DM + c + 4) = y1; }
  }
}

__device__ __forceinline__ void prologue(AP a, unsigned char* lds) {
  unsigned char* ws = a->ws;
  float* tile = (float*)lds;
  for (int f = 0; f < (MK_NO_HELPER ? 4 : 1); ++f) {
    const int layer = f >> 1, which = f & 1;
    const float* wg = a->in[which ? 8 : 3] + (size_t)layer * DM * FF; const float* wu = a->in[which ? 9 : 4] + (size_t)layer * DM * FF; const float* wd = a->in[which ? 10 : 5] + (size_t)layer * DM * FF;
    const float* gn = a->in[which ? 7 : 2] + (size_t)layer * DM;
    xpose_mat(wg, DM, FF, (bf16_t*)(ws + WS_WGU + f * SZ_GU), 1, tile, gn);
    xpose_mat(wu, DM, FF, (bf16_t*)(ws + WS_WGU + f * SZ_GU), 2, tile, gn);
    xpose_mat(wd, FF, DM, (bf16_t*)(ws + WS_WD + f * SZ_D), 0, tile);
  }
  xpose_mat(a->in[11], DM, NIN_REAL, (bf16_t*)(ws + WS_WIN), 0, tile, a->in[6]);
#if MK_NO_HELPER
  xpose_mat(a->in[20], DM, DM, (bf16_t*)(ws + WS_WOUT), 0, tile);
  xpose_mat(a->in[21], DM, NQKV, (bf16_t*)(ws + WS_WQKV), 0, tile, a->in[6] + DM);
  xpose_mat(a->in[27], DM, DM, (bf16_t*)(ws + WS_WO), 0, tile);
#endif
  const size_t gtid = (size_t)blockIdx.x * 512 + tidx(), gn = (size_t)gridDim.x * 512;
  { u32x4* p = (u32x4*)(ws + WS_WIN + (size_t)NIN_REAL * DM * 2); const size_t n16 = (size_t)(NIN - NIN_REAL) * DM * 2 / 16; unsigned zz = 0u; asm volatile("" : "+v"(zz)); const u32x4 z = {zz, zz, zz, zz};
    for (size_t i = gtid; i < n16; i += gn) p[i] = z; }
  { u64* ssz = (u64*)(ws + WS_SS); unsigned zq = 0u; asm volatile("" : "+v"(zq)); const u64 z64 = ((u64)zq << 32) | zq;
    for (size_t i = gtid; i < (size_t)6 * T; i += gn) ssz[i < (size_t)5 * T ? i : i + T] = z64; }
  { float* rope = (float*)(ws + WS_ROPE); const int* pos = (const int*)a->in[1];
    for (size_t i = gtid; i < (size_t)T * 16; i += gn) {
      const int tok = (int)(i >> 4), j = (int)(i & 15);
      const float inv = exp2f(-(float)j * (18.931568569324174f / 16.f));
      double rev = (double)pos[tok] * (double)inv * 0.15915494309189535; rev -= floor(rev);
      const float fr = (float)rev;
      rope[(size_t)tok * 32 + j] = __builtin_amdgcn_cosf(fr); rope[(size_t)tok * 32 + 16 + j] = __builtin_amdgcn_sinf(fr);
    } }
  cast_phase(a->in[0], (bf16_t*)(ws + WS_XN), (u64*)(ws + WS_SS) + (size_t)5 * T);
}

__device__ __forceinline__ void conv_module(AP a, unsigned char* lds) {
  const bf16_t* P = (const bf16_t*)(a->ws + WS_H); bf16_t* CAT = (bf16_t*)(a->ws + WS_S);
  unsigned* glu = (unsigned*)lds; float* part = (float*)(lds + 62 * 512 * 4); float* stats = part + 512;
  const int tid = tidx(), lane = tid & 63, wid = tid >> 6, c0 = 2 * tid;
  const float* cw = a->in[12];
  float w0[31], w1[31];
#pragma unroll
  for (int j = 0; j < 31; ++j) { const f32x2 t = *(const f32x2*)(cw + j * 1024 + c0); w0[j] = t[0]; w1[j] = t[1]; }
  const f32x2 cb = *(const f32x2*)(a->in[13] + c0), lg = *(const f32x2*)(a->in[14] + c0), lb = *(const f32x2*)(a->in[15] + c0);
  for (int tile = blockIdx.x; tile < T / 32; tile += gridDim.x) {
    const int tok0 = tile * 32, s0 = tok0 & (SEQ - 1);
    for (int r0 = 0; r0 < 64; r0 += 8) {
      unsigned pv[8], pg[8];
#pragma unroll
      for (int i = 0; i < 8; ++i) { const int r = r0 + i, s = s0 - 15 + r; const bool ok = (r < 62) && s >= 0 && s < SEQ;
        const bf16_t* pr = P + (size_t)(ok ? tok0 - 15 + r : tok0) * NIN + c0; pv[i] = *(const unsigned*)pr; pg[i] = *(const unsigned*)(pr + 1024); }
#pragma unroll
      for (int i = 0; i < 8; ++i) { const int r = r0 + i, s = s0 - 15 + r; const bool ok = s >= 0 && s < SEQ;
        const unsigned val = ok ? cvt_pk_bf16(bflo(pv[i]) * sigm(bflo(pg[i])), bfhi(pv[i]) * sigm(bfhi(pg[i]))) : 0u;
        if (r < 62) glu[r * 512 + tid] = val; }
    }
#pragma unroll 1
    for (int tt = 0; tt < 32; ++tt) {
      float o0 = cb[0], o1 = cb[1];
#pragma unroll
      for (int j = 0; j < 31; ++j) { const unsigned u = glu[(tt + j) * 512 + tid]; o0 += w0[j] * bflo(u); o1 += w1[j] * bfhi(u); }
      const float s = wave_sum(o0 + o1), q = wave_sum(o0 * o0 + o1 * o1);
      if (lane == 0) { part[(wid * 32 + tt) * 2] = s; part[(wid * 32 + tt) * 2 + 1] = q; }
    }
    __syncthreads();
    if (tid < 32) { float s = 0.f, q = 0.f;
      for (int w = 0; w < 8; ++w) { s += part[(w * 32 + tid) * 2]; q += part[(w * 32 + tid) * 2 + 1]; }
      const float mean = s * (1.f / 1024.f), var = fmaxf(q * (1.f / 1024.f) - mean * mean, 0.f);
      stats[tid * 2] = mean; stats[tid * 2 + 1] = rsqrtf(var + EPS); }
    __syncthreads();
#pragma unroll 1
    for (int tt = 0; tt < 32; ++tt) {
      float o0 = cb[0], o1 = cb[1];
#pragma unroll
      for (int j = 0; j < 31; ++j) { const unsigned u = glu[(tt + j) * 512 + tid]; o0 += w0[j] * bflo(u); o1 += w1[j] * bfhi(u); }
      const float mean = stats[tt * 2], rstd = stats[tt * 2 + 1];
      const float y0 = (o0 - mean) * rstd * lg[0] + lb[0], y1 = (o1 - mean) * rstd * lg[1] + lb[1];
      *(unsigned*)(CAT + (size_t)(tok0 + tt) * DM + c0) = cvt_pk_bf16(silu(y0), silu(y1));
    }
    __syncthreads();
  }
}

__device__ __forceinline__ void dn_prep(AP a) {
  const bf16_t* P = (const bf16_t*)(a->ws + WS_H);
  bf16_t* QN = (bf16_t*)(a->ws + WS_S); bf16_t* KN = (bf16_t*)(a->ws + WS_S + SZ_T1K); bf16_t* VS = (bf16_t*)(a->ws + WS_S + 2 * SZ_T1K);
  const float* sw = a->in[16];
  const int lane = tidx() & 63, wid = tidx() >> 6;
  for (int tok = blockIdx.x * 8 + wid; tok < T; tok += gridDim.x * 8) {
    const int s = tok & (SEQ - 1);
#pragma unroll 1
    for (int sb = 0; sb < 24; sb += 4) {
      unsigned x0[4], xm[4], xp[4]; f32x2 wa[4], wb[4], wc[4];
#pragma unroll
      for (int i = 0; i < 4; ++i) { const int c = (sb + i) * 128 + 2 * lane; const bf16_t* pr = P + (size_t)tok * NIN + 2048 + c;
        x0[i] = *(const unsigned*)pr; xm[i] = *(const unsigned*)(pr - (s > 0 ? NIN : 0)); xp[i] = *(const unsigned*)(pr + (s < SEQ - 1 ? NIN : 0));
        wa[i] = *(const f32x2*)(sw + c); wb[i] = *(const f32x2*)(sw + 3072 + c); wc[i] = *(const f32x2*)(sw + 6144 + c); }
#pragma unroll
      for (int i = 0; i < 4; ++i) { const int slot = sb + i;
        const unsigned um = (s > 0) ? xm[i] : 0u, up = (s < SEQ - 1) ? xp[i] : 0u;
        float y0 = wa[i][0] * bflo(um) + wb[i][0] * bflo(x0[i]) + wc[i][0] * bflo(up), y1 = wa[i][1] * bfhi(um) + wb[i][1] * bfhi(x0[i]) + wc[i][1] * bfhi(up);
        y0 = silu(y0); y1 = silu(y1);
        if (slot < 16) { const float ss = wave_sum(y0 * y0 + y1 * y1); float r = rsqrtf(ss + EPS); if (slot < 8) r *= 0.08838834764831845f; y0 *= r; y1 *= r; }
        bf16_t* dst = (slot < 8 ? QN : (slot < 16 ? KN : VS)) + (size_t)tok * 1024 + (slot & 7) * 128 + 2 * lane;
        *(unsigned*)dst = cvt_pk_bf16(y0, y1); }
    }
  }
  const float* BA = (const float*)(a->ws + WS_BA); float* BG = (float*)(a->ws + WS_BG);
  for (size_t i = (size_t)blockIdx.x * 512 + tidx(); i < (size_t)T * 16; i += (size_t)gridDim.x * 512) {
    const int tok = (int)(i >> 4), j = (int)(i & 15);
    const float braw = BA[(size_t)tok * 32 + j], araw = BA[(size_t)tok * 32 + 16 + j];
    const float xx = araw + a->in[18][j]; const float sp = xx > 20.f ? xx : log1pf(expf(xx));
    const float g = -expf(a->in[17][j]) * sp;
    BG[(size_t)tok * 32 + j] = sigm(braw); BG[(size_t)tok * 32 + 16 + j] = expf(g);
  }
}

__device__ __forceinline__ void scan_phase(AP a, unsigned char* lds) {
  const bf16_t* QN = (const bf16_t*)(a->ws + WS_S); const bf16_t* KN = (const bf16_t*)(a->ws + WS_S + SZ_T1K); const bf16_t* VS = (const bf16_t*)(a->ws + WS_S + 2 * SZ_T1K);
  const float* BG = (const float*)(a->ws + WS_BG);
  constexpr int BUF_F = 32 * 128 * 2 + 32 * 32 + 64;
  float* sb = (float*)lds; float* ob = sb + 2 * BUF_F;
  float* dump = ob + 2048 + (tidx() & 255);
  float* wtile = (float*)(lds + 86016) + ((tidx() >> 6) & 3) * (64 * 33);
  int hid = (int)blockIdx.x * 4 + ((tidx() >> 6) & 3); const int hstep = (int)gridDim.x * 4;
  float* gains = (float*)(lds + 119808);
  for (int i = tidx(); i < 4 * DM; i += 512) { const int v = i >> 11, k = i & (DM - 1); gains[i] = (v == 0) ? a->in[7][k] : (v == 1) ? a->in[2][DM + k] : (v == 2) ? a->in[7][DM + k] : a->in[6][DM + k]; }
  __syncthreads();
  int hprev = -1; float hv[32];
#pragma unroll
  for (int i = 0; i < 32; ++i) hv[i] = 0.f;
  const int tid = tidx(), lane = tid & 63, wid = tid >> 6, j = lane & 7, col = (wid & 3) * 8 + (lane >> 3);
  const int tl = tid >> 4, c8 = (tid & 15) * 8, tlv = (tid >> 2) & 31, cv = (tid & 3) * 8;
  for (int item = blockIdx.x; item < 256; item += gridDim.x) {
    const int cb = item & 3, dir = (item >> 2) & 1, h = (item >> 3) & 7, b = item >> 6;
    bf16_t* OD = (bf16_t*)(a->ws + WS_S + (3 + dir) * SZ_T1K);
    f32x2 S2[8];
#pragma unroll
    for (int i = 0; i < 8; ++i) S2[i] = (f32x2){0.f, 0.f};
    u32x4 kr, qr, vr; float ar = 0.f, br = 0.f;
#define SC_TOK(c, t) (b * SEQ + (dir ? (SEQ - 1 - ((c) * 32 + (t))) : ((c) * 32 + (t))))
#define SC_LOAD(c) do { const size_t tk = (size_t)SC_TOK(c, tl); kr = *(const u32x4*)(KN + tk * 1024 + h * 128 + c8); qr = *(const u32x4*)(QN + tk * 1024 + h * 128 + c8); \
      if (tid < 128) vr = *(const u32x4*)(VS + (size_t)SC_TOK(c, tlv) * 1024 + h * 128 + cb * 32 + cv); \
      else if (tid < 160) { const size_t t2 = (size_t)SC_TOK(c, tid - 128); br = BG[t2 * 32 + dir * 8 + h]; ar = BG[t2 * 32 + 16 + dir * 8 + h]; } } while (0)
#define SC_WRITE(bi) do { float* kb = sb + (bi) * BUF_F; float* qb = kb + 4096; float* vb = qb + 4096; float* abp = vb + 1024; \
      *(f32x4*)(kb + tl * 128 + c8) = (f32x4){bflo(kr[0]), bfhi(kr[0]), bflo(kr[1]), bfhi(kr[1])}; *(f32x4*)(kb + tl * 128 + c8 + 4) = (f32x4){bflo(kr[2]), bfhi(kr[2]), bflo(kr[3]), bfhi(kr[3])}; \
      *(f32x4*)(qb + tl * 128 + c8) = (f32x4){bflo(qr[0]), bfhi(qr[0]), bflo(qr[1]), bfhi(qr[1])}; *(f32x4*)(qb + tl * 128 + c8 + 4) = (f32x4){bflo(qr[2]), bfhi(qr[2]), bflo(qr[3]), bfhi(qr[3])}; \
      if (tid < 128) { *(f32x4*)(vb + tlv * 32 + cv) = (f32x4){bflo(vr[0]), bfhi(vr[0]), bflo(vr[1]), bfhi(vr[1])}; *(f32x4*)(vb + tlv * 32 + cv + 4) = (f32x4){bflo(vr[2]), bfhi(vr[2]), bflo(vr[3]), bfhi(vr[3])}; } \
      else if (tid < 160) { abp[(tid - 128) * 2] = ar; abp[(tid - 128) * 2 + 1] = br; } } while (0)
#define SC_FLUSH(c) do { if (tid < 128) { const float* op = ob + ((c) & 1) * 1024 + tlv * 32 + cv; const f32x4 x0 = *(const f32x4*)op, x1 = *(const f32x4*)(op + 4); \
      u32x4 w; w[0] = cvt_pk_bf16(x0[0], x0[1]); w[1] = cvt_pk_bf16(x0[2], x0[3]); w[2] = cvt_pk_bf16(x1[0], x1[1]); w[3] = cvt_pk_bf16(x1[2], x1[3]); \
      *(u32x4*)(OD + (size_t)SC_TOK(c, tlv) * 1024 + h * 128 + cb * 32 + cv) = w; } } while (0)
    __syncthreads();
    SC_LOAD(0); SC_WRITE(0); __syncthreads();
    for (int c = 0; c < SEQ / 32; ++c) {
      if (c + 1 < SEQ / 32) SC_LOAD(c + 1);
      if (c > 0) SC_FLUSH(c - 1);
      const float* kb = sb + (c & 1) * BUF_F; const float* qb = kb + 4096; const float* vb = qb + 4096; const float* abp = vb + 1024; float* obc = ob + (c & 1) * 1024;
      if (wid < 4) {
        f32x4 kv[4], qv[4]; f32x2 ab2; float vv;
#define SC_LD(t) do { _Pragma("unroll") for (int i = 0; i < 4; ++i) { kv[i] = *(const f32x4*)(kb + (t) * 128 + 16 * j + 4 * i); qv[i] = *(const f32x4*)(qb + (t) * 128 + 16 * j + 4 * i); } \
          ab2 = *(const f32x2*)(abp + (t) * 2); vv = vb[(t) * 32 + col]; } while (0)
        SC_LD(0);
#pragma unroll 8
        for (int t = 0; t < 32; ++t) {
          f32x2 kk[8], qq[8];
#pragma unroll
          for (int i = 0; i < 4; ++i) { kk[2 * i] = (f32x2){kv[i][0], kv[i][1]}; kk[2 * i + 1] = (f32x2){kv[i][2], kv[i][3]}; qq[2 * i] = (f32x2){qv[i][0], qv[i][1]}; qq[2 * i + 1] = (f32x2){qv[i][2], qv[i][3]}; }
          const float al = ab2[0], bt = ab2[1], vc = vv;
          SC_LD((t + 1) & 31);
          f32x2 d0 = S2[0] * kk[0], d1 = S2[1] * kk[1];
#pragma unroll
          for (int i = 1; i < 4; ++i) { d0 = S2[2 * i] * kk[2 * i] + d0; d1 = S2[2 * i + 1] * kk[2 * i + 1] + d1; }
          d0 = d0 + d1;
          const float d = row_sum8(d0[0] + d0[1]);
          const float dl = bt * (vc - al * d);
          const f32x2 dl2 = {dl, dl}, al2 = {al, al};
#pragma unroll
          for (int i = 0; i < 8; ++i) S2[i] = kk[i] * dl2 + S2[i] * al2;
          f32x2 o0 = S2[0] * qq[0], o1 = S2[1] * qq[1];
#pragma unroll
          for (int i = 1; i < 4; ++i) { o0 = S2[2 * i] * qq[2 * i] + o0; o1 = S2[2 * i + 1] * qq[2 * i + 1] + o1; }
          o0 = o0 + o1;
          const float od = row_sum8(o0[0] + o0[1]);
          *((j == 0) ? (obc + t * 32 + col) : dump) = od;
        }
#undef SC_LD
      } else {
        if (hprev >= 0) helper_finish(a, hprev, hv, wtile, gains, lane);
        if (hid < HT_TOTAL) { helper_issue(a, hid, hv, lane); hprev = hid; hid += hstep; } else hprev = -1;
      }
      if (c + 1 < SEQ / 32) SC_WRITE((c + 1) & 1);
      asm volatile("s_waitcnt lgkmcnt(0)" ::: "memory"); __builtin_amdgcn_s_barrier(); asm volatile("" ::: "memory");
    }
    SC_FLUSH(SEQ / 32 - 1);
    __syncthreads();
#undef SC_TOK
#undef SC_LOAD
#undef SC_WRITE
#undef SC_FLUSH
  }
  if (wid >= 4) { if (hprev >= 0) helper_finish(a, hprev, hv, wtile, gains, lane); for (; hid < HT_TOTAL; hid += hstep) { helper_issue(a, hid, hv, lane); helper_finish(a, hid, hv, wtile, gains, lane); } }
}

__device__ __forceinline__ void gnorm_phase(AP a) {
  const bf16_t* P = (const bf16_t*)(a->ws + WS_H); bf16_t* CAT = (bf16_t*)(a->ws + WS_S);
  const bf16_t* OF = (const bf16_t*)(a->ws + WS_S + 3 * SZ_T1K); const bf16_t* OB = (const bf16_t*)(a->ws + WS_S + 4 * SZ_T1K);
  const int lane = tidx() & 63, wid = tidx() >> 6;
  const f32x2 g = *(const f32x2*)(a->in[19] + 2 * lane);
  for (int tok = blockIdx.x * 8 + wid; tok < T; tok += gridDim.x * 8) {
    unsigned uf[8], ub[8], uz[8];
#pragma unroll
    for (int h = 0; h < 8; ++h) { const size_t o = (size_t)tok * 1024 + h * 128 + 2 * lane;
      uf[h] = *(const unsigned*)(OF + o); ub[h] = *(const unsigned*)(OB + o); uz[h] = *(const unsigned*)(P + (size_t)tok * NIN + 5120 + h * 128 + 2 * lane); }
#pragma unroll
    for (int h = 0; h < 8; ++h) {
      const float o0 = bflo(uf[h]) + bflo(ub[h]), o1 = bfhi(uf[h]) + bfhi(ub[h]);
      const float ss = wave_sum(o0 * o0 + o1 * o1), rstd = rsqrtf(ss * (1.f / 128.f) + EPS);
      const float y0 = o0 * rstd * g[0] * silu(bflo(uz[h])), y1 = o1 * rstd * g[1] * silu(bfhi(uz[h]));
      *(unsigned*)(CAT + (size_t)tok * DM + 1024 + h * 128 + 2 * lane) = cvt_pk_bf16(y0, y1);
    }
  }
}

__device__ __forceinline__ void attn_phase(AP a, unsigned char* lds) {
  const bf16_t* QKV = (const bf16_t*)(a->ws + WS_H); float* OA = (float*)(a->ws + WS_S);
  const int lane = tidx() & 63;
  const float s1 = wave_sum(a->in[22][lane] * a->in[23][lane] + a->in[22][lane + 64] * a->in[23][lane + 64]);
  const float s2 = wave_sum(a->in[24][lane] * a->in[25][lane] + a->in[24][lane + 64] * a->in[25][lane + 64]);
  const float lam = __int_as_float(__builtin_amdgcn_readfirstlane(__float_as_int(expf(s1) - expf(s2) + LAMBDA_INIT)));
  int seq = SEQ; asm volatile("" : "+s"(seq));
  const int nk = (512 - (int)blockIdx.x + (int)gridDim.x - 1) / (int)gridDim.x;
#pragma unroll 1
  for (int it = 0; it < 4 * nk; ++it) {
    const int item = blockIdx.x + gridDim.x * (it >> 2), m = it & 1, vh = (it >> 1) & 1;
    const int h = item & 7, qb = (item >> 3) & 15, b = item >> 7;
    const size_t tok0 = (size_t)b * SEQ + qb * 256, kv0 = (size_t)b * SEQ;
    att::attn_dense_body<att::bf16>(QKV + tok0 * NQKV + h * 256 + m * 128, QKV + kv0 * NQKV + 2048 + h * 256 + m * 128, QKV + kv0 * NQKV + 4096 + h * 256 + vh * 128,
                                    OA + tok0 * DM + h * 256 + vh * 128, seq, (char*)lds, m, lam, (unsigned short*)(lds + 69632));
    __syncthreads();
    if ((it & 3) == 3) {
      asm volatile("s_waitcnt vmcnt(0)" ::: "memory");
      const int wv = tidx() >> 6, ln = tidx() & 63; bf16_t* CAT = (bf16_t*)a->out;
      const f32x4 sg = *(const f32x4*)(a->in[26] + 4 * ln);
#pragma unroll 4
      for (int r = 0; r < 32; ++r) {
        const size_t o = (tok0 + wv * 32 + r) * DM + h * 256 + 4 * ln;
        const f32x4 v = *(const f32x4*)(OA + o);
        const float ss = wave_sum(v[0] * v[0] + v[1] * v[1] + v[2] * v[2] + v[3] * v[3]), rr = rsqrtf(ss * (1.f / 256.f) + EPS) * (1.f - LAMBDA_INIT);
        u32x2 w; w[0] = cvt_pk_bf16(v[0] * rr * sg[0], v[1] * rr * sg[1]); w[1] = cvt_pk_bf16(v[2] * rr * sg[2], v[3] * rr * sg[3]);
        *(u32x2*)(CAT + o) = w;
      }
    }
  }
}
__device__ __forceinline__ void subln_phase(AP a) {
  const float* OA = (const float*)(a->ws + WS_S); bf16_t* CAT = (bf16_t*)(a->ws + WS_H);
  const int lane = tidx() & 63, wid = tidx() >> 6;
  const f32x4 g = *(const f32x4*)(a->in[26] + 4 * lane);
  for (int task = blockIdx.x * 8 + wid; task < T * 8; task += gridDim.x * 8) {
    const size_t o = (size_t)(task >> 3) * DM + (task & 7) * 256 + 4 * lane;
    const f32x4 v = *(const f32x4*)(OA + o);
    const float ss = wave_sum(v[0] * v[0] + v[1] * v[1] + v[2] * v[2] + v[3] * v[3]), r = rsqrtf(ss * (1.f / 256.f) + EPS) * (1.f - LAMBDA_INIT);
    u32x2 w; w[0] = cvt_pk_bf16(v[0] * r * g[0], v[1] * r * g[1]); w[1] = cvt_pk_bf16(v[2] * r * g[2], v[3] * r * g[3]);
    *(u32x2*)(CAT + o) = w;
  }
}

#define XB_TMO      128
#define XB_XCNT(j)  (256  + 64 * (j))
#define XB_XSUB(j)  (1280 + 64 * (j))
#define XB_XGEN(j)  (2304 + 64 * (j))
#define XB_TOP      3328
#define XB_TOPGEN   3392
#define XCD_BAR_WORDS 3456
#define XB_SPIN_CAP (1u << 18)
__device__ __forceinline__ unsigned xb_ld(unsigned* p)              { return __hip_atomic_load(p, __ATOMIC_RELAXED, __HIP_MEMORY_SCOPE_AGENT); }
__device__ __forceinline__ unsigned xb_add(unsigned* p, unsigned v) { return __hip_atomic_fetch_add(p, v, __ATOMIC_RELAXED, __HIP_MEMORY_SCOPE_AGENT); }
__device__ __forceinline__ unsigned xb_xcc_id() { return (unsigned)__builtin_amdgcn_s_getreg((3 << 11) | 20) & 0xFu; }
#define XB_SPIN(cond, bar) do { unsigned _sp = 0; while (cond) { __builtin_amdgcn_s_sleep(1); \
    if ((++_sp & 255u) == 0u) { if (xb_ld(&(bar)[XB_TMO])) break; if (_sp > XB_SPIN_CAP) { atomicAdd(&(bar)[XB_TMO], 1u); break; } } } } while (0)
__device__ __forceinline__ void xcd_barrier_complete(unsigned* bar, unsigned x, unsigned& nloc, unsigned& nx) {
  const unsigned G = gridDim.x;
  unsigned sum, cnt, mine, sp = 0u;
  for (;;) {
    sum = 0u; cnt = 0u; mine = 0u;
#pragma unroll 1
    for (unsigned j = 0; j < 16; ++j) { const unsigned c = xb_ld(&bar[XB_XCNT(j)]); sum += c; cnt += (c > 0u) ? 1u : 0u; mine = (j == x) ? c : mine; }
    if (sum == G) break;
    __builtin_amdgcn_s_sleep(1);
    if ((++sp & 255u) == 0u) { if (xb_ld(&bar[XB_TMO])) break; if (sp > XB_SPIN_CAP) { atomicAdd(&bar[XB_TMO], 1u); break; } }
  }
  nloc = mine > 0u ? mine : 1u; nx = cnt > 0u ? cnt : 1u;
}
__device__ __forceinline__ void xcd_barrier(unsigned* bar, volatile PG8_LAS unsigned* st) {
  asm volatile("s_waitcnt vmcnt(0)" ::: "memory");
  __syncthreads();
  if (threadIdx.x == 0) {
    const unsigned x = xb_xcc_id();
    __builtin_amdgcn_s_waitcnt(0);
    unsigned nloc = st[0], nx = st[1];
    if (nloc == 0u) { xcd_barrier_complete(bar, x, nloc, nx); st[0] = nloc; st[1] = nx; }
    const unsigned old = xb_add(&bar[XB_XSUB(x)], 1u);
    const unsigned gen = old / nloc;
    if (old + 1u == (gen + 1u) * nloc) {
      __builtin_amdgcn_fence(__ATOMIC_RELEASE, "agent");
      asm volatile("s_waitcnt vmcnt(0)" ::: "memory");
      const unsigned og = xb_add(&bar[XB_TOP], 1u);
      const unsigned tg = og / nx;
      if (og + 1u == (tg + 1u) * nx) xb_add(&bar[XB_TOPGEN], 1u);
      else XB_SPIN(xb_ld(&bar[XB_TOPGEN]) == tg, bar);
      __builtin_amdgcn_fence(__ATOMIC_ACQUIRE, "agent");
      xb_add(&bar[XB_XGEN(x)], 1u);
      asm volatile("s_waitcnt vmcnt(0)" ::: "memory");
    } else {
      XB_SPIN(xb_ld(&bar[XB_XGEN(x)]) == gen, bar);
      __builtin_amdgcn_fence(__ATOMIC_ACQUIRE, "agent");
      asm volatile("s_waitcnt vmcnt(0)" ::: "memory");
    }
  }
  __syncthreads();
}

enum { PT_PRO, PT_GU, PT_RES, PT_NORM, PT_IN, PT_CONV, PT_SCAN, PT_GNORM, PT_QKV, PT_ATTN, PT_SUBLN, PT_FINAL };

__global__ void __launch_bounds__(512, 2) mega(Args a_kernarg) {
  extern __shared__ __attribute__((aligned(16))) unsigned char lds[];
  cg::grid_group grid = cg::this_grid();
  const AP a0 = (AP)__builtin_amdgcn_kernarg_segment_ptr();
  volatile PG8_LAS unsigned* xst = (volatile PG8_LAS unsigned*)((PG8_LAS unsigned char*)lds + (LDS_BYTES - 16));
  if (threadIdx.x == 0) { xst[0] = 0u; xst[1] = 0u; (void)xb_add(&((unsigned*)(a0->ws + WS_BAR))[XB_XCNT(xb_xcc_id())], 1u); }
  __syncthreads();
  const int ph_lo = a0->ph_lo, ph_hi = a0->ph_hi;
  for (int php = ph_lo; php < ph_hi; ++php) {
    int ph = php;
#ifndef MK_DUP_PH
#define DUP2 0
#else
#define DUP2 (int)dup2
#endif
#ifdef MK_DUP_PH
    bool dup2 = false;
    if (php > MK_DUP_PH) { ph = php - 1; dup2 = (php == MK_DUP_PH + 1); }
#endif
    unsigned long long apv = (unsigned long long)a0; asm volatile("" : "+s"(apv)); const AP a = (AP)apv;
    unsigned char* ws = a->ws;
    int type = PT_PRO, f = 0, nss = -1;
    const bf16_t* gA = (const bf16_t*)(ws + WS_H); const bf16_t* gB = nullptr; int gK = FF;
    switch (ph) {
      case 0: type = PT_PRO; break;
      case 1: type = PT_GU; f = 0; nss = 5; break;
      case 2: type = PT_RES; gB = (const bf16_t*)(ws + WS_WD); nss = 0; break;
      case 3: type = PT_IN; nss = 0; break;
      case 4: type = PT_CONV; break;
      case 5: type = PT_SCAN; break;
      case 6: type = PT_GNORM; break;
      case 7: type = PT_RES; gA = (const bf16_t*)(ws + WS_S); gB = (const bf16_t*)(ws + WS_WOUT); gK = DM; nss = 1; break;
      case 8: type = PT_GU; f = 1; nss = 1; break;
      case 9: type = PT_RES; gB = (const bf16_t*)(ws + WS_WD + 1 * SZ_D); nss = 2; break;
      case 10: type = PT_GU; f = 2; nss = 2; break;
      case 11: type = PT_RES; gB = (const bf16_t*)(ws + WS_WD + 2 * SZ_D); nss = 3; break;
      case 12: type = PT_QKV; nss = 3; break;
      case 13: type = PT_ATTN; break;
      case 14: type = PT_SUBLN; break;
      case 15: type = PT_RES; gA = (const bf16_t*)a->out; gB = (const bf16_t*)(ws + WS_WO); gK = DM; nss = 4; break;
      case 16: type = PT_GU; f = 3; nss = 4; break;
      case 17: type = PT_RES; gB = (const bf16_t*)(ws + WS_WD + 3 * SZ_D); break;
      default: type = PT_FINAL; break;
    }
    const u64* ssp = (const u64*)(ws + WS_SS) + (size_t)(nss >= 0 ? nss : 0) * T;
    pg8::StaticOrder S;
#ifndef MK_ENABLE
#define MK_ENABLE 0xFFFF
#endif
    if (!((MK_ENABLE >> type) & 1)) continue;
    if (type == PT_SUBLN) continue;
    switch (type) {
      case PT_PRO: prologue(a, lds); break;
      case PT_GU: {
#ifdef MK_STAGGER
        if ((blockIdx.x >> 3) & 1) { const unsigned long long t0 = __builtin_amdgcn_s_memrealtime(); while (__builtin_amdgcn_s_memrealtime() - t0 < MK_STAGGER) __builtin_amdgcn_s_sleep(32); }
#endif
        pg8::Gemm g{(const bf16_t*)(ws + WS_XN), (const bf16_t*)(ws + WS_WGU + (size_t)f * SZ_GU), T, 2 * FF, DM}; S.init(T, 2 * FF, gridDim.x, blockIdx.x);
        EpiSwiglu E{(bf16_t*)(ws + WS_H), ssp, DUP2}; pg8::gemm_phase<EpiSwiglu, pg8::StaticOrder>((PG8_LAS unsigned char*)lds, g, S, E, nullptr); } break;
      case PT_RES: { pg8::Gemm g{gA, gB, T, DM, gK}; S.init(T, DM, gridDim.x, blockIdx.x);
        EpiResid E{a, ph, DUP2}; pg8::gemm_phase<EpiResid, pg8::StaticOrder>((PG8_LAS unsigned char*)lds, g, S, E, nullptr); } break;
      case PT_IN: { pg8::Gemm g{(const bf16_t*)(ws + WS_XN), (const bf16_t*)(ws + WS_WIN), T, NIN, DM}; S.init(T, NIN, gridDim.x, blockIdx.x);
        EpiP E{(bf16_t*)(ws + WS_H), (float*)(ws + WS_BA), ssp}; pg8::gemm_phase<EpiP, pg8::StaticOrder>((PG8_LAS unsigned char*)lds, g, S, E, nullptr); } break;
      case PT_CONV: dn_prep(a); break;
      case PT_SCAN: scan_phase(a, lds); break;
      case PT_GNORM: gnorm_phase(a); conv_module(a, lds); break;
      case PT_QKV: { pg8::Gemm g{(const bf16_t*)(ws + WS_XN), (const bf16_t*)(ws + WS_WQKV), T, NQKV, DM}; S.init(T, NQKV, gridDim.x, blockIdx.x);
        EpiQKV E{(bf16_t*)(ws + WS_H), (const float*)(ws + WS_ROPE), ssp}; pg8::gemm_phase<EpiQKV, pg8::StaticOrder>((PG8_LAS unsigned char*)lds, g, S, E, nullptr); } break;
      case PT_ATTN: attn_phase(a, lds); break;
      case PT_SUBLN: break;
      default: final_phase((const bf16_t*)(ws + WS_XN), (const u64*)(ws + WS_SS) + (size_t)6 * T, a->in[28], a->out); break;
    }
    if (php + 1 < ph_hi) { if (ph_hi > 4096) grid.sync(); else xcd_barrier((unsigned*)(a0->ws + WS_BAR), xst); }
  }
}
}

#ifndef MK_MULTI
#define MK_MULTI 0
#endif
extern "C" void kernel_launch(void* const* d_in, const int* in_sizes, int n_in, void* d_out, int out_size, void* d_ws, size_t ws_size, hipStream_t stream) {
  static int grid = 0;
  if (grid == 0) {
    if (n_in != 29 || out_size != mk::T * mk::DM || ws_size < mk::WS_END) { fprintf(stderr, "kernel_launch: unexpected shapes n_in %d out %d ws %zu (need %zu)\n", n_in, out_size, ws_size, (size_t)mk::WS_END); grid = -1; return; }
    int dev = 0, cus = 0, per_cu = 0;
    hipGetDevice(&dev); hipDeviceGetAttribute(&cus, hipDeviceAttributeMultiprocessorCount, dev);
    if (hipFuncSetAttribute((const void*)mk::mega, hipFuncAttributeMaxDynamicSharedMemorySize, mk::LDS_BYTES) != hipSuccess) { fprintf(stderr, "kernel_launch: hipFuncSetAttribute failed\n"); grid = -1; return; }
    hipOccupancyMaxActiveBlocksPerMultiprocessor(&per_cu, (const void*)mk::mega, 512, mk::LDS_BYTES);
    if (per_cu < 1) per_cu = 1;
    grid = cus * per_cu;
    (void)hipGetLastError();
  }
  if (grid < 0) return;
  mk::Args a{};
  for (int i = 0; i < 29; ++i) a.in[i] = (const float*)d_in[i];
  a.out = (float*)d_out; a.ws = (unsigned char*)d_ws;
#if MK_MULTI
  for (int ph = 0; ph < mk::NPHASE; ++ph) { a.ph_lo = ph; a.ph_hi = ph + 1; hipLaunchKernelGGL(mk::mega, dim3(grid), dim3(512), mk::LDS_BYTES, stream, a); }
#else
  a.ph_lo = 0; a.ph_hi = mk::NPHASE;
  (void)hipMemsetAsync((char*)d_ws + mk::WS_BAR, 0, 16384, stream);
  void* args[] = {&a};
  hipError_t e = hipLaunchCooperativeKernel((const void*)mk::mega, dim3(grid), dim3(512), args, mk::LDS_BYTES, stream);
  if (e != hipSuccess) fprintf(stderr, "cooperative launch failed: %s (grid %d)\n", hipGetErrorString(e), grid);
#endif
}
```

```cpp
#include <hip/hip_runtime.h>
#include <hip/hip_cooperative_groups.h>
#include <cstdio>
#include <cstdint>
namespace cg = cooperative_groups;
__device__ __forceinline__ int tidx() { int t = threadIdx.x; asm volatile("" : "+v"(t)); return t; }
namespace pg8 {
#define PG8_LAS __attribute__((address_space(3)))
typedef unsigned short bf16_t;
typedef short bf16x8 __attribute__((ext_vector_type(8)));
typedef float f32x4 __attribute__((ext_vector_type(4)));
typedef unsigned u32x4 __attribute__((ext_vector_type(4)));
constexpr int BM = 256, BK = 64, HALF = 128, HTB = HALF * BK * 2  , STAGE_BYTES = 8 * HTB, NXCD = 8, WGM = 4;

__host__ __device__ __forceinline__ int lds_byte(int r, int c) { const int st = (r >> 4) * 2 + (c >> 5), rr = r & 15, cc = c & 31, ob = rr * 64 + cc * 2; return st * 1024 + (ob ^ (((ob >> 9) & 1) << 5)); }
__host__ __device__ __forceinline__ void stage_rc(int b, int& R, int& C) { const int st = b / 1024, sb = b % 1024, swz = sb ^ (((sb >> 9) & 1) << 5); R = (st >> 1) * 16 + swz / 64; C = (st & 1) * 32 + (swz % 64) / 2; }
__host__ __device__ __forceinline__ int perm32(int rho) { const int n = rho >> 4, i = rho & 15; return 8 * (i >> 2) + 4 * n + (i & 3); }
struct Unit { int pm, pn; };
struct Gemm { const bf16_t* A; const bf16_t* Bt; int M, N, K; };

struct StaticOrder {
    int nM, nN, nwg, G, c;
    __host__ __device__ void init(int M, int N, int G_, int c_) { nM = M / BM; nN = N / BM; nwg = nM * nN; G = G_; c = c_; }
    __host__ __device__ bool next(int i, Unit& u) const {
        const long L = (long)i * G + c; if (L >= nwg) return false;
        int wgid = (int)L; { const int q = nwg / NXCD, r = nwg % NXCD, xcd = wgid % NXCD, off = wgid / NXCD; wgid = (xcd < r ? xcd * (q + 1) : r * (q + 1) + (xcd - r) * q) + off; }
        const int nig = WGM * nN, gid = wgid / nig, fm = gid * WGM, gsz = (nM - fm) < WGM ? (nM - fm) : WGM;
        u.pm = fm + ((wgid % nig) % gsz); u.pn = (wgid % nig) / gsz; return true;
    }
    __device__ __forceinline__ void a_ready(const Unit&) const {}
    __device__ __forceinline__ void done(const Unit&) const {}
};
__device__ __forceinline__ unsigned cvt_pk_bf16(float lo, float hi) { unsigned r; asm volatile("v_cvt_pk_bf16_f32 %0, %1, %2" : "=v"(r) : "v"(lo), "v"(hi)); return r; }
template <class Epi, class Sched, bool STAMP = false>
__device__ __forceinline__ void gemm_phase(PG8_LAS unsigned char* lds, const Gemm g, const Sched& S, const Epi& E, unsigned long long* stamps) {
    const int tid = tidx(), wid = __builtin_amdgcn_readfirstlane(tid >> 6), lane = tid & 63, wr = wid >> 2, wc = wid & 3, fr = lane & 15, fq = lane >> 4;
    const int K = g.K, nt = K / BK;
    int ts_lo = 0, ts_hi = 0, nts = 0; const unsigned long long rt_entry = STAMP ? (unsigned long long)wall_clock64() : 0ull;
#define PG8_STAMP() do { if (STAMP && wid == 0 && nts < 64) { const unsigned long long _c = (unsigned long long)clock64(); \
        ts_lo = (lane == nts) ? (int)(unsigned)_c : ts_lo; ts_hi = (lane == nts) ? (int)(unsigned)(_c >> 32) : ts_hi; ++nts; } } while (0)
    PG8_STAMP();
    unsigned voffA[2], voffB[2];
#pragma unroll
    for (int i = 0; i < 2; ++i) { int R, C; stage_rc(tid * 16 + i * 8192, R, C); const int Rb = Epi::PERM ? ((R & ~31) + perm32(R & 31)) : R;
        voffA[i] = (unsigned)(R * K + C) * 2u; voffB[i] = (unsigned)(Rb * K + C) * 2u; }
    const size_t kstep = (size_t)(BK * 2);
    const size_t hstep = (size_t)HALF * K * 2;
    const size_t tstep = 2 * hstep;
    const unsigned ldsw = (unsigned)wid * 1024u;
    const int aoff = lds_byte(wr * 64 + fr, fq * 8), boff = lds_byte(wc * 32 + fr, fq * 8);
#define PG8_SA(b, h) (((b) * 2 + (h)) * HTB)
#define PG8_SB(b, h) ((4 + (b) * 2 + (h)) * HTB)
#define PG8_STAGE(bufoff, gbase, voff) do { _Pragma("unroll") for (int _i = 0; _i < 2; ++_i) \
        __builtin_amdgcn_global_load_lds((const unsigned*)((const char*)(gbase) + (voff)[_i]), (PG8_LAS unsigned*)(lds + (bufoff) + ldsw + _i * 8192), 16, 0, 0); } while (0)
#define PG8_LDA(dst, b, h) do { _Pragma("unroll") for (int m = 0; m < 4; ++m) _Pragma("unroll") for (int k = 0; k < 2; ++k) dst[m][k] = *(const PG8_LAS bf16x8*)(lds + PG8_SA(b, h) + aoff + m * 2048 + k * 1024); } while (0)
#define PG8_LDB(dst, b, h) do { _Pragma("unroll") for (int n = 0; n < 2; ++n) _Pragma("unroll") for (int k = 0; k < 2; ++k) dst[n][k] = *(const PG8_LAS bf16x8*)(lds + PG8_SB(b, h) + boff + n * 2048 + k * 1024); } while (0)
#define PG8_MMA(ai, bj, At, Bt) do { __builtin_amdgcn_s_setprio(1); _Pragma("unroll") for (int m = 0; m < 4; ++m) _Pragma("unroll") for (int n = 0; n < 2; ++n) _Pragma("unroll") for (int k = 0; k < 2; ++k) \
        acc[ai][bj][m][n] = __builtin_amdgcn_mfma_f32_16x16x32_bf16(Bt[n][k], At[m][k], acc[ai][bj][m][n], 0, 0, 0); __builtin_amdgcn_s_setprio(0); } while (0)
#define PG8_WAIT_V(n) asm volatile("s_waitcnt vmcnt(" #n ")" ::: "memory")
#define PG8_WAIT_L(n) asm volatile("s_waitcnt lgkmcnt(" #n ")" ::: "memory")
#define PG8_BAR __builtin_amdgcn_s_barrier()
#define PG8_SCHED __builtin_amdgcn_sched_barrier(0)
    Unit cur, nxt; int ui = 0;
    if (!S.next(0, cur)) return;
    f32x4 acc[2][2][4][2];
#pragma unroll
    for (int a = 0; a < 2; ++a)
#pragma unroll
        for (int b = 0; b < 2; ++b)
#pragma unroll
            for (int m = 0; m < 4; ++m)
#pragma unroll
                for (int n = 0; n < 2; ++n) acc[a][b][m][n] = (f32x4){0.f, 0.f, 0.f, 0.f};
    bf16x8 At[4][2], B0[2][2], B1[2][2];
    const char* cA = (const char*)g.A + (size_t)cur.pm * tstep; const char* cB = (const char*)g.Bt + (size_t)cur.pn * tstep;
    S.a_ready(cur);
    PG8_STAGE(PG8_SB(0, 0), cB, voffB); PG8_STAGE(PG8_SA(0, 0), cA, voffA); PG8_STAGE(PG8_SB(0, 1), cB + hstep, voffB); PG8_STAGE(PG8_SA(0, 1), cA + hstep, voffA);
    if (wr == 1) PG8_BAR;
    PG8_WAIT_V(4); PG8_BAR;
    PG8_STAGE(PG8_SB(1, 0), cB + kstep, voffB); PG8_STAGE(PG8_SA(1, 0), cA + kstep, voffA); PG8_STAGE(PG8_SB(1, 1), cB + hstep + kstep, voffB);
    PG8_WAIT_V(6); PG8_BAR;
    PG8_STAMP();
    for (;;) {
        const bool has_next = S.next(ui + 1, nxt);
        const char* nA = has_next ? (const char*)g.A + (size_t)nxt.pm * tstep : cA; const char* nB = has_next ? (const char*)g.Bt + (size_t)nxt.pn * tstep : cB;
        for (int t = 0; t < nt; t += 2) {
            const bool last = (t == nt - 2);
            const char* a1 = cA + (size_t)(t + 1) * kstep;
            const char* a2 = last ? nA : cA + (size_t)(t + 2) * kstep; const char* b2 = last ? nB : cB + (size_t)(t + 2) * kstep;
            const char* a3 = a2 + kstep; const char* b3 = b2 + kstep;
            if (last && has_next) S.a_ready(nxt);
            PG8_LDB(B0, 0, 0); PG8_SCHED; PG8_LDA(At, 0, 0); PG8_STAGE(PG8_SA(1, 1), a1 + hstep, voffA);
            PG8_WAIT_L(8); PG8_BAR; PG8_WAIT_L(0); PG8_MMA(0, 0, At, B0); PG8_BAR; PG8_SCHED;
            PG8_LDB(B1, 0, 1); PG8_STAGE(PG8_SB(0, 0), b2, voffB);
            PG8_BAR; PG8_WAIT_L(0); PG8_MMA(0, 1, At, B1); PG8_BAR;
            PG8_LDA(At, 0, 1); PG8_STAGE(PG8_SA(0, 0), a2, voffA);
            PG8_BAR; PG8_WAIT_L(0); PG8_MMA(1, 0, At, B0); PG8_BAR; PG8_SCHED;
            PG8_STAGE(PG8_SB(0, 1), b2 + hstep, voffB);
            PG8_WAIT_V(6); PG8_BAR; PG8_MMA(1, 1, At, B1); PG8_BAR;
            PG8_LDB(B0, 1, 0); PG8_SCHED; PG8_LDA(At, 1, 0); PG8_STAGE(PG8_SA(0, 1), a2 + hstep, voffA);
            PG8_WAIT_L(8); PG8_BAR; PG8_WAIT_L(0); PG8_MMA(0, 0, At, B0); PG8_BAR; PG8_SCHED;
            PG8_LDB(B1, 1, 1); PG8_STAGE(PG8_SB(1, 0), b3, voffB);
            PG8_BAR; PG8_WAIT_L(0); PG8_MMA(0, 1, At, B1); PG8_BAR;
            PG8_LDA(At, 1, 1); PG8_STAGE(PG8_SA(1, 0), a3, voffA);
            PG8_BAR; PG8_WAIT_L(0); PG8_MMA(1, 0, At, B0); PG8_BAR; PG8_SCHED;
            PG8_STAGE(PG8_SB(1, 1), b3 + hstep, voffB);
            PG8_WAIT_V(6); PG8_BAR; PG8_MMA(1, 1, At, B1); PG8_BAR;
        }
        PG8_STAMP();
        if constexpr (!Epi::AFTER_DRAIN) { E(acc, cur, wr, wc, fr, fq); S.done(cur); }
        PG8_STAMP();
        if (!has_next) break;
#pragma unroll
        for (int a = 0; a < 2; ++a)
#pragma unroll
            for (int b = 0; b < 2; ++b)
#pragma unroll
                for (int m = 0; m < 4; ++m)
#pragma unroll
                    for (int n = 0; n < 2; ++n) acc[a][b][m][n] = (f32x4){0.f, 0.f, 0.f, 0.f};
        cur = nxt; cA = nA; cB = nB; ++ui;
    }
    PG8_WAIT_V(0);
    if (wr == 0) PG8_BAR;
    PG8_BAR;
    if constexpr (Epi::AFTER_DRAIN) { E.fused(acc, cur, wr, wc, fr, fq, lds, wid, lane); S.done(cur); }
    PG8_STAMP();
    if (STAMP && wid == 0) { stamps[lane] = lane < nts ? (((unsigned long long)(unsigned)ts_hi << 32) | (unsigned)ts_lo) : 0ull;
        if (lane == 62) stamps[62] = rt_entry; if (lane == 63) stamps[63] = (unsigned long long)wall_clock64(); }
#undef PG8_STAMP
#undef PG8_SA
#undef PG8_SB
#undef PG8_STAGE
#undef PG8_LDA
#undef PG8_LDB
#undef PG8_MMA
#undef PG8_WAIT_V
#undef PG8_WAIT_L
#undef PG8_BAR
#undef PG8_SCHED
}
}

namespace att {
using bf16 = unsigned short;
constexpr int   D = 128, NW = 8, QBLK = 32, KVBLK = 64;
constexpr float SCALE = 0.088388347648318440f;
constexpr float THR = 8.f;
constexpr int SDEPTH = 2;
constexpr int LDQ = 6144, LDK = 6144, LDO = 2048;
constexpr size_t SHM_V = KVBLK * D * 2, SHM_K = KVBLK * D * 2, SHM_ATTN = 2 * SHM_V + 2 * SHM_K + NW * 64 * 4;
using bf16x8 = __attribute__((ext_vector_type(8))) short;
using s16x4  = __attribute__((ext_vector_type(4))) short;
using f32x16 = __attribute__((ext_vector_type(16))) float;
using f32x8  = __attribute__((ext_vector_type(8))) float;
using u32x4  = __attribute__((ext_vector_type(4))) unsigned;
#define KSWZ(row, colB) ((row) * 256 + ((colB) ^ (((row) & 7) << 4)))
#define SBAR() __builtin_amdgcn_sched_barrier(0)
__device__ __forceinline__ int crow(int r, int hi) { return (r & 3) + 8 * (r >> 2) + 4 * hi; }
__device__ __forceinline__ unsigned cvtpk(float lo, float hi) {
  unsigned r; asm volatile("v_cvt_pk_bf16_f32 %0, %1, %2" : "=v"(r) : "v"(lo), "v"(hi)); return r;
}
template <typename TIn> struct Stage;
template <> struct Stage<bf16>  { using T = bf16x8;
  __device__ static __forceinline__ T ld8(const bf16* p) { return *reinterpret_cast<const bf16x8*>(p); }
  __device__ static __forceinline__ bf16x8 tobf(T x) { return x; } };
template <> struct Stage<float> { using T = f32x8;
  __device__ static __forceinline__ T ld8(const float* p) { return *reinterpret_cast<const f32x8*>(p); }
  __device__ static __forceinline__ bf16x8 tobf(T x) {
    u32x4 w = {cvtpk(x[0], x[1]), cvtpk(x[2], x[3]), cvtpk(x[4], x[5]), cvtpk(x[6], x[7])}; return *reinterpret_cast<bf16x8*>(&w); } };

__device__ __forceinline__ void partialSM(f32x16& p0, f32x16& p1, float& m_reg, float& mn, float& alpha) {
  constexpr float C = SCALE * 1.4426950408889634f;
  float pmax = p0[0]; for (int r = 1; r < 16; ++r) pmax = fmaxf(pmax, p0[r]); for (int r = 0; r < 16; ++r) pmax = fmaxf(pmax, p1[r]);
  { auto rr = __builtin_amdgcn_permlane32_swap(__float_as_uint(pmax), __float_as_uint(pmax), false, false);
    pmax = fmaxf(__uint_as_float(rr[0]), __uint_as_float(rr[1])); }
  if (__builtin_expect(__all(pmax - m_reg <= THR / SCALE), 1)) { mn = m_reg; alpha = 1.f; }
  else { mn = fmaxf(m_reg, pmax); alpha = __builtin_amdgcn_exp2f((m_reg - mn) * C); m_reg = mn; }
  float mnC = -mn * C;
  for (int r = 0; r < 16; ++r) p0[r] = fmaf(p0[r], C, mnC); for (int r = 0; r < 16; ++r) p1[r] = fmaf(p1[r], C, mnC);
  for (int r = 0; r < 16; ++r) p0[r] = __builtin_amdgcn_exp2f(p0[r]);
}
__device__ __forceinline__ void finishSM(f32x16& p0, f32x16& p1, float alpha, float& l_reg, bf16x8& pa0, bf16x8& pa1, bf16x8& pa2, bf16x8& pa3) {
  for (int r = 0; r < 16; ++r) p1[r] = __builtin_amdgcn_exp2f(p1[r]);
  float ps = 0; for (int r = 0; r < 16; ++r) ps += p0[r]; for (int r = 0; r < 16; ++r) ps += p1[r];
  { auto rr = __builtin_amdgcn_permlane32_swap(__float_as_uint(ps), __float_as_uint(ps), false, false);
    ps = __uint_as_float(rr[0]) + __uint_as_float(rr[1]); }
  l_reg = l_reg * alpha + ps;
#define PK4(P, BASE, OUT) do { unsigned a0 = cvtpk(P[BASE + 0], P[BASE + 1]), a1 = cvtpk(P[BASE + 2], P[BASE + 3]);   \
    unsigned b0 = cvtpk(P[BASE + 4], P[BASE + 5]), b1 = cvtpk(P[BASE + 6], P[BASE + 7]);                              \
    auto r0 = __builtin_amdgcn_permlane32_swap(a0, b0, false, false); auto r1 = __builtin_amdgcn_permlane32_swap(a1, b1, false, false); \
    u32x4 w = {r0[0], r1[0], r0[1], r1[1]}; OUT = *reinterpret_cast<bf16x8*>(&w); } while (0)
  PK4(p0, 0, pa0); PK4(p0, 8, pa1); PK4(p1, 0, pa2); PK4(p1, 8, pa3);
#undef PK4
}
__device__ __forceinline__ void qkt(f32x16& p0, f32x16& p1, const bf16* Ks, const bf16x8* qr, int r32, int hi) {
  p0 = f32x16{}; p1 = f32x16{};
  for (int d0 = 0; d0 < 8; ++d0) { int cb = (d0 * 16 + hi * 8) * 2;
    bf16x8 b0 = *reinterpret_cast<const bf16x8*>((const char*)Ks + KSWZ(r32, cb));
    bf16x8 b1 = *reinterpret_cast<const bf16x8*>((const char*)Ks + KSWZ(32 + r32, cb));
    p0 = __builtin_amdgcn_mfma_f32_32x32x16_bf16(b0, qr[d0], p0, 0, 0, 0);
    p1 = __builtin_amdgcn_mfma_f32_32x32x16_bf16(b1, qr[d0], p1, 0, 0, 0); }
}
__device__ __forceinline__ int v_st(int k, int c) { const int kk = (k & ~0xC) | ((k & 4) << 1) | ((k & 8) >> 1); return ((kk >> 3) * 4 + (c >> 5)) * 512 + ((kk & 7) * 32 + (c & 31)) * 2; }
__device__ __forceinline__ int v_rd_base(int lane) { return ((lane & 3) << 3) | (((lane >> 2) & 3) << 6) | (((lane >> 4) & 1) << 5) | (((lane >> 5) & 1) << 8); }
constexpr int v_rd_off(int d0, int ks, int half) { return d0 * 512 + ks * 4096 + half * 2048; }
template <int OFF> __device__ __forceinline__ s16x4 tr_read(int vb) {
  s16x4 r; asm volatile("ds_read_b64_tr_b16 %0, %1 offset:%2" : "=&v"(r) : "v"(vb), "i"(OFF) : "memory"); return r;
}
template <int D0> __device__ __forceinline__ void pv_one(f32x16& od, int vb, bf16x8 pa0, bf16x8 pa1, bf16x8 pa2, bf16x8 pa3) {
  const s16x4 l0 = tr_read<v_rd_off(D0, 0, 0)>(vb), h0 = tr_read<v_rd_off(D0, 0, 1)>(vb), l1 = tr_read<v_rd_off(D0, 1, 0)>(vb), h1 = tr_read<v_rd_off(D0, 1, 1)>(vb);
  const s16x4 l2 = tr_read<v_rd_off(D0, 2, 0)>(vb), h2 = tr_read<v_rd_off(D0, 2, 1)>(vb), l3 = tr_read<v_rd_off(D0, 3, 0)>(vb), h3 = tr_read<v_rd_off(D0, 3, 1)>(vb);
  asm volatile("s_waitcnt lgkmcnt(0)" ::: "memory"); SBAR();
#define PK(L, H) (bf16x8){L[0], L[1], L[2], L[3], H[0], H[1], H[2], H[3]}
  od = __builtin_amdgcn_mfma_f32_32x32x16_bf16(pa0, PK(l0, h0), od, 0, 0, 0);
  od = __builtin_amdgcn_mfma_f32_32x32x16_bf16(pa1, PK(l1, h1), od, 0, 0, 0);
  od = __builtin_amdgcn_mfma_f32_32x32x16_bf16(pa2, PK(l2, h2), od, 0, 0, 0);
  od = __builtin_amdgcn_mfma_f32_32x32x16_bf16(pa3, PK(l3, h3), od, 0, 0, 0);
#undef PK
}
__device__ __forceinline__ void pv_d0(f32x16* o, int vb, bf16x8 pa0, bf16x8 pa1, bf16x8 pa2, bf16x8 pa3) {
  pv_one<0>(o[0], vb, pa0, pa1, pa2, pa3); pv_one<1>(o[1], vb, pa0, pa1, pa2, pa3); pv_one<2>(o[2], vb, pa0, pa1, pa2, pa3); pv_one<3>(o[3], vb, pa0, pa1, pa2, pa3);
}

template <typename TQ>
__device__ __forceinline__ void attn_dense_body(const TQ* __restrict__ Qb, const bf16* __restrict__ Kh, const bf16* __restrict__ Vh,
                                                float* __restrict__ Ob, int seq, char* lds, int mode, float lam, unsigned short* o1buf) {
  using St = Stage<bf16>; using SQ = Stage<TQ>;
  const int tid = tidx(), wid = tid >> 6, lane = tid & 63, r32 = lane & 31, hi = lane >> 5;
  bf16* V_lds = (bf16*)lds; bf16* K_lds = (bf16*)(lds + 2 * SHM_V);
  float* ws = (float*)(lds + 2 * SHM_V + 2 * SHM_K) + wid * 64; float* li_l = ws; float* al_l = ws + 32;
  float m_reg = -1e30f, l_reg = 0; f32x16 o[4] = {}; bf16x8 qr[8];
  const TQ* Qw = Qb + (long)(wid * QBLK + r32) * LDQ + hi * 8;
#pragma unroll
  for (int d0 = 0; d0 < 8; ++d0) qr[d0] = SQ::tobf(SQ::ld8(Qw + d0 * 16));
  const int sr = tid >> 4, sc = (tid & 15) * 8, vst0 = v_st(sr, sc), vst1 = v_st(32 + sr, sc);
  const int vb0 = (int)(uintptr_t)V_lds + v_rd_base(lane);
  struct { typename St::T vs0, vs1, ks0, ks1; } sr_[SDEPTH];
#define SLOAD(i, k0) do { sr_[i].vs0 = St::ld8(&Vh[(long)((k0) + sr) * LDK + sc]); sr_[i].vs1 = St::ld8(&Vh[(long)((k0) + 32 + sr) * LDK + sc]); \
    sr_[i].ks0 = St::ld8(&Kh[(long)((k0) + sr) * LDK + sc]); sr_[i].ks1 = St::ld8(&Kh[(long)((k0) + 32 + sr) * LDK + sc]); } while (0)
#define SWRITE(b, i) do { *(bf16x8*)((char*)V_lds + (b) * SHM_V + vst0) = St::tobf(sr_[i].vs0);          \
    *(bf16x8*)((char*)V_lds + (b) * SHM_V + vst1) = St::tobf(sr_[i].vs1); int kc = sc * 2;               \
    *(bf16x8*)((char*)K_lds + (b) * SHM_K + KSWZ(sr, kc)) = St::tobf(sr_[i].ks0);                       \
    *(bf16x8*)((char*)K_lds + (b) * SHM_K + KSWZ(32 + sr, kc)) = St::tobf(sr_[i].ks1); } while (0)
#define SWAIT() do { if constexpr (SDEPTH == 2) asm volatile("s_waitcnt vmcnt(4)" ::: "memory"); else asm volatile("s_waitcnt vmcnt(0)" ::: "memory"); } while (0)
#define RESC(a) do { if (__any((a) < 1.f)) { if (hi == 0) al_l[r32] = (a); asm volatile("s_waitcnt lgkmcnt(0)" ::: "memory"); \
    for (int d = 0; d < 4; ++d) for (int r = 0; r < 16; ++r) o[d][r] *= al_l[crow(r, hi)]; } } while (0)
  f32x16 pA0, pA1, pB0, pB1; float mnA, mnB, alA, alB; bf16x8 pa0, pa1, pa2, pa3; const int NT = seq / KVBLK;
  constexpr int SE = 0, SO = SDEPTH - 1;
  SLOAD(SE, 0); asm volatile("s_waitcnt vmcnt(0)" ::: "memory"); SWRITE(0, SE); __syncthreads();
  qkt(pA0, pA1, K_lds, qr, r32, hi); partialSM(pA0, pA1, m_reg, mnA, alA);
  SLOAD(SO, KVBLK); if constexpr (SDEPTH == 2) { if (2 < NT) SLOAD(SE, 2 * KVBLK); }
  SWAIT(); SWRITE(1, SO); __syncthreads();
  for (int j = 1; j + 1 < NT; j += 2) {
    SBAR(); qkt(pB0, pB1, (bf16*)((char*)K_lds + SHM_K), qr, r32, hi);
    finishSM(pA0, pA1, alA, l_reg, pa0, pa1, pa2, pa3); SBAR();
    SLOAD(SO, (j + SDEPTH) * KVBLK); SBAR();
    pv_d0(o, vb0, pa0, pa1, pa2, pa3); partialSM(pB0, pB1, m_reg, mnB, alB);
    __syncthreads(); SWAIT(); SWRITE(0, SE);
    RESC(alB); __syncthreads();
    SBAR(); qkt(pA0, pA1, K_lds, qr, r32, hi);
    finishSM(pB0, pB1, alB, l_reg, pa0, pa1, pa2, pa3); SBAR();
    if (SDEPTH == 1 || j + 3 < NT) SLOAD(SE, (j + 1 + SDEPTH) * KVBLK); SBAR();
    pv_d0(o, vb0 + (int)SHM_V, pa0, pa1, pa2, pa3); partialSM(pA0, pA1, m_reg, mnA, alA);
    __syncthreads(); SWAIT(); SWRITE(1, SO);
    RESC(alA); __syncthreads();
  }
  SBAR(); qkt(pB0, pB1, (bf16*)((char*)K_lds + SHM_K), qr, r32, hi);
  finishSM(pA0, pA1, alA, l_reg, pa0, pa1, pa2, pa3); SBAR();
  pv_d0(o, vb0, pa0, pa1, pa2, pa3); partialSM(pB0, pB1, m_reg, mnB, alB);
  __syncthreads(); RESC(alB);
  finishSM(pB0, pB1, alB, l_reg, pa0, pa1, pa2, pa3); SBAR();
  pv_d0(o, vb0 + (int)SHM_V, pa0, pa1, pa2, pa3);
  if (hi == 0) li_l[r32] = l_reg; asm volatile("s_waitcnt lgkmcnt(0)" ::: "memory");
  float rli[16];
#pragma unroll
  for (int r = 0; r < 16; ++r) rli[r] = __builtin_amdgcn_rcpf(li_l[crow(r, hi)]);
  float* Ow = Ob + (long)(wid * QBLK) * LDO;
#pragma unroll
  for (int r = 0; r < 16; ++r) { int orow = crow(r, hi);
    for (int d0 = 0; d0 < 4; ++d0) { const float val = o[d0][r] * rli[r]; unsigned short* lp = o1buf + (wid * QBLK + orow) * 128 + d0 * 32 + r32;
      if (mode == 0) { *lp = (unsigned short)(cvtpk(val, val) & 0xffffu); } else { Ow[(long)orow * LDO + d0 * 32 + r32] = __uint_as_float(((unsigned)*lp) << 16) - lam * val; } } }
#undef SLOAD
#undef SWRITE
#undef SWAIT
#undef RESC
}

#undef KSWZ
#undef SBAR
}
#ifndef MK_NO_HELPER
#define MK_NO_HELPER 0
#endif
namespace mk {
using pg8::bf16_t; using pg8::f32x4; using pg8::u32x4; using pg8::cvt_pk_bf16; using pg8::Unit;
typedef unsigned u32x2 __attribute__((ext_vector_type(2)));
typedef float f32x2 __attribute__((ext_vector_type(2)));
constexpr int T = 16384, DM = 2048, FF = 5632, SEQ = 4096;
constexpr int NIN_REAL = 6176, NIN = 6400, NQKV = 6144;
constexpr int LDS_BYTES = 155648;
constexpr float EPS = 1e-6f;
constexpr float LAMBDA_INIT = 0.35550906759096924f;
#ifdef MK_DUP_PH
constexpr int NPHASE = 20;
#else
constexpr int NPHASE = 19;
#endif

constexpr size_t SZ_SMALL = (size_t)T * 32 * 4;
constexpr size_t SZ_GU = (size_t)2 * FF * DM * 2, SZ_D = (size_t)DM * FF * 2;
constexpr size_t WS_ROPE = 0, WS_BA = WS_ROPE + SZ_SMALL, WS_BG = WS_BA + SZ_SMALL;
constexpr size_t WS_SS = WS_BG + SZ_SMALL;
constexpr size_t WS_WGU = WS_SS + (size_t)1024 * 1024, WS_WD = WS_WGU + 4 * SZ_GU;
typedef unsigned long long u64;
constexpr size_t WS_BAR = WS_SS + (size_t)960 * 1024;
constexpr float SSQ = 1048576.f, SSQ_INV = 1.f / 1048576.f;
constexpr size_t WS_WIN = WS_WD + 4 * SZ_D, WS_WOUT = WS_WIN + (size_t)NIN * DM * 2;
constexpr size_t WS_WQKV = WS_WOUT + (size_t)DM * DM * 2, WS_WO = WS_WQKV + (size_t)NQKV * DM * 2;
constexpr size_t WS_XN = WS_WO + (size_t)DM * DM * 2;
constexpr size_t WS_H = WS_XN + (size_t)T * DM * 2;
constexpr size_t WS_S = WS_H + (size_t)T * NIN * 2;
constexpr size_t SZ_T1K = (size_t)T * 1024 * 2;
constexpr size_t WS_END = WS_S + 5 * SZ_T1K;

struct Args { const float* in[29]; float* out; unsigned char* ws; int ph_lo, ph_hi; };
typedef const __attribute__((address_space(4))) Args* AP;

__device__ __forceinline__ float bflo(unsigned w) { return __uint_as_float(w << 16); }
__device__ __forceinline__ float bfhi(unsigned w) { return __uint_as_float(w & 0xffff0000u); }
__device__ __forceinline__ float sigm(float x) { return __builtin_amdgcn_rcpf(1.f + __expf(-x)); }
__device__ __forceinline__ float silu(float x) { return x * sigm(x); }
__device__ __forceinline__ float wave_sum(float v) {
#pragma unroll
  for (int m = 32; m >= 1; m >>= 1) v += __shfl_xor(v, m, 64);
  return v;
}

template <int CTRL> __device__ __forceinline__ float dpp_mov(float v) { return __int_as_float(__builtin_amdgcn_update_dpp(0, __float_as_int(v), CTRL, 0xF, 0xF, true)); }
__device__ __forceinline__ float row_sum8(float v) { v += dpp_mov<0xB1>(v); v += dpp_mov<0x4E>(v); v += dpp_mov<0x141>(v); return v; }
__device__ __forceinline__ float row_sum16(float v) { v += dpp_mov<0xB1>(v); v += dpp_mov<0x4E>(v); v += dpp_mov<0x141>(v); v += dpp_mov<0x140>(v); return v; }
__device__ __forceinline__ float dpp_row_bcast_sum4(float v) { float t = v + __shfl_xor(v, 16, 64); return t + __shfl_xor(t, 32, 64) - v; }
#define EPI_PIN() __builtin_amdgcn_sched_barrier(0)
struct EpiSwiglu { static constexpr bool PERM = true, AFTER_DRAIN = false; bf16_t* H; const u64* ss; int dup;
  __device__ __forceinline__ void operator()(const f32x4 (&acc)[2][2][4][2], const Unit& u, int wr, int wc, int fr, int fq) const {
    const int row0 = u.pm * 256 + wr * 64 + fr, col0 = u.pn * 128 + wc * 32 + 8 * fq;
    float rsv[2][4];
#pragma unroll
    for (int ai = 0; ai < 2; ++ai)
#pragma unroll
      for (int m = 0; m < 4; ++m) rsv[ai][m] = (float)ss[row0 + ai * 128 + m * 16] * SSQ_INV;
    EPI_PIN();
#pragma unroll
    for (int ai = 0; ai < 2; ++ai)
#pragma unroll
      for (int m = 0; m < 4; ++m) {
        const float rs = rsqrtf(rsv[ai][m] * (1.f / DM) + EPS);
        const f32x4 g0 = acc[ai][0][m][0] * rs, g1 = acc[ai][0][m][1] * rs, u0 = acc[ai][1][m][0] * rs, u1 = acc[ai][1][m][1] * rs;
        float h[8];
#pragma unroll
        for (int j = 0; j < 4; ++j) { h[j] = silu(g0[j]) * u0[j]; h[4 + j] = silu(g1[j]) * u1[j]; }
        u32x4 w; w[0] = cvt_pk_bf16(h[0], h[1]); w[1] = cvt_pk_bf16(h[2], h[3]); w[2] = cvt_pk_bf16(h[4], h[5]); w[3] = cvt_pk_bf16(h[6], h[7]);
#if MK_PROBE_NOSTORE
        if (!dup || w[0] == 0x12345678u)
#endif
        __builtin_nontemporal_store(w, (u32x4*)(H + (size_t)(row0 + ai * 128 + m * 16) * FF + col0));
      }
  }
};
struct EpiResid { static constexpr bool PERM = false, AFTER_DRAIN = false; AP a; int ph; int dup;
  __device__ __forceinline__ void operator()(const f32x4 (&acc)[2][2][4][2], const Unit& u, int wr, int wc, int fr, int fq) const {
    bf16_t* xb = (bf16_t*)(a->ws + WS_XN); const float* xin = a->in[0];
    const float scale = (ph == 7 || ph == 15) ? 1.f : 0.5f;
    const int nss = (ph == 2) ? 0 : (ph == 7) ? 1 : (ph == 9) ? 2 : (ph == 11) ? 3 : (ph == 15) ? 4 : 6;
    u64* ss = (u64*)(a->ws + WS_SS) + (size_t)nss * T;
    const int row0 = u.pm * 256 + wr * 64 + fr, col0 = u.pn * 256 + wc * 32 + 4 * fq;
#pragma unroll
    for (int ai = 0; ai < 2; ++ai) {
    u32x2 rb[4][2][2];
    if (ph != 2) {
#pragma unroll
      for (int m = 0; m < 4; ++m)
#pragma unroll
        for (int bj = 0; bj < 2; ++bj)
#pragma unroll
          for (int n = 0; n < 2; ++n) rb[m][bj][n] = *(const u32x2*)(xb + (size_t)(row0 + ai * 128 + m * 16) * DM + col0 + bj * 128 + n * 16);
    }
    EPI_PIN();
#pragma unroll
    for (int mh = 0; mh < 2; ++mh) {
      f32x4 r[2][2][2];
      if (ph == 2) {
#pragma unroll
        for (int m2 = 0; m2 < 2; ++m2)
#pragma unroll
          for (int bj = 0; bj < 2; ++bj)
#pragma unroll
            for (int n = 0; n < 2; ++n) r[m2][bj][n] = *(const f32x4*)(xin + (size_t)(row0 + ai * 128 + (mh * 2 + m2) * 16) * DM + col0 + bj * 128 + n * 16);
      } else {
#pragma unroll
        for (int m2 = 0; m2 < 2; ++m2)
#pragma unroll
          for (int bj = 0; bj < 2; ++bj)
#pragma unroll
            for (int n = 0; n < 2; ++n) { const u32x2 q = rb[mh * 2 + m2][bj][n]; r[m2][bj][n] = (f32x4){bflo(q[0]), bfhi(q[0]), bflo(q[1]), bfhi(q[1])}; }
      }
      EPI_PIN();
#pragma unroll
      for (int m2 = 0; m2 < 2; ++m2) {
        const int m = mh * 2 + m2;
        const size_t off = (size_t)(row0 + ai * 128 + m * 16) * DM + col0; float sq = 0.f;
#pragma unroll
        for (int bj = 0; bj < 2; ++bj)
#pragma unroll
          for (int n = 0; n < 2; ++n) { const f32x4 rr = r[m2][bj][n] + acc[ai][bj][m][n] * scale;
            u32x2 w; w[0] = cvt_pk_bf16(rr[0], rr[1]); w[1] = cvt_pk_bf16(rr[2], rr[3]); *(u32x2*)(xb + off + bj * 128 + n * 16) = w;
            const float y0 = bflo(w[0]), y1 = bfhi(w[0]), y2 = bflo(w[1]), y3 = bfhi(w[1]); sq += y0 * y0 + y1 * y1 + y2 * y2 + y3 * y3; }
        sq += dpp_row_bcast_sum4(sq); if (fq == 0) atomicAdd(ss + row0 + ai * 128 + m * 16, (u64)(sq * SSQ + 0.5f));
      }
      EPI_PIN();
    }
    }
  }
};
struct EpiP { static constexpr bool PERM = true, AFTER_DRAIN = false; bf16_t* P; float* BA; const u64* ss;
  __device__ __forceinline__ void operator()(const f32x4 (&acc)[2][2][4][2], const Unit& u, int wr, int wc, int fr, int fq) const {
    const int row0 = u.pm * 256 + wr * 64 + fr, col0 = u.pn * 256 + wc * 32 + 8 * fq;
    float rsv[2][4];
#pragma unroll
    for (int ai = 0; ai < 2; ++ai)
#pragma unroll
      for (int m = 0; m < 4; ++m) rsv[ai][m] = (float)ss[row0 + ai * 128 + m * 16] * SSQ_INV;
    EPI_PIN();
#pragma unroll
    for (int ai = 0; ai < 2; ++ai)
#pragma unroll
      for (int m = 0; m < 4; ++m) {
        const int row = row0 + ai * 128 + m * 16;
        const float rs = rsqrtf(rsv[ai][m] * (1.f / DM) + EPS);
#pragma unroll
        for (int bj = 0; bj < 2; ++bj) {
          const f32x4 a0 = acc[ai][bj][m][0] * rs, a1 = acc[ai][bj][m][1] * rs;
          u32x4 w; w[0] = cvt_pk_bf16(a0[0], a0[1]); w[1] = cvt_pk_bf16(a0[2], a0[3]); w[2] = cvt_pk_bf16(a1[0], a1[1]); w[3] = cvt_pk_bf16(a1[2], a1[3]);
          *(u32x4*)(P + (size_t)row * NIN + col0 + bj * 128) = w;
        }
        if (u.pn == 24 && wc == 0) { *(f32x4*)(BA + (size_t)row * 32 + 8 * fq) = acc[ai][0][m][0] * rs; *(f32x4*)(BA + (size_t)row * 32 + 8 * fq + 4) = acc[ai][0][m][1] * rs; }
      }
  }
};
struct EpiQKV { static constexpr bool PERM = false, AFTER_DRAIN = false; bf16_t* O; const float* rope; const u64* ss;
  __device__ __forceinline__ void operator()(const f32x4 (&acc)[2][2][4][2], const Unit& u, int wr, int wc, int fr, int fq) const {
    const int row0 = u.pm * 256 + wr * 64 + fr, col0 = u.pn * 256 + wc * 32 + 4 * fq;
    const bool rot = (wc == 0) && (u.pn < 16);
    float rsv[2][4];
#pragma unroll
    for (int ai = 0; ai < 2; ++ai)
#pragma unroll
      for (int m = 0; m < 4; ++m) rsv[ai][m] = (float)ss[row0 + ai * 128 + m * 16] * SSQ_INV;
#pragma unroll
    for (int ai = 0; ai < 2; ++ai) {
      f32x4 cv[4], sv[4];
#pragma unroll
      for (int m = 0; m < 4; ++m) { const size_t ro = (size_t)(row0 + ai * 128 + m * 16) * 32 + 4 * fq;
        cv[m] = rot ? *(const f32x4*)(rope + ro) : (f32x4){1.f, 1.f, 1.f, 1.f}; sv[m] = rot ? *(const f32x4*)(rope + ro + 16) : (f32x4){0.f, 0.f, 0.f, 0.f}; }
      EPI_PIN();
#pragma unroll
      for (int m = 0; m < 4; ++m) {
        const int row = row0 + ai * 128 + m * 16;
        const float rs = rsqrtf(rsv[ai][m] * (1.f / DM) + EPS);
#pragma unroll
        for (int bj = 0; bj < 2; ++bj) {
          f32x4 v0 = acc[ai][bj][m][0] * rs, v1 = acc[ai][bj][m][1] * rs;
          const f32x4 n0 = v0 * cv[m] - v1 * sv[m], n1 = v1 * cv[m] + v0 * sv[m];
          u32x2 w0, w1; w0[0] = cvt_pk_bf16(n0[0], n0[1]); w0[1] = cvt_pk_bf16(n0[2], n0[3]); w1[0] = cvt_pk_bf16(n1[0], n1[1]); w1[1] = cvt_pk_bf16(n1[2], n1[3]);
          bf16_t* p = O + (size_t)row * NQKV + col0 + bj * 128;
          *(u32x2*)p = w0; *(u32x2*)(p + 16) = w1;
        }
      }
      EPI_PIN();
    }
  }
};

__device__ __forceinline__ void xpose_mat(const float* __restrict__ W, int K, int N, bf16_t* __restrict__ Wt, int mode, float* tile, const float* __restrict__ gk = nullptr) {
  (void)tile;
  const int lane = tidx() & 63, wid = tidx() >> 6;
  const int nkt = K / 64, ntiles = nkt * (N / 32);
  for (int t = blockIdx.x * 8 + wid; t < ntiles; t += gridDim.x * 8) {
    const int nt = t / nkt, kt = t - nt * nkt, n = nt * 32 + (lane & 31), kb = kt * 64 + (lane >> 5) * 32;
    const float* src = W + (size_t)kb * N + n;
    float v[32];
#pragma unroll
    for (int i = 0; i < 32; ++i) v[i] = src[(size_t)i * N];
    int nd = n; if (mode == 1) nd = (n >> 7) * 256 + (n & 127); else if (mode == 2) nd = (n >> 7) * 256 + 128 + (n & 127);
#pragma unroll
    for (int q = 0; q < 4; ++q) {
      f32x4 g0 = {1.f, 1.f, 1.f, 1.f}, g1 = g0;
      if (gk) { g0 = *(const f32x4*)(gk + kb + 8 * q); g1 = *(const f32x4*)(gk + kb + 8 * q + 4); }
      u32x4 w; w[0] = cvt_pk_bf16(v[8 * q] * g0[0], v[8 * q + 1] * g0[1]); w[1] = cvt_pk_bf16(v[8 * q + 2] * g0[2], v[8 * q + 3] * g0[3]);
      w[2] = cvt_pk_bf16(v[8 * q + 4] * g1[0], v[8 * q + 5] * g1[1]); w[3] = cvt_pk_bf16(v[8 * q + 6] * g1[2], v[8 * q + 7] * g1[3]);
      *(u32x4*)(Wt + (size_t)nd * K + kb + 8 * q) = w;
    }
  }
}

constexpr int HT_FFN = (DM / 64) * (FF / 32);
constexpr int HT_SQ = (DM / 64) * (DM / 32), HT_QKV = (DM / 64) * (NQKV / 32);
#if MK_NO_HELPER
constexpr int HT_TOTAL = 0;
#else
constexpr int HT_TOTAL = 9 * HT_FFN + 2 * HT_SQ + HT_QKV;
#endif
struct HTile { const float* W; bf16_t* Wt; int gi; int K, N, mode, k0, n0; };
__device__ __forceinline__ HTile helper_decode(AP a, int id) {
  HTile t; t.mode = 0; t.gi = -1; int lt; unsigned char* ws = a->ws;
  if (id < 9 * HT_FFN) {
    const int mi = id / HT_FFN; lt = id - mi * HT_FFN; const int f = 1 + mi / 3, which = mi - (mi / 3) * 3, layer = f >> 1, second = f & 1;
    if (which == 2) { t.W = a->in[second ? 10 : 5] + (size_t)layer * DM * FF; t.K = FF; t.N = DM; t.Wt = (bf16_t*)(ws + WS_WD + (size_t)f * SZ_D); }
    else { t.W = a->in[which ? (second ? 9 : 4) : (second ? 8 : 3)] + (size_t)layer * DM * FF; t.K = DM; t.N = FF; t.Wt = (bf16_t*)(ws + WS_WGU + (size_t)f * SZ_GU); t.mode = 1 + which; t.gi = f - 1; }
  } else if (id < 9 * HT_FFN + HT_SQ) { lt = id - 9 * HT_FFN; t.W = a->in[20]; t.K = DM; t.N = DM; t.Wt = (bf16_t*)(ws + WS_WOUT); }
  else if (id < 9 * HT_FFN + HT_SQ + HT_QKV) { lt = id - 9 * HT_FFN - HT_SQ; t.W = a->in[21]; t.K = DM; t.N = NQKV; t.Wt = (bf16_t*)(ws + WS_WQKV); t.gi = 3; }
  else { lt = id - 9 * HT_FFN - HT_SQ - HT_QKV; t.W = a->in[27]; t.K = DM; t.N = DM; t.Wt = (bf16_t*)(ws + WS_WO); }
  const int nkt = t.K / 64, nt = lt / nkt, kt = lt - nt * nkt; t.k0 = kt * 64; t.n0 = nt * 32;
  return t;
}
__device__ __forceinline__ void helper_issue(AP a, int id, float (&v)[32], int lane) {
  const HTile t = helper_decode(a, id);
  const float* src = t.W + (size_t)(t.k0 + (lane >> 5) * 32) * t.N + t.n0 + (lane & 31);
#pragma unroll
  for (int i = 0; i < 32; ++i) v[i] = src[(size_t)i * t.N];
}
__device__ __forceinline__ void helper_finish(AP a, int id, const float (&v)[32], float* wtile, const float* gains, int lane) {
  const HTile t = helper_decode(a, id); (void)wtile;
  const int n = t.n0 + (lane & 31), kb = t.k0 + (lane >> 5) * 32;
  int nd = n; if (t.mode == 1) nd = (n >> 7) * 256 + (n & 127); else if (t.mode == 2) nd = (n >> 7) * 256 + 128 + (n & 127);
#pragma unroll
  for (int q = 0; q < 4; ++q) {
    f32x4 g0 = {1.f, 1.f, 1.f, 1.f}, g1 = g0;
    if (t.gi >= 0) { const float* gp = gains + t.gi * DM + kb + 8 * q; g0 = *(const f32x4*)gp; g1 = *(const f32x4*)(gp + 4); }
    u32x4 w; w[0] = cvt_pk_bf16(v[8 * q] * g0[0], v[8 * q + 1] * g0[1]); w[1] = cvt_pk_bf16(v[8 * q + 2] * g0[2], v[8 * q + 3] * g0[3]);
    w[2] = cvt_pk_bf16(v[8 * q + 4] * g1[0], v[8 * q + 5] * g1[1]); w[3] = cvt_pk_bf16(v[8 * q + 6] * g1[2], v[8 * q + 7] * g1[3]);
    *(u32x4*)(t.Wt + (size_t)nd * t.K + kb + 8 * q) = w;
  }
}

__device__ __forceinline__ void cast_phase(const float* __restrict__ X, bf16_t* __restrict__ XB, u64* __restrict__ ss) {
  const int lane = tidx() & 63, wid = tidx() >> 6;
  for (int row = blockIdx.x * 8 + wid; row < T; row += gridDim.x * 8) {
    const float* xr = X + (size_t)row * DM;
    f32x4 v[8]; float sq = 0.f;
#pragma unroll
    for (int i = 0; i < 8; ++i) v[i] = *(const f32x4*)(xr + (i * 64 + lane) * 4);
#pragma unroll
    for (int i = 0; i < 8; ++i) { u32x2 w; w[0] = cvt_pk_bf16(v[i][0], v[i][1]); w[1] = cvt_pk_bf16(v[i][2], v[i][3]); *(u32x2*)(XB + (size_t)row * DM + (i * 64 + lane) * 4) = w;
      const float y0 = bflo(w[0]), y1 = bfhi(w[0]), y2 = bflo(w[1]), y3 = bfhi(w[1]); sq += y0 * y0 + y1 * y1 + y2 * y2 + y3 * y3; }
    sq = wave_sum(sq);
    if (lane == 0) ss[row] = (u64)(sq * SSQ + 0.5f);
  }
}
__device__ __forceinline__ void final_phase(const bf16_t* __restrict__ XB, const u64* __restrict__ ss, const float* __restrict__ g, float* __restrict__ out) {
  const int lane = tidx() & 63, wid = tidx() >> 6;
  for (int row = blockIdx.x * 8 + wid; row < T; row += gridDim.x * 8) {
    const float rstd = rsqrtf((float)ss[row] * SSQ_INV * (1.f / DM) + EPS);
    u32x4 xv[4];
#pragma unroll
    for (int i = 0; i < 4; ++i) xv[i] = *(const u32x4*)(XB + (size_t)row * DM + (i * 64 + lane) * 8);
#pragma unroll
    for (int i = 0; i < 4; ++i) { const int c = (i * 64 + lane) * 8; const f32x4 g0 = *(const f32x4*)(g + c), g1 = *(const f32x4*)(g + c + 4);
      const f32x4 y0 = (f32x4){bflo(xv[i][0]), bfhi(xv[i][0]), bflo(xv[i][1]), bfhi(xv[i][1])} * rstd * g0, y1 = (f32x4){bflo(xv[i][2]), bfhi(xv[i][2]), bflo(xv[i][3]), bfhi(xv[i][3])} * rstd * g1;
      *(f32x4*)(out + (size_t)row * DM + c) = y0; *(f32x4*)(out + (size_t)row * DM + c + 4) = y1; }
  }
}

__device__ __forceinline__ void prologue(AP a, unsigned char* lds) {
  unsigned char* ws = a->ws;
  float* tile = (float*)lds;
  for (int f = 0; f < (MK_NO_HELPER ? 4 : 1); ++f) {
    const int layer = f >> 1, which = f & 1;
    const float* wg = a->in[which ? 8 : 3] + (size_t)layer * DM * FF; const float* wu = a->in[which ? 9 : 4] + (size_t)layer * DM * FF; const float* wd = a->in[which ? 10 : 5] + (size_t)layer * DM * FF;
    const float* gn = a->in[which ? 7 : 2] + (size_t)layer * DM;
    xpose_mat(wg, DM, FF, (bf16_t*)(ws + WS_WGU + f * SZ_GU), 1, tile, gn);
    xpose_mat(wu, DM, FF, (bf16_t*)(ws + WS_WGU + f * SZ_GU), 2, tile, gn);
    xpose_mat(wd, FF, DM, (bf16_t*)(ws + WS_WD + f * SZ_D), 0, tile);
  }
  xpose_mat(a->in[11], DM, NIN_REAL, (bf16_t*)(ws + WS_WIN), 0, tile, a->in[6]);
#if MK_NO_HELPER
  xpose_mat(a->in[20], DM, DM, (bf16_t*)(ws + WS_WOUT), 0, tile);
  xpose_mat(a->in[21], DM, NQKV, (bf16_t*)(ws + WS_WQKV), 0, tile, a->in[6] + DM);
  xpose_mat(a->in[27], DM, DM, (bf16_t*)(ws + WS_WO), 0, tile);
#endif
  const size_t gtid = (size_t)blockIdx.x * 512 + tidx(), gn = (size_t)gridDim.x * 512;
  { u32x4* p = (u32x4*)(ws + WS_WIN + (size_t)NIN_REAL * DM * 2); const size_t n16 = (size_t)(NIN - NIN_REAL) * DM * 2 / 16; unsigned zz = 0u; asm volatile("" : "+v"(zz)); const u32x4 z = {zz, zz, zz, zz};
    for (size_t i = gtid; i < n16; i += gn) p[i] = z; }
  { u64* ssz = (u64*)(ws + WS_SS); unsigned zq = 0u; asm volatile("" : "+v"(zq)); const u64 z64 = ((u64)zq << 32) | zq;
    for (size_t i = gtid; i < (size_t)6 * T; i += gn) ssz[i < (size_t)5 * T ? i : i + T] = z64; }
  { float* rope = (float*)(ws + WS_ROPE); const int* pos = (const int*)a->in[1];
    for (size_t i = gtid; i < (size_t)T * 16; i += gn) {
      const int tok = (int)(i >> 4), j = (int)(i & 15);
      const float inv = exp2f(-(float)j * (18.931568569324174f / 16.f));
      double rev = (double)pos[tok] * (double)inv * 0.15915494309189535; rev -= floor(rev);
      const float fr = (float)rev;
      rope[(size_t)tok * 32 + j] = __builtin_amdgcn_cosf(fr); rope[(size_t)tok * 32 + 16 + j] = __builtin_amdgcn_sinf(fr);
    } }
  cast_phase(a->in[0], (bf16_t*)(ws + WS_XN), (u64*)(ws + WS_SS) + (size_t)5 * T);
}

__device__ __forceinline__ void conv_module(AP a, unsigned char* lds) {
  const bf16_t* P = (const bf16_t*)(a->ws + WS_H); bf16_t* CAT = (bf16_t*)(a->ws + WS_S);
  unsigned* glu = (unsigned*)lds; float* part = (float*)(lds + 62 * 512 * 4); float* stats = part + 512;
  const int tid = tidx(), lane = tid & 63, wid = tid >> 6, c0 = 2 * tid;
  const float* cw = a->in[12];
  float w0[31], w1[31];
#pragma unroll
  for (int j = 0; j < 31; ++j) { const f32x2 t = *(const f32x2*)(cw + j * 1024 + c0); w0[j] = t[0]; w1[j] = t[1]; }
  const f32x2 cb = *(const f32x2*)(a->in[13] + c0), lg = *(const f32x2*)(a->in[14] + c0), lb = *(const f32x2*)(a->in[15] + c0);
  for (int tile = blockIdx.x; tile < T / 32; tile += gridDim.x) {
    const int tok0 = tile * 32, s0 = tok0 & (SEQ - 1);
    for (int r0 = 0; r0 < 64; r0 += 8) {
      unsigned pv[8], pg[8];
#pragma unroll
      for (int i = 0; i < 8; ++i) { const int r = r0 + i, s = s0 - 15 + r; const bool ok = (r < 62) && s >= 0 && s < SEQ;
        const bf16_t* pr = P + (size_t)(ok ? tok0 - 15 + r : tok0) * NIN + c0; pv[i] = *(const unsigned*)pr; pg[i] = *(const unsigned*)(pr + 1024); }
#pragma unroll
      for (int i = 0; i < 8; ++i) { const int r = r0 + i, s = s0 - 15 + r; const bool ok = s >= 0 && s < SEQ;
        const unsigned val = ok ? cvt_pk_bf16(bflo(pv[i]) * sigm(bflo(pg[i])), bfhi(pv[i]) * sigm(bfhi(pg[i]))) : 0u;
        if (r < 62) glu[r * 512 + tid] = val; }
    }
#pragma unroll 1
    for (int tt = 0; tt < 32; ++tt) {
      float o0 = cb[0], o1 = cb[1];
#pragma unroll
      for (int j = 0; j < 31; ++j) { const unsigned u = glu[(tt + j) * 512 + tid]; o0 += w0[j] * bflo(u); o1 += w1[j] * bfhi(u); }
      const float s = wave_sum(o0 + o1), q = wave_sum(o0 * o0 + o1 * o1);
      if (lane == 0) { part[(wid * 32 + tt) * 2] = s; part[(wid * 32 + tt) * 2 + 1] = q; }
    }
    __syncthreads();
    if (tid < 32) { float s = 0.f, q = 0.f;
      for (int w = 0; w < 8; ++w) { s += part[(w * 32 + tid) * 2]; q += part[(w * 32 + tid) * 2 + 1]; }
      const float mean = s * (1.f / 1024.f), var = fmaxf(q * (1.f / 1024.f) - mean * mean, 0.f);
      stats[tid * 2] = mean; stats[tid * 2 + 1] = rsqrtf(var + EPS); }
    __syncthreads();
#pragma unroll 1
    for (int tt = 0; tt < 32; ++tt) {
      float o0 = cb[0], o1 = cb[1];
#pragma unroll
      for (int j = 0; j < 31; ++j) { const unsigned u = glu[(tt + j) * 512 + tid]; o0 += w0[j] * bflo(u); o1 += w1[j] * bfhi(u); }
      const float mean = stats[tt * 2], rstd = stats[tt * 2 + 1];
      const float y0 = (o0 - mean) * rstd * lg[0] + lb[0], y1 = (o1 - mean) * rstd * lg[1] + lb[1];
      *(unsigned*)(CAT + (size_t)(tok0 + tt) * DM + c0) = cvt_pk_bf16(silu(y0), silu(y1));
    }
    __syncthreads();
  }
}

__device__ __forceinline__ void dn_prep(AP a) {
  const bf16_t* P = (const bf16_t*)(a->ws + WS_H);
  bf16_t* QN = (bf16_t*)(a->ws + WS_S); bf16_t* KN = (bf16_t*)(a->ws + WS_S + SZ_T1K); bf16_t* VS = (bf16_t*)(a->ws + WS_S + 2 * SZ_T1K);
  const float* sw = a->in[16];
  const int lane = tidx() & 63, wid = tidx() >> 6;
  for (int tok = blockIdx.x * 8 + wid; tok < T; tok += gridDim.x * 8) {
    const int s = tok & (SEQ - 1);
#pragma unroll 1
    for (int sb = 0; sb < 24; sb += 4) {
      unsigned x0[4], xm[4], xp[4]; f32x2 wa[4], wb[4], wc[4];
#pragma unroll
      for (int i = 0; i < 4; ++i) { const int c = (sb + i) * 128 + 2 * lane; const bf16_t* pr = P + (size_t)tok * NIN + 2048 + c;
        x0[i] = *(const unsigned*)pr; xm[i] = *(const unsigned*)(pr - (s > 0 ? NIN : 0)); xp[i] = *(const unsigned*)(pr + (s < SEQ - 1 ? NIN : 0));
        wa[i] = *(const f32x2*)(sw + c); wb[i] = *(const f32x2*)(sw + 3072 + c); wc[i] = *(const f32x2*)(sw + 6144 + c); }
#pragma unroll
      for (int i = 0; i < 4; ++i) { const int slot = sb + i;
        const unsigned um = (s > 0) ? xm[i] : 0u, up = (s < SEQ - 1) ? xp[i] : 0u;
        float y0 = wa[i][0] * bflo(um) + wb[i][0] * bflo(x0[i]) + wc[i][0] * bflo(up), y1 = wa[i][1] * bfhi(um) + wb[i][1] * bfhi(x0[i]) + wc[i][1] * bfhi(up);
        y0 = silu(y0); y1 = silu(y1);
        if (slot < 16) { const float ss = wave_sum(y0 * y0 + y1 * y1); float r = rsqrtf(ss + EPS); if (slot < 8) r *= 0.08838834764831845f; y0 *= r; y1 *= r; }
        bf16_t* dst = (slot < 8 ? QN : (slot < 16 ? KN : VS)) + (size_t)tok * 1024 + (slot & 7) * 128 + 2 * lane;
        *(unsigned*)dst = cvt_pk_bf16(y0, y1); }
    }
  }
  const float* BA = (const float*)(a->ws + WS_BA); float* BG = (float*)(a->ws + WS_BG);
  for (size_t i = (size_t)blockIdx.x * 512 + tidx(); i < (size_t)T * 16; i += (size_t)gridDim.x * 512) {
    const int tok = (int)(i >> 4), j = (int)(i & 15);
    const float braw = BA[(size_t)tok * 32 + j], araw = BA[(size_t)tok * 32 + 16 + j];
    const float xx = araw + a->in[18][j]; const float sp = xx > 20.f ? xx : log1pf(expf(xx));
    const float g = -expf(a->in[17][j]) * sp;
    BG[(size_t)tok * 32 + j] = sigm(braw); BG[(size_t)tok * 32 + 16 + j] = expf(g);
  }
}

__device__ __forceinline__ void scan_phase(AP a, unsigned char* lds) {
  const bf16_t* QN = (const bf16_t*)(a->ws + WS_S); const bf16_t* KN = (const bf16_t*)(a->ws + WS_S + SZ_T1K); const bf16_t* VS = (const bf16_t*)(a->ws + WS_S + 2 * SZ_T1K);
  const float* BG = (const float*)(a->ws + WS_BG);
  constexpr int BUF_F = 32 * 128 * 2 + 32 * 32 + 64;
  float* sb = (float*)lds; float* ob = sb + 2 * BUF_F;
  float* dump = ob + 2048 + (tidx() & 255);
  float* wtile = (float*)(lds + 86016) + ((tidx() >> 6) & 3) * (64 * 33);
  int hid = (int)blockIdx.x * 4 + ((tidx() >> 6) & 3); const int hstep = (int)gridDim.x * 4;
  float* gains = (float*)(lds + 119808);
  for (int i = tidx(); i < 4 * DM; i += 512) { const int v = i >> 11, k = i & (DM - 1); gains[i] = (v == 0) ? a->in[7][k] : (v == 1) ? a->in[2][DM + k] : (v == 2) ? a->in[7][DM + k] : a->in[6][DM + k]; }
  __syncthreads();
  int hprev = -1; float hv[32];
#pragma unroll
  for (int i = 0; i < 32; ++i) hv[i] = 0.f;
  const int tid = tidx(), lane = tid & 63, wid = tid >> 6, j = lane & 7, col = (wid & 3) * 8 + (lane >> 3);
  const int tl = tid >> 4, c8 = (tid & 15) * 8, tlv = (tid >> 2) & 31, cv = (tid & 3) * 8;
  for (int item = blockIdx.x; item < 256; item += gridDim.x) {
    const int cb = item & 3, dir = (item >> 2) & 1, h = (item >> 3) & 7, b = item >> 6;
    bf16_t* OD = (bf16_t*)(a->ws + WS_S + (3 + dir) * SZ_T1K);
    f32x2 S2[8];
#pragma unroll
    for (int i = 0; i < 8; ++i) S2[i] = (f32x2){0.f, 0.f};
    u32x4 kr, qr, vr; float ar = 0.f, br = 0.f;
#define SC_TOK(c, t) (b * SEQ + (dir ? (SEQ - 1 - ((c) * 32 + (t))) : ((c) * 32 + (t))))
#define SC_LOAD(c) do { const size_t tk = (size_t)SC_TOK(c, tl); kr = *(const u32x4*)(KN + tk * 1024 + h * 128 + c8); qr = *(const u32x4*)(QN + tk * 1024 + h * 128 + c8); \
      if (tid < 128) vr = *(const u32x4*)(VS + (size_t)SC_TOK(c, tlv) * 1024 + h * 128 + cb * 32 + cv); \
      else if (tid < 160) { const size_t t2 = (size_t)SC_TOK(c, tid - 128); br = BG[t2 * 32 + dir * 8 + h]; ar = BG[t2 * 32 + 16 + dir * 8 + h]; } } while (0)
#define SC_WRITE(bi) do { float* kb = sb + (bi) * BUF_F; float* qb = kb + 4096; float* vb = qb + 4096; float* abp = vb + 1024; \
      *(f32x4*)(kb + tl * 128 + c8) = (f32x4){bflo(kr[0]), bfhi(kr[0]), bflo(kr[1]), bfhi(kr[1])}; *(f32x4*)(kb + tl * 128 + c8 + 4) = (f32x4){bflo(kr[2]), bfhi(kr[2]), bflo(kr[3]), bfhi(kr[3])}; \
      *(f32x4*)(qb + tl * 128 + c8) = (f32x4){bflo(qr[0]), bfhi(qr[0]), bflo(qr[1]), bfhi(qr[1])}; *(f32x4*)(qb + tl * 128 + c8 + 4) = (f32x4){bflo(qr[2]), bfhi(qr[2]), bflo(qr[3]), bfhi(qr[3])}; \
      if (tid < 128) { *(f32x4*)(vb + tlv * 32 + cv) = (f32x4){bflo(vr[0]), bfhi(vr[0]), bflo(vr[1]), bfhi(vr[1])}; *(f32x4*)(vb + tlv * 32 + cv + 4) = (f32x4){bflo(vr[2]), bfhi(vr[2]), bflo(vr[3]), bfhi(vr[3])}; } \
      else if (tid < 160) { abp[(tid - 128) * 2] = ar; abp[(tid - 128) * 2 + 1] = br; } } while (0)
#define SC_FLUSH(c) do { if (tid < 128) { const float* op = ob + ((c) & 1) * 1024 + tlv * 32 + cv; const f32x4 x0 = *(const f32x4*)op, x1 = *(const f32x4*)(op + 4); \
      u32x4 w; w[0] = cvt_pk_bf16(x0[0], x0[1]); w[1] = cvt_pk_bf16(x0[2], x0[3]); w[2] = cvt_pk_bf16(x1[0], x1[1]); w[3] = cvt_pk_bf16(x1[2], x1[3]); \
      *(u32x4*)(OD + (size_t)SC_TOK(c, tlv) * 1024 + h * 128 + cb * 32 + cv) = w; } } while (0)
    __syncthreads();
    SC_LOAD(0); SC_WRITE(0); __syncthreads();
    for (int c = 0; c < SEQ / 32; ++c) {
      if (c + 1 < SEQ / 32) SC_LOAD(c + 1);
      if (c > 0) SC_FLUSH(c - 1);
      const float* kb = sb + (c & 1) * BUF_F; const float* qb = kb + 4096; const float* vb = qb + 4096; const float* abp = vb + 1024; float* obc = ob + (c & 1) * 1024;
      if (wid < 4) {
        f32x4 kv[4], qv[4]; f32x2 ab2; float vv;
#define SC_LD(t) do { _Pragma("unroll") for (int i = 0; i < 4; ++i) { kv[i] = *(const f32x4*)(kb + (t) * 128 + 16 * j + 4 * i); qv[i] = *(const f32x4*)(qb + (t) * 128 + 16 * j + 4 * i); } \
          ab2 = *(const f32x2*)(abp + (t) * 2); vv = vb[(t) * 32 + col]; } while (0)
        SC_LD(0);
#pragma unroll 8
        for (int t = 0; t < 32; ++t) {
          f32x2 kk[8], qq[8];
#pragma unroll
          for (int i = 0; i < 4; ++i) { kk[2 * i] = (f32x2){kv[i][0], kv[i][1]}; kk[2 * i + 1] = (f32x2){kv[i][2], kv[i][3]}; qq[2 * i] = (f32x2){qv[i][0], qv[i][1]}; qq[2 * i + 1] = (f32x2){qv[i][2], qv[i][3]}; }
          const float al = ab2[0], bt = ab2[1], vc = vv;
          SC_LD((t + 1) & 31);
          f32x2 d0 = S2[0] * kk[0], d1 = S2[1] * kk[1];
#pragma unroll
          for (int i = 1; i < 4; ++i) { d0 = S2[2 * i] * kk[2 * i] + d0; d1 = S2[2 * i + 1] * kk[2 * i + 1] + d1; }
          d0 = d0 + d1;
          const float d = row_sum8(d0[0] + d0[1]);
          const float dl = bt * (vc - al * d);
          const f32x2 dl2 = {dl, dl}, al2 = {al, al};
#pragma unroll
          for (int i = 0; i < 8; ++i) S2[i] = kk[i] * dl2 + S2[i] * al2;
          f32x2 o0 = S2[0] * qq[0], o1 = S2[1] * qq[1];
#pragma unroll
          for (int i = 1; i < 4; ++i) { o0 = S2[2 * i] * qq[2 * i] + o0; o1 = S2[2 * i + 1] * qq[2 * i + 1] + o1; }
          o0 = o0 + o1;
          const float od = row_sum8(o0[0] + o0[1]);
          *((j == 0) ? (obc + t * 32 + col) : dump) = od;
        }
#undef SC_LD
      } else {
        if (hprev >= 0) helper_finish(a, hprev, hv, wtile, gains, lane);
        if (hid < HT_TOTAL) { helper_issue(a, hid, hv, lane); hprev = hid; hid += hstep; } else hprev = -1;
      }
      if (c + 1 < SEQ / 32) SC_WRITE((c + 1) & 1);
      asm volatile("s_waitcnt lgkmcnt(0)" ::: "memory"); __builtin_amdgcn_s_barrier(); asm volatile("" ::: "memory");
    }
    SC_FLUSH(SEQ / 32 - 1);
    __syncthreads();
#undef SC_TOK
#undef SC_LOAD
#undef SC_WRITE
#undef SC_FLUSH
  }
  if (wid >= 4) { if (hprev >= 0) helper_finish(a, hprev, hv, wtile, gains, lane); for (; hid < HT_TOTAL; hid += hstep) { helper_issue(a, hid, hv, lane); helper_finish(a, hid, hv, wtile, gains, lane); } }
}

__device__ __forceinline__ void gnorm_phase(AP a) {
  const bf16_t* P = (const bf16_t*)(a->ws + WS_H); bf16_t* CAT = (bf16_t*)(a->ws + WS_S);
  const bf16_t* OF = (const bf16_t*)(a->ws + WS_S + 3 * SZ_T1K); const bf16_t* OB = (const bf16_t*)(a->ws + WS_S + 4 * SZ_T1K);
  const int lane = tidx() & 63, wid = tidx() >> 6;
  const f32x2 g = *(const f32x2*)(a->in[19] + 2 * lane);
  for (int tok = blockIdx.x * 8 + wid; tok < T; tok += gridDim.x * 8) {
    unsigned uf[8], ub[8], uz[8];
#pragma unroll
    for (int h = 0; h < 8; ++h) { const size_t o = (size_t)tok * 1024 + h * 128 + 2 * lane;
      uf[h] = *(const unsigned*)(OF + o); ub[h] = *(const unsigned*)(OB + o); uz[h] = *(const unsigned*)(P + (size_t)tok * NIN + 5120 + h * 128 + 2 * lane); }
#pragma unroll
    for (int h = 0; h < 8; ++h) {
      const float o0 = bflo(uf[h]) + bflo(ub[h]), o1 = bfhi(uf[h]) + bfhi(ub[h]);
      const float ss = wave_sum(o0 * o0 + o1 * o1), rstd = rsqrtf(ss * (1.f / 128.f) + EPS);
      const float y0 = o0 * rstd * g[0] * silu(bflo(uz[h])), y1 = o1 * rstd * g[1] * silu(bfhi(uz[h]));
      *(unsigned*)(CAT + (size_t)tok * DM + 1024 + h * 128 + 2 * lane) = cvt_pk_bf16(y0, y1);
    }
  }
}

__device__ __forceinline__ void attn_phase(AP a, unsigned char* lds) {
  const bf16_t* QKV = (const bf16_t*)(a->ws + WS_H); float* OA = (float*)(a->ws + WS_S);
  const int lane = tidx() & 63;
  const float s1 = wave_sum(a->in[22][lane] * a->in[23][lane] + a->in[22][lane + 64] * a->in[23][lane + 64]);
  const float s2 = wave_sum(a->in[24][lane] * a->in[25][lane] + a->in[24][lane + 64] * a->in[25][lane + 64]);
  const float lam = __int_as_float(__builtin_amdgcn_readfirstlane(__float_as_int(expf(s1) - expf(s2) + LAMBDA_INIT)));
  int seq = SEQ; asm volatile("" : "+s"(seq));
  const int nk = (512 - (int)blockIdx.x + (int)gridDim.x - 1) / (int)gridDim.x;
#pragma unroll 1
  for (int it = 0; it < 4 * nk; ++it) {
    const int item = blockIdx.x + gridDim.x * (it >> 2), m = it & 1, vh = (it >> 1) & 1;
    const int h = item & 7, qb = (item >> 3) & 15, b = item >> 7;
    const size_t tok0 = (size_t)b * SEQ + qb * 256, kv0 = (size_t)b * SEQ;
    att::attn_dense_body<att::bf16>(QKV + tok0 * NQKV + h * 256 + m * 128, QKV + kv0 * NQKV + 2048 + h * 256 + m * 128, QKV + kv0 * NQKV + 4096 + h * 256 + vh * 128,
                                    OA + tok0 * DM + h * 256 + vh * 128, seq, (char*)lds, m, lam, (unsigned short*)(lds + 69632));
    __syncthreads();
    if ((it & 3) == 3) {
      asm volatile("s_waitcnt vmcnt(0)" ::: "memory");
      const int wv = tidx() >> 6, ln = tidx() & 63; bf16_t* CAT = (bf16_t*)a->out;
      const f32x4 sg = *(const f32x4*)(a->in[26] + 4 * ln);
#pragma unroll 4
      for (int r = 0; r < 32; ++r) {
        const size_t o = (tok0 + wv * 32 + r) * DM + h * 256 + 4 * ln;
        const f32x4 v = *(const f32x4*)(OA + o);
        const float ss = wave_sum(v[0] * v[0] + v[1] * v[1] + v[2] * v[2] + v[3] * v[3]), rr = rsqrtf(ss * (1.f / 256.f) + EPS) * (1.f - LAMBDA_INIT);
        u32x2 w; w[0] = cvt_pk_bf16(v[0] * rr * sg[0], v[1] * rr * sg[1]); w[1] = cvt_pk_bf16(v[2] * rr * sg[2], v[3] * rr * sg[3]);
        *(u32x2*)(CAT + o) = w;
      }
    }
  }
}
__device__ __forceinline__ void subln_phase(AP a) {
  const float* OA = (const float*)(a->ws + WS_S); bf16_t* CAT = (bf16_t*)(a->ws + WS_H);
  const int lane = tidx() & 63, wid = tidx() >> 6;
  const f32x4 g = *(const f32x4*)(a->in[26] + 4 * lane);
  for (int task = blockIdx.x * 8 + wid; task < T * 8; task += gridDim.x * 8) {
    const size_t o = (size_t)(task >> 3) * DM + (task & 7) * 256 + 4 * lane;
    const f32x4 v = *(const f32x4*)(OA + o);
    const float ss = wave_sum(v[0] * v[0] + v[1] * v[1] + v[2] * v[2] + v[3] * v[3]), r = rsqrtf(ss * (1.f / 256.f) + EPS) * (1.f - LAMBDA_INIT);
    u32x2 w; w[0] = cvt_pk_bf16(v[0] * r * g[0], v[1] * r * g[1]); w[1] = cvt_pk_bf16(v[2] * r * g[2], v[3] * r * g[3]);
    *(u32x2*)(CAT + o) = w;
  }
}

#define XB_TMO      128
#define XB_XCNT(j)  (256  + 64 * (j))
#define XB_XSUB(j)  (1280 + 64 * (j))
#define XB_XGEN(j)  (2304 + 64 * (j))
#define XB_TOP      3328
#define XB_TOPGEN   3392
#define XCD_BAR_WORDS 3456
#define XB_SPIN_CAP (1u << 18)
__device__ __forceinline__ unsigned xb_ld(unsigned* p)              { return __hip_atomic_load(p, __ATOMIC_RELAXED, __HIP_MEMORY_SCOPE_AGENT); }
__device__ __forceinline__ unsigned xb_add(unsigned* p, unsigned v) { return __hip_atomic_fetch_add(p, v, __ATOMIC_RELAXED, __HIP_MEMORY_SCOPE_AGENT); }
__device__ __forceinline__ unsigned xb_xcc_id() { return (unsigned)__builtin_amdgcn_s_getreg((3 << 11) | 20) & 0xFu; }
#define XB_SPIN(cond, bar) do { unsigned _sp = 0; while (cond) { __builtin_amdgcn_s_sleep(1); \
    if ((++_sp & 255u) == 0u) { if (xb_ld(&(bar)[XB_TMO])) break; if (_sp > XB_SPIN_CAP) { atomicAdd(&(bar)[XB_TMO], 1u); break; } } } } while (0)
__device__ __forceinline__ void xcd_barrier_complete(unsigned* bar, unsigned x, unsigned& nloc, unsigned& nx) {
  const unsigned G = gridDim.x;
  unsigned sum, cnt, mine, sp = 0u;
  for (;;) {
    sum = 0u; cnt = 0u; mine = 0u;
#pragma unroll 1
    for (unsigned j = 0; j < 16; ++j) { const unsigned c = xb_ld(&bar[XB_XCNT(j)]); sum += c; cnt += (c > 0u) ? 1u : 0u; mine = (j == x) ? c : mine; }
    if (sum == G) break;
    __builtin_amdgcn_s_sleep(1);
    if ((++sp & 255u) == 0u) { if (xb_ld(&bar[XB_TMO])) break; if (sp > XB_SPIN_CAP) { atomicAdd(&bar[XB_TMO], 1u); break; } }
  }
  nloc = mine > 0u ? mine : 1u; nx = cnt > 0u ? cnt : 1u;
}
__device__ __forceinline__ void xcd_barrier(unsigned* bar, volatile PG8_LAS unsigned* st) {
  asm volatile("s_waitcnt vmcnt(0)" ::: "memory");
  __syncthreads();
  if (threadIdx.x == 0) {
    const unsigned x = xb_xcc_id();
    __builtin_amdgcn_s_waitcnt(0);
    unsigned nloc = st[0], nx = st[1];
    if (nloc == 0u) { xcd_barrier_complete(bar, x, nloc, nx); st[0] = nloc; st[1] = nx; }
    const unsigned old = xb_add(&bar[XB_XSUB(x)], 1u);
    const unsigned gen = old / nloc;
    if (old + 1u == (gen + 1u) * nloc) {
      __builtin_amdgcn_fence(__ATOMIC_RELEASE, "agent");
      asm volatile("s_waitcnt vmcnt(0)" ::: "memory");
      const unsigned og = xb_add(&bar[XB_TOP], 1u);
      const unsigned tg = og / nx;
      if (og + 1u == (tg + 1u) * nx) xb_add(&bar[XB_TOPGEN], 1u);
      else XB_SPIN(xb_ld(&bar[XB_TOPGEN]) == tg, bar);
      __builtin_amdgcn_fence(__ATOMIC_ACQUIRE, "agent");
      xb_add(&bar[XB_XGEN(x)], 1u);
      asm volatile("s_waitcnt vmcnt(0)" ::: "memory");
    } else {
      XB_SPIN(xb_ld(&bar[XB_XGEN(x)]) == gen, bar);
      __builtin_amdgcn_fence(__ATOMIC_ACQUIRE, "agent");
      asm volatile("s_waitcnt vmcnt(0)" ::: "memory");
    }
  }
  __syncthreads();
}

enum { PT_PRO, PT_GU, PT_RES, PT_NORM, PT_IN, PT_CONV, PT_SCAN, PT_GNORM, PT_QKV, PT_ATTN, PT_SUBLN, PT_FINAL };

__global__ void __launch_bounds__(512, 2) mega(Args a_kernarg) {
  extern __shared__ __attribute__((aligned(16))) unsigned char lds[];
  cg::grid_group grid = cg::this_grid();
  const AP a0 = (AP)__builtin_amdgcn_kernarg_segment_ptr();
  volatile PG8_LAS unsigned* xst = (volatile PG8_LAS unsigned*)((PG8_LAS unsigned char*)lds + (LDS_BYTES - 16));
  if (threadIdx.x == 0) { xst[0] = 0u; xst[1] = 0u; const unsigned xx = xb_xcc_id(); const unsigned rank = xb_add(&((unsigned*)(a0->ws + WS_BAR))[XB_XCNT(xx)], 1u);
    xst[2] = blockIdx.x; xst[3] = xx + 8u * rank; }
  __syncthreads();
  const int ph_lo = a0->ph_lo, ph_hi = a0->ph_hi;
  for (int php = ph_lo; php < ph_hi; ++php) {
    int ph = php;
#ifndef MK_DUP_PH
#define DUP2 0
#else
#define DUP2 (int)dup2
#endif
#ifdef MK_DUP_PH
    bool dup2 = false;
    if (php > MK_DUP_PH) { ph = php - 1; dup2 = (php == MK_DUP_PH + 1); }
#endif
    unsigned long long apv = (unsigned long long)a0; asm volatile("" : "+s"(apv)); const AP a = (AP)apv;
    unsigned char* ws = a->ws;
    int type = PT_PRO, f = 0, nss = -1;
    const bf16_t* gA = (const bf16_t*)(ws + WS_H); const bf16_t* gB = nullptr; int gK = FF;
    switch (ph) {
      case 0: type = PT_PRO; break;
      case 1: type = PT_GU; f = 0; nss = 5; break;
      case 2: type = PT_RES; gB = (const bf16_t*)(ws + WS_WD); nss = 0; break;
      case 3: type = PT_IN; nss = 0; break;
      case 4: type = PT_CONV; break;
      case 5: type = PT_SCAN; break;
      case 6: type = PT_GNORM; break;
      case 7: type = PT_RES; gA = (const bf16_t*)(ws + WS_S); gB = (const bf16_t*)(ws + WS_WOUT); gK = DM; nss = 1; break;
      case 8: type = PT_GU; f = 1; nss = 1; break;
      case 9: type = PT_RES; gB = (const bf16_t*)(ws + WS_WD + 1 * SZ_D); nss = 2; break;
      case 10: type = PT_GU; f = 2; nss = 2; break;
      case 11: type = PT_RES; gB = (const bf16_t*)(ws + WS_WD + 2 * SZ_D); nss = 3; break;
      case 12: type = PT_QKV; nss = 3; break;
      case 13: type = PT_ATTN; break;
      case 14: type = PT_SUBLN; break;
      case 15: type = PT_RES; gA = (const bf16_t*)a->out; gB = (const bf16_t*)(ws + WS_WO); gK = DM; nss = 4; break;
      case 16: type = PT_GU; f = 3; nss = 4; break;
      case 17: type = PT_RES; gB = (const bf16_t*)(ws + WS_WD + 3 * SZ_D); break;
      default: type = PT_FINAL; break;
    }
    const u64* ssp = (const u64*)(ws + WS_SS) + (size_t)(nss >= 0 ? nss : 0) * T;
    pg8::StaticOrder S; const int cid = __builtin_amdgcn_readfirstlane((int)xst[2]);
#ifndef MK_ENABLE
#define MK_ENABLE 0xFFFF
#endif
    if (!((MK_ENABLE >> type) & 1)) continue;
    if (type == PT_SUBLN) continue;
    switch (type) {
      case PT_PRO: prologue(a, lds); break;
      case PT_GU: {
#ifdef MK_STAGGER
        if ((blockIdx.x >> 3) & 1) { const unsigned long long t0 = __builtin_amdgcn_s_memrealtime(); while (__builtin_amdgcn_s_memrealtime() - t0 < MK_STAGGER) __builtin_amdgcn_s_sleep(32); }
#endif
        pg8::Gemm g{(const bf16_t*)(ws + WS_XN), (const bf16_t*)(ws + WS_WGU + (size_t)f * SZ_GU), T, 2 * FF, DM}; S.init(T, 2 * FF, gridDim.x, cid);
        EpiSwiglu E{(bf16_t*)(ws + WS_H), ssp, DUP2}; pg8::gemm_phase<EpiSwiglu, pg8::StaticOrder>((PG8_LAS unsigned char*)lds, g, S, E, nullptr); } break;
      case PT_RES: { pg8::Gemm g{gA, gB, T, DM, gK}; S.init(T, DM, gridDim.x, cid);
        EpiResid E{a, ph, DUP2}; pg8::gemm_phase<EpiResid, pg8::StaticOrder>((PG8_LAS unsigned char*)lds, g, S, E, nullptr); } break;
      case PT_IN: { pg8::Gemm g{(const bf16_t*)(ws + WS_XN), (const bf16_t*)(ws + WS_WIN), T, NIN, DM}; S.init(T, NIN, gridDim.x, cid);
        EpiP E{(bf16_t*)(ws + WS_H), (float*)(ws + WS_BA), ssp}; pg8::gemm_phase<EpiP, pg8::StaticOrder>((PG8_LAS unsigned char*)lds, g, S, E, nullptr); } break;
      case PT_CONV: dn_prep(a); break;
      case PT_SCAN: scan_phase(a, lds); break;
      case PT_GNORM: gnorm_phase(a); conv_module(a, lds); break;
      case PT_QKV: { pg8::Gemm g{(const bf16_t*)(ws + WS_XN), (const bf16_t*)(ws + WS_WQKV), T, NQKV, DM}; S.init(T, NQKV, gridDim.x, cid);
        EpiQKV E{(bf16_t*)(ws + WS_H), (const float*)(ws + WS_ROPE), ssp}; pg8::gemm_phase<EpiQKV, pg8::StaticOrder>((PG8_LAS unsigned char*)lds, g, S, E, nullptr); } break;
      case PT_ATTN: attn_phase(a, lds); break;
      case PT_SUBLN: break;
      default: final_phase((const bf16_t*)(ws + WS_XN), (const u64*)(ws + WS_SS) + (size_t)6 * T, a->in[28], a->out); break;
    }
    if (php + 1 < ph_hi) { if (php == ph_lo) { grid.sync();
        if (threadIdx.x == 0) { unsigned* bw = (unsigned*)(a0->ws + WS_BAR); bool ok = (gridDim.x == 256u);
#pragma unroll 1
          for (unsigned j = 0; j < 16; ++j) { const unsigned c = xb_ld(&bw[XB_XCNT(j)]); ok = ok && (c == (j < 8u ? 32u : 0u)); }
          if (ok) xst[2] = xst[3]; }
        __syncthreads(); }
      else xcd_barrier((unsigned*)(a0->ws + WS_BAR), xst); }
  }
}
}

#ifndef MK_MULTI
#define MK_MULTI 0
#endif
extern "C" void kernel_launch(void* const* d_in, const int* in_sizes, int n_in, void* d_out, int out_size, void* d_ws, size_t ws_size, hipStream_t stream) {
  static int grid = 0;
  if (grid == 0) {
    if (n_in != 29 || out_size != mk::T * mk::DM || ws_size < mk::WS_END) { fprintf(stderr, "kernel_launch: unexpected shapes n_in %d out %d ws %zu (need %zu)\n", n_in, out_size, ws_size, (size_t)mk::WS_END); grid = -1; return; }
    int dev = 0, cus = 0, per_cu = 0;
    hipGetDevice(&dev); hipDeviceGetAttribute(&cus, hipDeviceAttributeMultiprocessorCount, dev);
    if (hipFuncSetAttribute((const void*)mk::mega, hipFuncAttributeMaxDynamicSharedMemorySize, mk::LDS_BYTES) != hipSuccess) { fprintf(stderr, "kernel_launch: hipFuncSetAttribute failed\n"); grid = -1; return; }
    hipOccupancyMaxActiveBlocksPerMultiprocessor(&per_cu, (const void*)mk::mega, 512, mk::LDS_BYTES);
    if (per_cu < 1) per_cu = 1;
    grid = cus * per_cu;
    (void)hipGetLastError();
  }
  if (grid < 0) return;
  mk::Args a{};
  for (int i = 0; i < 29; ++i) a.in[i] = (const float*)d_in[i];
  a.out = (float*)d_out; a.ws = (unsigned char*)d_ws;
#if MK_MULTI
  for (int ph = 0; ph < mk::NPHASE; ++ph) { a.ph_lo = ph; a.ph_hi = ph + 1; hipLaunchKernelGGL(mk::mega, dim3(grid), dim3(512), mk::LDS_BYTES, stream, a); }
#else
  a.ph_lo = 0; a.ph_hi = mk::NPHASE;
  (void)hipMemsetAsync((char*)d_ws + mk::WS_BAR, 0, 16384, stream);
  void* args[] = {&a};
  hipError_t e = hipLaunchCooperativeKernel((const void*)mk::mega, dim3(grid), dim3(512), args, mk::LDS_BYTES, stream);
  if (e != hipSuccess) fprintf(stderr, "cooperative launch failed: %s (grid %d)\n", hipGetErrorString(e), grid);
#endif
}
```
